# Optimizing an MI355X kernel written in HIP

```python
import math
import jax
import jax.numpy as jnp
from jax import lax
import numpy as np


D_MODEL = 1024
BATCH = 2
SEQ = 8192
DEPTH = 2

CTX_LEN = 256
GRID_W = 64
EPS = 1e-6
ROPE_BASE = 10000.0
CHUNK = 128
Q_BLOCK = 128
D_MIX = 2 * D_MODEL

ATT_QK_DIM = 64
ATT_V_DIM = 2 * ATT_QK_DIM
ATT_WIDTH = D_MODEL // 2
ATT_HEADS = ATT_WIDTH // ATT_V_DIM

SSD_HEAD_DIM = 64
SSD_WIDTH = D_MODEL
SSD_HEADS = SSD_WIDTH // SSD_HEAD_DIM
SSD_GROUPS = 2
SSD_HPG = SSD_HEADS // SSD_GROUPS
SSD_STATE = 128
SSD_CONV = 3
SSD_CONV_DIM = SSD_WIDTH + 2 * SSD_GROUPS * SSD_STATE

RET_WIDTH = D_MODEL // 2
RET_HEADS = 4
RET_V_DIM = RET_WIDTH // RET_HEADS
RET_QK_DIM = RET_V_DIM // 2
RET_DECAY_EXP_FWD = (5.0, 6.0, 7.0, 8.0)
RET_DECAY_EXP_BWD = (5.5, 6.5, 7.5, 8.5)

IN_SPLITS = (ATT_HEADS * 2 * ATT_QK_DIM, ATT_HEADS * 2 * ATT_QK_DIM, ATT_WIDTH, ATT_WIDTH,
             SSD_CONV_DIM, 2 * SSD_HEADS, SSD_WIDTH,
             RET_HEADS * RET_QK_DIM, RET_HEADS * RET_QK_DIM, RET_WIDTH, RET_WIDTH)
D_IN_PROJ = sum(IN_SPLITS)

kernel_name = 'hybrid_diffusion_parallel_heads'


def rms_norm(x, gain=None):
    xf = x.astype(jnp.float32)
    y = xf * lax.rsqrt(jnp.mean(xf * xf, axis=-1, keepdims=True) + EPS)
    if gain is not None:
        y = y * gain.astype(jnp.float32)
    return y.astype(x.dtype)


def split_columns(t, sizes):
    parts, off = [], 0
    for s in sizes:
        parts.append(t[..., off:off + s])
        off += s
    return parts


def axial_rope_table(n_rows, dim):
    row = jnp.repeat(jnp.arange(n_rows, dtype=jnp.float32), GRID_W)
    col = jnp.tile(jnp.arange(GRID_W, dtype=jnp.float32), n_rows)
    n_freq = dim // 4
    inv_freq = ROPE_BASE ** (-jnp.arange(n_freq, dtype=jnp.float32) / n_freq)
    ang = jnp.concatenate([row[:, None] * inv_freq, col[:, None] * inv_freq], axis=-1)
    return jnp.cos(ang), jnp.sin(ang)


def apply_rope(x, cos, sin):
    shape = (1, x.shape[1]) + (1,) * (x.ndim - 3) + (cos.shape[-1],)
    cs = cos.reshape(shape).astype(x.dtype)
    sn = sin.reshape(shape).astype(x.dtype)
    x1, x2 = jnp.split(x, 2, axis=-1)
    return jnp.concatenate([x1 * cs - x2 * sn, x1 * sn + x2 * cs], axis=-1)


def depthwise_centred_conv(u, w, b):
    pad = (w.shape[0] - 1) // 2
    y = lax.conv_general_dilated(u, w[:, None, :].astype(u.dtype), window_strides=(1,),
                                 padding=[(pad, pad)], dimension_numbers=('NWC', 'WIO', 'NWC'),
                                 feature_group_count=u.shape[-1])
    return jax.nn.silu(y + b.astype(u.dtype))


def diff_attention(q, k, v, lam):
    s = jnp.einsum('bqhmd,bkhmd->bhmqk', q, k).astype(jnp.float32) * (ATT_QK_DIM ** -0.5)
    p = jax.nn.softmax(s, axis=-1)
    a = p[:, :, 0] - lam * p[:, :, 1]
    return jnp.einsum('bhqk,bkhe->bqhe', a.astype(v.dtype), v)


def diff_attention_blocked(q, k, v, lam):
    b, L = q.shape[:2]
    qb = jnp.moveaxis(q.reshape((b, L // Q_BLOCK, Q_BLOCK) + q.shape[2:]), 1, 0)
    o = lax.map(lambda qq: diff_attention(qq, k, v, lam), qb)
    return jnp.moveaxis(o, 0, 1).reshape(b, L, ATT_HEADS, ATT_V_DIM)


def chunked_scan(q, k, v, log_a, s0, want_y):
    b, L, g, n = q.shape
    hg, p = v.shape[-2:]
    nc = L // CHUNK
    qc = q.reshape(b, nc, CHUNK, g, n)
    kc = k.reshape(b, nc, CHUNK, g, n)
    vc = v.reshape(b, nc, CHUNK, g, hg, p)
    cum = jnp.cumsum(log_a.astype(jnp.float32).reshape(b, nc, CHUNK, g, hg), axis=2)
    total = cum[:, :, -1]
    to_end = jnp.exp(total[:, :, None] - cum)
    chunk_states = jnp.einsum('bcjgn,bcjgh,bcjghp->bcghnp', kc, to_end, vc).astype(jnp.float32)

    def step(s, inp):
        st, tot = inp
        return jnp.exp(tot)[..., None, None] * s + st, s

    s_final, s_in = lax.scan(step, s0, (jnp.moveaxis(chunk_states, 1, 0), jnp.moveaxis(total, 1, 0)))
    if not want_y:
        return None, s_final
    s_in = jnp.moveaxis(s_in, 0, 1)
    lower = jnp.tril(jnp.ones((CHUNK, CHUNK), dtype=bool))[:, :, None, None]
    seg = cum[:, :, :, None] - cum[:, :, None]
    decay = jnp.exp(jnp.where(lower, seg, -jnp.inf))
    scores = jnp.einsum('bcign,bcjgn->bcijg', qc, kc)
    y = (jnp.einsum('bcijg,bcijgh,bcjghp->bcighp', scores, decay, vc)
         + jnp.einsum('bcign,bcigh,bcghnp->bcighp', qc, jnp.exp(cum), s_in))
    return y.reshape(b, L, g, hg, p), s_final


def bidirectional_scan(q, k, v_f, v_b, la_f, la_b, s0_f, s0_b, want_y):
    y_f, s_f = chunked_scan(q, k, v_f, la_f, s0_f, want_y)
    fl = lambda a: jnp.flip(a, axis=1)
    y_b, s_b = chunked_scan(fl(q), fl(k), fl(v_b), fl(la_b), s0_b, want_y)
    y = y_f + fl(y_b) if want_y else None
    return y, s_f, s_b


def retention_log_decay(exps):
    return jnp.log1p(-jnp.exp2(-jnp.asarray(exps, dtype=jnp.float32)))


def hybrid_layer(x, ctx, c, c_ctx, w_ada, b_ada, w_in, w_out, attn_q_norm, attn_k_norm,
                 lambda_q1, lambda_k1, lambda_q2, lambda_k2, attn_subln,
                 ssd_conv_w, ssd_conv_b, ssd_dt_bias, ssd_a_log, ssd_d, ssd_norm, ret_norm,
                 lam_init, cos, sin, need_ctx):
    bsz = x.shape[0]
    shift, scale, gate = jnp.split(jax.nn.silu(c) @ w_ada + b_ada, 3, axis=-1)
    shift_c, scale_c, gate_c = jnp.split(jax.nn.silu(c_ctx) @ w_ada + b_ada, 3, axis=-1)
    h = rms_norm(x) * (1 + scale[:, None]) + shift[:, None]
    hc = rms_norm(ctx) * (1 + scale_c) + shift_c
    aq, ak, av, ag, xbc, dtr, z, rq, rk, rv, rg = split_columns(h @ w_in, IN_SPLITS)
    aq_c, ak_c, av_c, ag_c, xbc_c, dtr_c, z_c, rq_c, rk_c, rv_c, rg_c = split_columns(hc @ w_in, IN_SPLITS)

    lam = (jnp.exp(jnp.sum(lambda_q1 * lambda_k1)) - jnp.exp(jnp.sum(lambda_q2 * lambda_k2))
           + lam_init).astype(jnp.float32)

    def attn_heads(t, gain):
        return rms_norm(t.reshape(bsz, t.shape[1], ATT_HEADS, 2, ATT_QK_DIM), gain)

    def attn_out(o, g):
        o = rms_norm(o, attn_subln) * (1.0 - lam_init)
        return o.reshape(bsz, o.shape[1], ATT_WIDTH) * jax.nn.silu(g)

    k_c = attn_heads(ak_c, attn_k_norm)
    v_c = av_c.reshape(bsz, -1, ATT_HEADS, ATT_V_DIM)
    q_l = apply_rope(attn_heads(aq, attn_q_norm), cos, sin)
    k_l = apply_rope(attn_heads(ak, attn_k_norm), cos, sin)
    v_l = av.reshape(bsz, -1, ATT_HEADS, ATT_V_DIM)
    attn_lat = attn_out(diff_attention_blocked(q_l, jnp.concatenate([k_l, k_c], axis=1),
                                               jnp.concatenate([v_l, v_c], axis=1), lam), ag)

    def ssd_prep(xbc_t, dtr_t):
        u = depthwise_centred_conv(xbc_t, ssd_conv_w, ssd_conv_b)
        L = u.shape[1]
        xs, bm, cm = split_columns(u, (SSD_WIDTH, SSD_GROUPS * SSD_STATE, SSD_GROUPS * SSD_STATE))
        xs = xs.reshape(bsz, L, SSD_GROUPS, SSD_HPG, SSD_HEAD_DIM)
        bm = bm.reshape(bsz, L, SSD_GROUPS, SSD_STATE)
        cm = cm.reshape(bsz, L, SSD_GROUPS, SSD_STATE)
        dt = jax.nn.softplus(dtr_t.astype(jnp.float32).reshape(bsz, L, 2, SSD_HEADS) + ssd_dt_bias)
        la = (dt * -jnp.exp(ssd_a_log)).reshape(bsz, L, 2, SSD_GROUPS, SSD_HPG)
        dt = dt.reshape(bsz, L, 2, SSD_GROUPS, SSD_HPG)
        return (xs, bm, cm, xs * dt[:, :, 0, ..., None], xs * dt[:, :, 1, ..., None],
                la[:, :, 0], la[:, :, 1])

    def ssd_out(y, xs, z_t):
        L = y.shape[1]
        y = y + xs * ssd_d.reshape(SSD_GROUPS, SSD_HPG, 1)
        y = y.reshape(bsz, L, SSD_WIDTH) * jax.nn.silu(z_t)
        y = rms_norm(y.reshape(bsz, L, SSD_GROUPS, SSD_WIDTH // SSD_GROUPS)).reshape(bsz, L, SSD_WIDTH)
        return y * ssd_norm

    zero_s = jnp.zeros((bsz, SSD_GROUPS, SSD_HPG, SSD_STATE, SSD_HEAD_DIM), jnp.float32)
    xs_c, bm_c, cm_c, vf_c, vb_c, laf_c, lab_c = ssd_prep(xbc_c, dtr_c)
    ys_c, ssd_sf, ssd_sb = bidirectional_scan(cm_c, bm_c, vf_c, vb_c, laf_c, lab_c, zero_s, zero_s, need_ctx)
    xs_l, bm_l, cm_l, vf_l, vb_l, laf_l, lab_l = ssd_prep(xbc, dtr)
    ys_l, _, _ = bidirectional_scan(cm_l, bm_l, vf_l, vb_l, laf_l, lab_l, ssd_sf, ssd_sb, True)
    ssd_lat = ssd_out(ys_l, xs_l, z)

    ret_la_f = retention_log_decay(RET_DECAY_EXP_FWD)[:, None]
    ret_la_b = retention_log_decay(RET_DECAY_EXP_BWD)[:, None]

    def ret_prep(q_t, k_t, v_t, rope):
        L = q_t.shape[1]
        q = q_t.reshape(bsz, L, RET_HEADS, RET_QK_DIM)
        k = k_t.reshape(bsz, L, RET_HEADS, RET_QK_DIM) * (RET_QK_DIM ** -0.5)
        if rope:
            q, k = apply_rope(q, cos, sin), apply_rope(k, cos, sin)
        v = v_t.reshape(bsz, L, RET_HEADS, 1, RET_V_DIM)
        shp = (bsz, L, RET_HEADS, 1)
        return q, k, v, jnp.broadcast_to(ret_la_f, shp), jnp.broadcast_to(ret_la_b, shp)

    def ret_out(y, g):
        L = y.shape[1]
        y = rms_norm(y.reshape(bsz, L, RET_HEADS, RET_V_DIM), ret_norm).reshape(bsz, L, RET_WIDTH)
        return y * jax.nn.silu(g)

    zero_r = jnp.zeros((bsz, RET_HEADS, 1, RET_QK_DIM, RET_V_DIM), jnp.float32)
    q_rc, k_rc, v_rc, lf_rc, lb_rc = ret_prep(rq_c, rk_c, rv_c, False)
    yr_c, ret_sf, ret_sb = bidirectional_scan(q_rc, k_rc, v_rc, v_rc, lf_rc, lb_rc, zero_r, zero_r, need_ctx)
    q_rl, k_rl, v_rl, lf_rl, lb_rl = ret_prep(rq, rk, rv, True)
    yr_l, _, _ = bidirectional_scan(q_rl, k_rl, v_rl, v_rl, lf_rl, lb_rl, ret_sf, ret_sb, True)
    ret_lat = ret_out(yr_l, rg)

    mix = jnp.concatenate([attn_lat, ssd_lat, ret_lat], axis=-1).astype(x.dtype)
    x_new = x + gate[:, None] * (mix @ w_out)
    if not need_ctx:
        return x_new, None
    attn_ctx = attn_out(diff_attention(attn_heads(aq_c, attn_q_norm), k_c, v_c, lam), ag_c)
    mix_c = jnp.concatenate([attn_ctx, ssd_out(ys_c, xs_c, z_c), ret_out(yr_c, rg_c)], axis=-1).astype(ctx.dtype)
    ctx_new = ctx + gate_c * (mix_c @ w_out)
    return x_new, ctx_new


def setup_inputs(seed: int = 0) -> dict:
    key = jax.random.key(seed)
    ks = jax.random.split(key, 24)
    f32 = jnp.float32

    def nrm(k, shape, s):
        return jax.random.normal(k, shape, f32) * s

    log_lo, log_hi = math.log(1e-3), math.log(1e-1)
    dt = jnp.exp(jax.random.uniform(ks[15], (DEPTH, 2, SSD_HEADS), f32) * (log_hi - log_lo) + log_lo)
    return {
        'x': nrm(ks[0], (BATCH, SEQ, D_MODEL), 1.0),
        'c': nrm(ks[1], (BATCH, D_MODEL), 1.0),
        'ctx': nrm(ks[2], (BATCH, CTX_LEN, D_MODEL), 1.0),
        'c_ctx': nrm(ks[3], (D_MODEL,), 1.0),
        'w_ada': nrm(ks[4], (DEPTH, D_MODEL, 3 * D_MODEL), 0.5 * D_MODEL ** -0.5),
        'b_ada': nrm(ks[5], (DEPTH, 3 * D_MODEL), 0.02),
        'w_in': nrm(ks[6], (DEPTH, D_MODEL, D_IN_PROJ), D_MODEL ** -0.5),
        'w_out': nrm(ks[7], (DEPTH, D_MIX, D_MODEL), D_MIX ** -0.5),
        'attn_q_norm': 1.0 + nrm(ks[8], (DEPTH, ATT_QK_DIM), 0.02),
        'attn_k_norm': 1.0 + nrm(ks[9], (DEPTH, ATT_QK_DIM), 0.02),
        'lambda_q1': nrm(ks[10], (DEPTH, ATT_QK_DIM), 0.1),
        'lambda_k1': nrm(ks[11], (DEPTH, ATT_QK_DIM), 0.1),
        'lambda_q2': nrm(ks[12], (DEPTH, ATT_QK_DIM), 0.1),
        'lambda_k2': nrm(ks[13], (DEPTH, ATT_QK_DIM), 0.1),
        'attn_subln': 1.0 + nrm(ks[14], (DEPTH, ATT_V_DIM), 0.02),
        'ssd_conv_w': nrm(ks[16], (DEPTH, SSD_CONV, SSD_CONV_DIM), SSD_CONV ** -0.5),
        'ssd_conv_b': nrm(ks[17], (DEPTH, SSD_CONV_DIM), 0.02),
        'ssd_dt_bias': dt + jnp.log(-jnp.expm1(-dt)),
        'ssd_a_log': jnp.log(jax.random.uniform(ks[18], (DEPTH, 2, SSD_HEADS), f32, 1.0, 16.0)),
        'ssd_d': 1.0 + nrm(ks[19], (DEPTH, SSD_HEADS), 0.1),
        'ssd_norm': 1.0 + nrm(ks[20], (DEPTH, SSD_WIDTH), 0.02),
        'ret_norm': 1.0 + nrm(ks[21], (DEPTH, RET_V_DIM), 0.02),
    }


def reference(x, c, ctx, c_ctx, w_ada, b_ada, w_in, w_out, attn_q_norm, attn_k_norm,
              lambda_q1, lambda_k1, lambda_q2, lambda_k2, attn_subln,
              ssd_conv_w, ssd_conv_b, ssd_dt_bias, ssd_a_log, ssd_d, ssd_norm, ret_norm):
    n_rows = x.shape[1] // GRID_W
    cos, sin = axial_rope_table(n_rows, ATT_QK_DIM)
    for layer in range(DEPTH):
        lam_init = 0.8 - 0.6 * math.exp(-0.3 * layer)
        x, ctx = hybrid_layer(x, ctx, c, c_ctx, w_ada[layer], b_ada[layer], w_in[layer], w_out[layer],
                              attn_q_norm[layer], attn_k_norm[layer], lambda_q1[layer], lambda_k1[layer],
                              lambda_q2[layer], lambda_k2[layer], attn_subln[layer],
                              ssd_conv_w[layer], ssd_conv_b[layer], ssd_dt_bias[layer], ssd_a_log[layer],
                              ssd_d[layer], ssd_norm[layer], ret_norm[layer],
                              lam_init, cos, sin, layer < DEPTH - 1)
    return x
```

```cpp
#include <hip/hip_runtime.h>
#include <cstdio>
#include <cstdint>

constexpr int DM = 1024, NB = 2, SEQ = 8192, CTXL = 256, DEPTH = 2;
constexpr int ML = NB * SEQ, MC = NB * CTXL, MT = ML + MC;
constexpr int NPROJ = 6176, NPAD = 6400, PITCH = 6208, DMIX = 2048;
constexpr int C_AQ = 0, C_Z = 512, C_RG = 1536, C_AK = 2048, C_AV = 2560, C_AG = 3072, C_XBC = 3584, C_XS = 3584, C_BM = 4608, C_CM = 4864,
              C_RQ = 5120, C_RK = 5376, C_RV = 5632, C_DTR = 6144;
constexpr int C_YS = 2048  , C_YR = 3072  ;
constexpr float EPS = 1e-6f;
constexpr float LOG2E = 1.4426950408889634f;

typedef unsigned short bf16_t;
typedef short bf16x8 __attribute__((ext_vector_type(8)));
typedef float f32x4 __attribute__((ext_vector_type(4)));
typedef unsigned u32x4 __attribute__((ext_vector_type(4)));

constexpr size_t MiB = 1u << 20;
constexpr size_t WS_CTL = 0;
constexpr size_t WS_PROJ = 1 * MiB;
constexpr size_t PROJ_BYTES = (size_t)MT * PITCH * 2;
constexpr size_t WS_H = WS_PROJ + ((PROJ_BYTES + 4095) / 4096) * 4096;
constexpr size_t H_BYTES = (size_t)MT * DM * 2;
constexpr size_t WS_WINT = WS_H + H_BYTES;
constexpr size_t WINT_BYTES = (size_t)NPAD * DM * 2;
constexpr size_t WS_WOUTT = WS_WINT + WINT_BYTES;
constexpr size_t WOUTT_BYTES = (size_t)DM * DMIX * 2;
constexpr size_t WS_CTXN = WS_WOUTT + WOUTT_BYTES;
constexpr size_t CTXN_BYTES = (size_t)MC * DM * 4;
constexpr size_t WS_END = WS_CTXN + CTXN_BYTES;
static_assert(WS_END <= 256 * MiB, "workspace map exceeds 256 MiB");
constexpr int CF_MOD = 1024;
constexpr int CF_LAM = 512, CF_MB = 516;

struct Params {
    const float* in[22];
    float* out;
    unsigned char* ws;
    int layer; int pad;
};

__device__ __forceinline__ float bf2f(bf16_t v) { return __uint_as_float((unsigned)v << 16); }
__device__ __forceinline__ bf16_t f2bf(float f) { unsigned u = __float_as_uint(f); return (bf16_t)((u + 0x7fffu + ((u >> 16) & 1u)) >> 16); }
__device__ __forceinline__ unsigned pk2(float lo, float hi) { return (unsigned)f2bf(lo) | ((unsigned)f2bf(hi) << 16); }
__device__ __forceinline__ float siluf(float x) { return x / (1.f + __expf(-x)); }
__device__ __forceinline__ float wave_sum(float v) {
#pragma unroll
    for (int o = 1; o < 64; o <<= 1) v += __shfl_xor(v, o);
    return v;
}
__device__ __forceinline__ float lam_init_of(int layer) { return 0.8f - 0.6f * __expf(-0.3f * (float)layer); }

struct RowInfo { int b, t, L, isctx; };
__device__ __forceinline__ RowInfo row_info(int r) {
    RowInfo i;
    if (r < ML) { i.b = r >> 13; i.t = r & (SEQ - 1); i.L = SEQ; i.isctx = 0; }
    else { const int rr = r - ML; i.b = rr >> 8; i.t = rr & (CTXL - 1); i.L = CTXL; i.isctx = 1; }
    return i;
}
__device__ __forceinline__ int seq_row0(int b, int isctx) { return isctx ? ML + b * CTXL : b * SEQ; }

__device__ void phase_ada(const Params& p, float* lds, int blk, int nblk) {
    const int tid = threadIdx.x;
    float* ctl = (float*)(p.ws + WS_CTL);
    const float* c = p.in[1]; const float* cc = p.in[3];
    for (int i = tid; i < 3 * DM; i += blockDim.x) {
        const int v = i / DM, k = i % DM;
        const float x = (v < 2) ? c[v * DM + k] : cc[k];
        lds[i] = siluf(x);
    }
    __syncthreads();
    float* red = lds + 3 * DM;
    for (int grp = blk; grp < 256; grp += nblk) {
        const int layer = grp / 128, col0 = (grp % 128) * 24;
        const float* w = p.in[4] + (size_t)layer * DM * 3072;
        const int cl = tid & 31, kg = tid >> 5;
        float a0 = 0.f, a1 = 0.f, a2 = 0.f;
        if (cl < 24) {
            for (int i = 0; i < 64; ++i) {
                const int k = kg * 64 + i;
                const float wv = w[(size_t)k * 3072 + col0 + cl];
                a0 += lds[k] * wv; a1 += lds[DM + k] * wv; a2 += lds[2 * DM + k] * wv;
            }
        }
        red[(kg * 32 + cl) * 3 + 0] = a0; red[(kg * 32 + cl) * 3 + 1] = a1; red[(kg * 32 + cl) * 3 + 2] = a2;
        __syncthreads();
        if (tid < 72) {
            const int v = tid / 24, cc2 = tid % 24;
            float s = 0.f;
            for (int g = 0; g < 16; ++g) s += red[(g * 32 + cc2) * 3 + v];
            s += p.in[5][layer * 3072 + col0 + cc2];
            ctl[CF_MOD + (layer * 3 + v) * 3072 + col0 + cc2] = s;
        }
        __syncthreads();
    }
    if (blk == 0 && tid < 64) {
        for (int layer = 0; layer < DEPTH; ++layer) {
            const float q1 = p.in[10][layer * 64 + tid] * p.in[11][layer * 64 + tid];
            const float q2 = p.in[12][layer * 64 + tid] * p.in[13][layer * 64 + tid];
            const float s1 = wave_sum(q1), s2 = wave_sum(q2);
            float gq = fabsf(p.in[8][layer * 64 + tid]), gk = fabsf(p.in[9][layer * 64 + tid]);
#pragma unroll
            for (int o = 1; o < 64; o <<= 1) { gq = fmaxf(gq, __shfl_xor(gq, o)); gk = fmaxf(gk, __shfl_xor(gk, o)); }
            if (tid == 0) {
                ctl[CF_LAM + layer] = expf(s1) - expf(s2) + lam_init_of(layer);
                ctl[CF_MB + layer] = 8.0f * gq * gk * LOG2E * 1.03f + 0.5f;
            }
        }
    }
}

__device__ __forceinline__ int win_src_col(int n) {
    if (n < 512) return n;
    if (n < 1536) return 3616 + (n - 512);
    if (n < 2048) return 5664 + (n - 1536);
    if (n < 2560) return 512 + (n - 2048);
    if (n < 3072) return 1024 + (n - 2560);
    if (n < 3584) return 1536 + (n - 3072);
    if (n < 5120) return 2048 + (n - 3584);
    if (n < 5376) return 4640 + (n - 5120);
    if (n < 5632) return 4896 + (n - 5376);
    if (n < 6144) return 5152 + (n - 5632);
    if (n < 6176) return 3584 + (n - 6144);
    return -1;
}
__device__ __forceinline__ void transpose_item(const float* W, int K, int N, int srccol, bf16_t* WT, int k0, int n0, float* scr, int lane) {
    if (srccol >= 0) {
#pragma unroll 8
        for (int i = 0; i < 32; ++i) { const int kk = 2 * i + (lane >> 5); scr[kk * 33 + (lane & 31)] = W[(size_t)(k0 + kk) * N + srccol + (lane & 31)]; }
    } else {
#pragma unroll 8
        for (int i = 0; i < 32; ++i) { const int kk = 2 * i + (lane >> 5); scr[kk * 33 + (lane & 31)] = 0.f; }
    }
    __builtin_amdgcn_s_waitcnt(0xC07F); asm volatile("" ::: "memory");
    const int c = lane & 7;
#pragma unroll
    for (int j = 0; j < 4; ++j) {
        const int n = (lane >> 3) + 8 * j; const float* s = scr + (8 * c) * 33 + n;
        u32x4 o; o.x = pk2(s[0 * 33], s[1 * 33]); o.y = pk2(s[2 * 33], s[3 * 33]); o.z = pk2(s[4 * 33], s[5 * 33]); o.w = pk2(s[6 * 33], s[7 * 33]);
        *(u32x4*)(WT + (size_t)(n0 + n) * K + k0 + 8 * c) = o;
    }
    __builtin_amdgcn_s_waitcnt(0xC07F); asm volatile("" ::: "memory");
}
__device__ void phase_convw(const Params& p, int layer, float* lds, int blk, int nblk) {
    const int tid = threadIdx.x, lane = tid & 63, wave = tid >> 6, nw = blockDim.x >> 6;
    float* scr = lds + wave * (64 * 33);
    const int gw = blk * nw + wave, NGW = nblk * nw;
    const float* win = p.in[6] + (size_t)layer * DM * NPROJ;
    const float* wout = p.in[7] + (size_t)layer * DMIX * DM;
    bf16_t* wint = (bf16_t*)(p.ws + WS_WINT); bf16_t* woutt = (bf16_t*)(p.ws + WS_WOUTT);
    constexpr int I_IN = (DM / 64) * (NPAD / 32), I_OUT = (DMIX / 64) * (DM / 32);
    for (int it = gw; it < I_IN + I_OUT; it += NGW) {
        if (it < I_IN) { const int nb = it % (NPAD / 32), kb = it / (NPAD / 32); transpose_item(win, DM, NPROJ, win_src_col(nb * 32), wint, kb * 64, nb * 32, scr, lane); }
        else { const int r = it - I_IN; const int nb = r % (DM / 32), kb = r / (DM / 32); transpose_item(wout, DMIX, DM, nb * 32, woutt, kb * 64, nb * 32, scr, lane); }
    }
}

__device__ void phase_norm(const Params& p, int layer, int blk, int nblk) {
    const int tid = threadIdx.x, lane = tid & 63, wave = tid >> 6, nw = blockDim.x >> 6;
    const float* ctl = (const float*)(p.ws + WS_CTL);
    bf16_t* H = (bf16_t*)(p.ws + WS_H);
    const float* xl = layer == 0 ? p.in[0] : p.out;
    const float* xc = layer == 0 ? p.in[2] : (const float*)(p.ws + WS_CTXN);
    for (int r = blk * nw + wave; r < MT; r += nblk * nw) {
        const RowInfo ri = row_info(r);
        const float* xr = ri.isctx ? xc + (size_t)(r - ML) * DM : xl + (size_t)r * DM;
        const float* mod = ctl + CF_MOD + (layer * 3 + (ri.isctx ? 2 : ri.b)) * 3072;
        f32x4 v[4]; float s = 0.f;
#pragma unroll
        for (int j = 0; j < 4; ++j) { v[j] = *(const f32x4*)(xr + 256 * j + 4 * lane); s += v[j].x * v[j].x + v[j].y * v[j].y + v[j].z * v[j].z + v[j].w * v[j].w; }
        const float rs = rsqrtf(wave_sum(s) * (1.f / DM) + EPS);
#pragma unroll
        for (int j = 0; j < 4; ++j) {
            const int c0 = 256 * j + 4 * lane;
            const f32x4 sh = *(const f32x4*)(mod + c0), sc = *(const f32x4*)(mod + 1024 + c0);
            const float o0 = v[j].x * rs * (1.f + sc.x) + sh.x, o1 = v[j].y * rs * (1.f + sc.y) + sh.y, o2 = v[j].z * rs * (1.f + sc.z) + sh.z, o3 = v[j].w * rs * (1.f + sc.w) + sh.w;
            uint2 o; o.x = pk2(o0, o1); o.y = pk2(o2, o3);
            *(uint2*)(H + (size_t)r * DM + c0) = o;
        }
    }
}

template <int EPI>
__global__ __launch_bounds__(256) void k_gemm_naive(Params p, const bf16_t* A, int lda, const bf16_t* Bt, int K) {
    const int tid = threadIdx.x, lane = tid & 63, wave = tid >> 6, wr = wave >> 1, wc = wave & 1;
    const int row0 = blockIdx.y * 128 + wr * 64, col0 = blockIdx.x * 128 + wc * 64;
    f32x4 acc[4][4];
#pragma unroll
    for (int i = 0; i < 4; ++i)
#pragma unroll
        for (int j = 0; j < 4; ++j) acc[i][j] = (f32x4){0.f, 0.f, 0.f, 0.f};
    const int fr = lane & 15, fq = lane >> 4;
    for (int k0 = 0; k0 < K; k0 += 32) {
        bf16x8 a[4], b[4];
#pragma unroll
        for (int i = 0; i < 4; ++i) a[i] = *(const bf16x8*)(A + (size_t)(row0 + i * 16 + fr) * lda + k0 + fq * 8);
#pragma unroll
        for (int j = 0; j < 4; ++j) b[j] = *(const bf16x8*)(Bt + (size_t)(col0 + j * 16 + fr) * K + k0 + fq * 8);
#pragma unroll
        for (int i = 0; i < 4; ++i)
#pragma unroll
            for (int j = 0; j < 4; ++j) acc[i][j] = __builtin_amdgcn_mfma_f32_16x16x32_bf16(a[i], b[j], acc[i][j], 0, 0, 0);
    }
    const float* ctl = (const float*)(p.ws + WS_CTL);
#pragma unroll
    for (int i = 0; i < 4; ++i)
#pragma unroll
        for (int j = 0; j < 4; ++j)
#pragma unroll
            for (int r = 0; r < 4; ++r) {
                const int row = row0 + i * 16 + fq * 4 + r, col = col0 + j * 16 + fr;
                const float v = acc[i][j][r];
                if (EPI == 0) { if (col < PITCH) ((bf16_t*)(p.ws + WS_PROJ))[(size_t)row * PITCH + col] = f2bf(v); }
                else {
                    const RowInfo ri = row_info(row);
                    const float g = ctl[CF_MOD + (p.layer * 3 + (ri.isctx ? 2 : ri.b)) * 3072 + 2048 + col];
                    if (!ri.isctx) { const float* xin = p.layer == 0 ? p.in[0] : p.out; p.out[(size_t)row * DM + col] = xin[(size_t)row * DM + col] + g * v; }
                    else if (p.layer == 0) { const size_t o = (size_t)(row - ML) * DM + col; ((float*)(p.ws + WS_CTXN))[o] = p.in[2][o] + g * v; }
                }
            }
}

__device__ void phase_prep(const Params& p, int layer, int blk, int nblk) {
    const int tid = threadIdx.x, lane = tid & 63, wave = tid >> 6, nw = blockDim.x >> 6;
    bf16_t* P = (bf16_t*)(p.ws + WS_PROJ);
    const float gq = p.in[8][layer * 64 + lane], gk = p.in[9][layer * 64 + lane];
    const int ai = lane & 31;
    const float invf = exp2f(-(float)(ai & 15) * (13.287712379549449f / 16.f));
    for (int r = blk * nw + wave; r < MT; r += nblk * nw) {
        const RowInfo ri = row_info(r);
        float cs = 1.f, sn = 0.f;
        if (!ri.isctx) { const float pos = (ai < 16) ? (float)(ri.t >> 6) : (float)(ri.t & 63); const float ang = pos * invf; cs = cosf(ang); sn = sinf(ang); }
        bf16_t* row = P + (size_t)r * PITCH;
#pragma unroll
        for (int v = 0; v < 16; ++v) {
            bf16_t* ptr = row + (v < 8 ? C_AQ + v * 64 : C_AK + (v - 8) * 64) + lane;
            float x = bf2f(*ptr);
            const float ss = wave_sum(x * x);
            x = x * rsqrtf(ss * (1.f / 64.f) + EPS) * (v < 8 ? gq : gk);
            const float o = __shfl_xor(x, 32);
            float y = (lane < 32) ? (x * cs - o * sn) : (o * sn + x * cs);
            if (v < 8) y *= 0.125f * LOG2E;
            *ptr = f2bf(y);
        }
#pragma unroll
        for (int v = 0; v < 8; ++v) {
            bf16_t* ptr = row + (v < 4 ? C_RQ + v * 64 : C_RK + (v - 4) * 64) + lane;
            float x = bf2f(*ptr);
            const float o = __shfl_xor(x, 32);
            float y = (lane < 32) ? (x * cs - o * sn) : (o * sn + x * cs);
            if (v >= 4) y *= 0.125f;
            *ptr = f2bf(y);
        }
    }
}

__global__ __launch_bounds__(256) void k_attn_naive(Params p) {
    __shared__ __attribute__((aligned(16))) float sm[8448];
    float* Ks = sm; float* Vs = sm + 32 * 128;
    const int tid = threadIdx.x, q = tid & 127, map = tid >> 7;
    int u = blockIdx.x; int b, h, q0, isctx;
    if (u < 512) { isctx = 0; b = u >> 8; h = (u >> 6) & 3; q0 = (u & 63) * 128; }
    else { u -= 512; isctx = 1; b = u >> 3; h = (u >> 1) & 3; q0 = (u & 1) * 128; }
    const float* ctl = (const float*)(p.ws + WS_CTL);
    const float lam = ctl[CF_LAM + p.layer], mb = ctl[CF_MB + p.layer];
    bf16_t* P = (bf16_t*)(p.ws + WS_PROJ);
    const int qrow = seq_row0(b, isctx) + q0 + q;
    float qv[64];
    {
        const bf16_t* qp = P + (size_t)qrow * PITCH + C_AQ + h * 128 + map * 64;
#pragma unroll
        for (int d = 0; d < 64; d += 8) { const u32x4 w = *(const u32x4*)(qp + d);
            qv[d] = __uint_as_float(w.x << 16); qv[d + 1] = __uint_as_float(w.x & 0xffff0000u); qv[d + 2] = __uint_as_float(w.y << 16); qv[d + 3] = __uint_as_float(w.y & 0xffff0000u);
            qv[d + 4] = __uint_as_float(w.z << 16); qv[d + 5] = __uint_as_float(w.z & 0xffff0000u); qv[d + 6] = __uint_as_float(w.w << 16); qv[d + 7] = __uint_as_float(w.w & 0xffff0000u); }
    }
    float o[128];
#pragma unroll
    for (int e = 0; e < 128; ++e) o[e] = 0.f;
    float l = 0.f;
    const int nkeys = isctx ? CTXL : SEQ + CTXL;
    for (int k0 = 0; k0 < nkeys; k0 += 32) {
        __syncthreads();
#pragma unroll
        for (int i = 0; i < 2; ++i) {
            const int ch = tid + i * 256, kr = ch >> 4, c8 = (ch & 15) * 8;
            const int kk = k0 + kr;
            const int krow = isctx ? (ML + b * CTXL + kk) : (kk < SEQ ? b * SEQ + kk : ML + b * CTXL + (kk - SEQ));
            const u32x4 wk = *(const u32x4*)(P + (size_t)krow * PITCH + C_AK + h * 128 + c8);
            const u32x4 wv = *(const u32x4*)(P + (size_t)krow * PITCH + C_AV + h * 128 + c8);
            float* kd = Ks + kr * 128 + c8; float* vd = Vs + kr * 128 + c8;
            kd[0] = __uint_as_float(wk.x << 16); kd[1] = __uint_as_float(wk.x & 0xffff0000u); kd[2] = __uint_as_float(wk.y << 16); kd[3] = __uint_as_float(wk.y & 0xffff0000u);
            kd[4] = __uint_as_float(wk.z << 16); kd[5] = __uint_as_float(wk.z & 0xffff0000u); kd[6] = __uint_as_float(wk.w << 16); kd[7] = __uint_as_float(wk.w & 0xffff0000u);
            vd[0] = __uint_as_float(wv.x << 16); vd[1] = __uint_as_float(wv.x & 0xffff0000u); vd[2] = __uint_as_float(wv.y << 16); vd[3] = __uint_as_float(wv.y & 0xffff0000u);
            vd[4] = __uint_as_float(wv.z << 16); vd[5] = __uint_as_float(wv.z & 0xffff0000u); vd[6] = __uint_as_float(wv.w << 16); vd[7] = __uint_as_float(wv.w & 0xffff0000u);
        }
        __syncthreads();
        for (int kr = 0; kr < 32; ++kr) {
            const float* kp = Ks + kr * 128 + map * 64;
            float s = 0.f;
#pragma unroll
            for (int d = 0; d < 64; d += 4) { const f32x4 kv = *(const f32x4*)(kp + d); s += qv[d] * kv.x + qv[d + 1] * kv.y + qv[d + 2] * kv.z + qv[d + 3] * kv.w; }
            const float pr = exp2f(s - mb);
            l += pr;
            const float* vp = Vs + kr * 128;
#pragma unroll
            for (int e = 0; e < 128; e += 4) { const f32x4 vv = *(const f32x4*)(vp + e); o[e] += pr * vv.x; o[e + 1] += pr * vv.y; o[e + 2] += pr * vv.z; o[e + 3] += pr * vv.w; }
        }
    }
    const float f = (map == 0) ? 1.f / l : lam / l;
#pragma unroll
    for (int half = 0; half < 2; ++half) {
        __syncthreads();
        if (map == 1) {
#pragma unroll
            for (int e = 0; e < 64; ++e) sm[q * 65 + e] = o[half * 64 + e] * f;
        }
        __syncthreads();
        if (map == 0) {
#pragma unroll
            for (int e = 0; e < 64; ++e) o[half * 64 + e] = o[half * 64 + e] * f - sm[q * 65 + e];
        }
    }
    if (map == 0) {
        float ss = 0.f;
#pragma unroll
        for (int e = 0; e < 128; ++e) ss += o[e] * o[e];
        const float rs = rsqrtf(ss * (1.f / 128.f) + EPS) * (1.f - lam_init_of(p.layer));
        const float* sub = p.in[14] + p.layer * 128;
        const bf16_t* gp = P + (size_t)qrow * PITCH + C_AG + h * 128;
        bf16_t* op = P + (size_t)qrow * PITCH + C_AQ + h * 128;
#pragma unroll
        for (int e = 0; e < 128; e += 2) {
            const unsigned gw = *(const unsigned*)(gp + e);
            const float g0 = __uint_as_float(gw << 16), g1 = __uint_as_float(gw & 0xffff0000u);
            *(unsigned*)(op + e) = pk2(o[e] * rs * sub[e] * siluf(g0), o[e + 1] * rs * sub[e + 1] * siluf(g1));
        }
    }
}

template <int KIND>
__global__ __launch_bounds__(KIND == 0 ? 64 : 128) void k_scan_naive(Params p) {
    constexpr int N = KIND == 0 ? 128 : 64, PD = KIND == 0 ? 64 : 128, TC = 32;
    __shared__ float qs[TC][N], ks[TC][N], vs[TC][PD], as_[TC];
    const int tid = threadIdx.x, layer = p.layer;
    const int nh = KIND == 0 ? 16 : 4;
    const int b = blockIdx.x / nh, head = blockIdx.x % nh, g = head >> 3;
    bf16_t* P = (bf16_t*)(p.ws + WS_PROJ);
    const float* cw = p.in[15] + (size_t)layer * 3 * 1536; const float* cb = p.in[16] + (size_t)layer * 1536;
    const float Dh = KIND == 0 ? p.in[19][layer * 16 + head] : 0.f;
    float S[N];
    for (int dir = 0; dir < 2; ++dir) {
#pragma unroll
        for (int n = 0; n < N; ++n) S[n] = 0.f;
        float dtb = 0.f, aexp = 0.f, lar = 0.f;
        if (KIND == 0) { dtb = p.in[17][(layer * 2 + dir) * 16 + head]; aexp = expf(p.in[18][(layer * 2 + dir) * 16 + head]); }
        else { const float e = (dir == 0 ? 5.0f : 5.5f) + (float)head; lar = log1pf(-exp2f(-e)); }
        for (int seg = 0; seg < 2; ++seg) {
            const int isctx = seg == 0, L = isctx ? CTXL : SEQ, r0 = seq_row0(b, isctx);
            for (int c0 = 0; c0 < L; c0 += TC) {
                const int tbase = dir == 0 ? c0 : L - TC - c0;
                __syncthreads();
                if (KIND == 0) {
                    for (int i = tid; i < TC * 320; i += blockDim.x) {
                        const int tt = i / 320, cc = i % 320;
                        const int col = cc < 64 ? head * 64 + cc : (cc < 192 ? 1024 + g * 128 + (cc - 64) : 1280 + g * 128 + (cc - 192));
                        const int t = tbase + tt;
                        float acc = cb[col];
#pragma unroll
                        for (int k = 0; k < 3; ++k) { const int ts = t + k - 1; if (ts >= 0 && ts < L) acc += cw[k * 1536 + col] * bf2f(P[(size_t)(r0 + ts) * PITCH + C_XBC + col]); }
                        const float uu = siluf(acc);
                        if (cc < 64) vs[tt][cc] = uu; else if (cc < 192) ks[tt][cc - 64] = uu; else qs[tt][cc - 192] = uu;
                    }
                    if (tid < TC) {
                        const float dtr = bf2f(P[(size_t)(r0 + tbase + tid) * PITCH + C_DTR + dir * 16 + head]) + dtb;
                        const float dt = dtr > 20.f ? dtr : log1pf(expf(dtr));
                        as_[tid] = dt;
                    }
                } else {
                    for (int i = tid; i < TC * 256; i += blockDim.x) {
                        const int tt = i / 256, cc = i % 256; const size_t rr = (size_t)(r0 + tbase + tt) * PITCH;
                        if (cc < 64) qs[tt][cc] = bf2f(P[rr + C_RQ + head * 64 + cc]);
                        else if (cc < 128) ks[tt][cc - 64] = bf2f(P[rr + C_RK + head * 64 + cc - 64]);
                        else vs[tt][cc - 128] = bf2f(P[rr + C_RV + head * 128 + cc - 128]);
                    }
                }
                __syncthreads();
                for (int s = 0; s < TC; ++s) {
                    const int tt = dir == 0 ? s : TC - 1 - s;
                    float a, v;
                    if (KIND == 0) { const float dt = as_[tt]; a = expf(-dt * aexp); v = vs[tt][tid] * dt; }
                    else { a = expf(lar); v = vs[tt][tid]; }
                    float y = 0.f;
#pragma unroll
                    for (int n = 0; n < N; ++n) { S[n] = a * S[n] + ks[tt][n] * v; y += qs[tt][n] * S[n]; }
                    bf16_t* yp = P + (size_t)(r0 + tbase + tt) * PITCH + (KIND == 0 ? C_YS + head * 64 : C_YR + head * 128) + tid;
                    if (dir == 0) *yp = f2bf(y);
                    else { float tot = bf2f(*yp) + y; if (KIND == 0) tot += Dh * vs[tt][tid]; *yp = f2bf(tot); }
                }
            }
        }
    }
}

__device__ void phase_fin(const Params& p, int layer, int blk, int nblk) {
    const int tid = threadIdx.x, lane = tid & 63, wave = tid >> 6, nw = blockDim.x >> 6;
    bf16_t* P = (bf16_t*)(p.ws + WS_PROJ);
    const float* snorm = p.in[20] + layer * 1024; const float* rnorm = p.in[21] + layer * 128;
    for (int r = blk * nw + wave; r < MT; r += nblk * nw) {
        bf16_t* row = P + (size_t)r * PITCH;
#pragma unroll
        for (int g = 0; g < 2; ++g) {
            const int c0 = g * 512 + lane * 8;
            float v[8]; float ss = 0.f;
#pragma unroll
            for (int j = 0; j < 8; ++j) { v[j] = bf2f(row[C_YS + c0 + j]) * siluf(bf2f(row[C_Z + c0 + j])); ss += v[j] * v[j]; }
            const float rs = rsqrtf(wave_sum(ss) * (1.f / 512.f) + EPS);
#pragma unroll
            for (int j = 0; j < 8; ++j) row[C_Z + c0 + j] = f2bf(v[j] * rs * snorm[c0 + j]);
        }
        {
            const int c0 = lane * 8;
            float v[8]; float ss = 0.f;
#pragma unroll
            for (int j = 0; j < 8; ++j) { v[j] = bf2f(row[C_YR + c0 + j]); ss += v[j] * v[j]; }
#pragma unroll
            for (int o = 1; o < 16; o <<= 1) ss += __shfl_xor(ss, o);
            const float rs = rsqrtf(ss * (1.f / 128.f) + EPS);
#pragma unroll
            for (int j = 0; j < 8; ++j) row[C_RG + c0 + j] = f2bf(v[j] * rs * rnorm[(c0 + j) & 127] * siluf(bf2f(row[C_RG + c0 + j])));
        }
    }
}

constexpr int CONV_LDS_BYTES = 8 * 64 * 33 * 4;
__global__ __launch_bounds__(512) void k_init(Params p) {
    extern __shared__ __attribute__((aligned(16))) float lds[];
    phase_ada(p, lds, blockIdx.x, gridDim.x);
    __syncthreads();
    phase_convw(p, 0, lds, blockIdx.x, gridDim.x);
}
__global__ __launch_bounds__(512) void k_norm(Params p) {
    extern __shared__ __attribute__((aligned(16))) float lds[];
    if (p.layer > 0) phase_convw(p, p.layer, lds, blockIdx.x, gridDim.x);
    phase_norm(p, p.layer, blockIdx.x, gridDim.x);
}
__global__ __launch_bounds__(512) void k_prep(Params p) { phase_prep(p, p.layer, blockIdx.x, gridDim.x); }
__global__ __launch_bounds__(512) void k_fin(Params p) { phase_fin(p, p.layer, blockIdx.x, gridDim.x); }

extern "C" void kernel_launch(void* const* d_in, const int* in_sizes, int n_in, void* d_out, int out_size, void* d_ws, size_t ws_size, hipStream_t stream) {
    if (n_in != 22 || ws_size < WS_END || out_size != ML * DM) { fprintf(stderr, "kernel_launch: unexpected shapes (n_in %d, ws %zu, out %d)\n", n_in, ws_size, out_size); return; }
    Params p{};
    for (int i = 0; i < 22; ++i) p.in[i] = (const float*)d_in[i];
    p.out = (float*)d_out; p.ws = (unsigned char*)d_ws; p.layer = 0; p.pad = 0;
    const bf16_t* H = (const bf16_t*)((unsigned char*)d_ws + WS_H);
    const bf16_t* WINT = (const bf16_t*)((unsigned char*)d_ws + WS_WINT);
    const bf16_t* WOUTT = (const bf16_t*)((unsigned char*)d_ws + WS_WOUTT);
    const bf16_t* PROJ = (const bf16_t*)((unsigned char*)d_ws + WS_PROJ);
    static int attr_done = 0;
    if (!attr_done) {
        (void)hipFuncSetAttribute((const void*)k_init, hipFuncAttributeMaxDynamicSharedMemorySize, CONV_LDS_BYTES);
        (void)hipFuncSetAttribute((const void*)k_norm, hipFuncAttributeMaxDynamicSharedMemorySize, CONV_LDS_BYTES);
        attr_done = 1;
    }
    hipLaunchKernelGGL(k_init, dim3(256), dim3(512), CONV_LDS_BYTES, stream, p);
    for (int layer = 0; layer < DEPTH; ++layer) {
        p.layer = layer;
        hipLaunchKernelGGL(k_norm, dim3(256), dim3(512), CONV_LDS_BYTES, stream, p);
        hipLaunchKernelGGL(k_gemm_naive<0>, dim3(NPAD / 128, MT / 128), dim3(256), 0, stream, p, H, DM, WINT, DM);
        hipLaunchKernelGGL(k_prep, dim3(256), dim3(512), 0, stream, p);
        hipLaunchKernelGGL(k_attn_naive, dim3(layer == 0 ? 528 : 512), dim3(256), 0, stream, p);
        hipLaunchKernelGGL(k_scan_naive<0>, dim3(NB * 16), dim3(64), 0, stream, p);
        hipLaunchKernelGGL(k_scan_naive<1>, dim3(NB * 4), dim3(128), 0, stream, p);
        hipLaunchKernelGGL(k_fin, dim3(256), dim3(512), 0, stream, p);
        hipLaunchKernelGGL(k_gemm_naive<1>, dim3(DM / 128, MT / 128), dim3(256), 0, stream, p, PROJ, PITCH, WOUTT, DMIX);
    }
}
```

```cpp
#include <hip/hip_runtime.h>
#include <cstdio>
#include <cstdint>

constexpr int DM = 1024, NB = 2, SEQ = 8192, CTXL = 256, DEPTH = 2;
constexpr int ML = NB * SEQ, MC = NB * CTXL, MT = ML + MC;
constexpr int NPROJ = 6176, NPAD = 6400, PITCH = 6208, DMIX = 2048;
constexpr int C_AQ = 0, C_Z = 512, C_RG = 1536, C_AK = 2048, C_AV = 2560, C_AG = 3072, C_XBC = 3584, C_XS = 3584, C_BM = 4608, C_CM = 4864,
              C_RQ = 5120, C_RK = 5376, C_RV = 5632, C_DTR = 6144;
constexpr int C_YS = 2048  , C_YR = 3072  ;
constexpr float EPS = 1e-6f;
constexpr float LOG2E = 1.4426950408889634f;

typedef unsigned short bf16_t;
typedef short bf16x8 __attribute__((ext_vector_type(8)));
typedef float f32x4 __attribute__((ext_vector_type(4)));
typedef unsigned u32x4 __attribute__((ext_vector_type(4)));
typedef float f32x16 __attribute__((ext_vector_type(16)));
typedef short s16x4 __attribute__((ext_vector_type(4)));
#define LAS __attribute__((address_space(3)))
constexpr int LDS_BYTES = 147456;

constexpr size_t MiB = 1u << 20;
constexpr size_t WS_CTL = 0;
constexpr size_t WS_PROJ = 1 * MiB;
constexpr size_t PROJ_BYTES = (size_t)MT * PITCH * 2;
constexpr size_t WS_H = WS_PROJ + ((PROJ_BYTES + 4095) / 4096) * 4096;
constexpr size_t H_BYTES = (size_t)MT * DM * 2;
constexpr size_t WS_WINT = WS_H + H_BYTES;
constexpr size_t WINT_BYTES = (size_t)NPAD * DM * 2;
constexpr size_t WS_WOUTT = WS_WINT + WINT_BYTES;
constexpr size_t WOUTT_BYTES = (size_t)DM * DMIX * 2;
constexpr size_t WS_CTXN = WS_WOUTT + WOUTT_BYTES;
constexpr size_t CTXN_BYTES = (size_t)MC * DM * 4;
constexpr size_t WS_END = WS_CTXN + CTXN_BYTES;
static_assert(WS_END <= 256 * MiB, "workspace map exceeds 256 MiB");
constexpr int CF_MOD = 1024;
constexpr int CF_LAM = 512, CF_MB = 516;

struct Params {
    const float* in[22];
    float* out;
    unsigned char* ws;
    int layer; int pad;
};

__device__ __forceinline__ float bf2f(bf16_t v) { return __uint_as_float((unsigned)v << 16); }
__device__ __forceinline__ bf16_t f2bf(float f) { unsigned u = __float_as_uint(f); return (bf16_t)((u + 0x7fffu + ((u >> 16) & 1u)) >> 16); }
__device__ __forceinline__ unsigned pk2(float lo, float hi) { return (unsigned)f2bf(lo) | ((unsigned)f2bf(hi) << 16); }
__device__ __forceinline__ float siluf(float x) { return x / (1.f + __expf(-x)); }
__device__ __forceinline__ float wave_sum(float v) {
#pragma unroll
    for (int o = 1; o < 64; o <<= 1) v += __shfl_xor(v, o);
    return v;
}
__device__ __forceinline__ float lam_init_of(int layer) { return 0.8f - 0.6f * __expf(-0.3f * (float)layer); }

struct RowInfo { int b, t, L, isctx; };
__device__ __forceinline__ RowInfo row_info(int r) {
    RowInfo i;
    if (r < ML) { i.b = r >> 13; i.t = r & (SEQ - 1); i.L = SEQ; i.isctx = 0; }
    else { const int rr = r - ML; i.b = rr >> 8; i.t = rr & (CTXL - 1); i.L = CTXL; i.isctx = 1; }
    return i;
}
__device__ __forceinline__ int seq_row0(int b, int isctx) { return isctx ? ML + b * CTXL : b * SEQ; }

__device__ void phase_ada(const Params& p, float* lds, int blk, int nblk) {
    const int tid = threadIdx.x;
    float* ctl = (float*)(p.ws + WS_CTL);
    const float* c = p.in[1]; const float* cc = p.in[3];
    for (int i = tid; i < 3 * DM; i += blockDim.x) {
        const int v = i / DM, k = i % DM;
        const float x = (v < 2) ? c[v * DM + k] : cc[k];
        lds[i] = siluf(x);
    }
    __syncthreads();
    float* red = lds + 3 * DM;
    for (int grp = blk; grp < 256; grp += nblk) {
        const int layer = grp / 128, col0 = (grp % 128) * 24;
        const float* w = p.in[4] + (size_t)layer * DM * 3072;
        const int cl = tid & 31, kg = tid >> 5;
        float a0 = 0.f, a1 = 0.f, a2 = 0.f;
        if (cl < 24) {
            for (int i = 0; i < 64; ++i) {
                const int k = kg * 64 + i;
                const float wv = w[(size_t)k * 3072 + col0 + cl];
                a0 += lds[k] * wv; a1 += lds[DM + k] * wv; a2 += lds[2 * DM + k] * wv;
            }
        }
        red[(kg * 32 + cl) * 3 + 0] = a0; red[(kg * 32 + cl) * 3 + 1] = a1; red[(kg * 32 + cl) * 3 + 2] = a2;
        __syncthreads();
        if (tid < 72) {
            const int v = tid / 24, cc2 = tid % 24;
            float s = 0.f;
            for (int g = 0; g < 16; ++g) s += red[(g * 32 + cc2) * 3 + v];
            s += p.in[5][layer * 3072 + col0 + cc2];
            ctl[CF_MOD + (layer * 3 + v) * 3072 + col0 + cc2] = s;
        }
        __syncthreads();
    }
    if (blk == 0 && tid < 64) {
        for (int layer = 0; layer < DEPTH; ++layer) {
            const float q1 = p.in[10][layer * 64 + tid] * p.in[11][layer * 64 + tid];
            const float q2 = p.in[12][layer * 64 + tid] * p.in[13][layer * 64 + tid];
            const float s1 = wave_sum(q1), s2 = wave_sum(q2);
            float gq = fabsf(p.in[8][layer * 64 + tid]), gk = fabsf(p.in[9][layer * 64 + tid]);
#pragma unroll
            for (int o = 1; o < 64; o <<= 1) { gq = fmaxf(gq, __shfl_xor(gq, o)); gk = fmaxf(gk, __shfl_xor(gk, o)); }
            if (tid == 0) {
                ctl[CF_LAM + layer] = expf(s1) - expf(s2) + lam_init_of(layer);
                ctl[CF_MB + layer] = 8.0f * gq * gk * LOG2E * 1.03f + 0.5f;
            }
        }
    }
}

__device__ __forceinline__ int win_src_col(int n) {
    if (n < 512) return n;
    if (n < 1536) return 3616 + (n - 512);
    if (n < 2048) return 5664 + (n - 1536);
    if (n < 2560) return 512 + (n - 2048);
    if (n < 3072) return 1024 + (n - 2560);
    if (n < 3584) return 1536 + (n - 3072);
    if (n < 5120) return 2048 + (n - 3584);
    if (n < 5376) return 4640 + (n - 5120);
    if (n < 5632) return 4896 + (n - 5376);
    if (n < 6144) return 5152 + (n - 5632);
    if (n < 6176) return 3584 + (n - 6144);
    return -1;
}
__device__ __forceinline__ void transpose_item(const float* W, int K, int N, int srccol, bf16_t* WT, int k0, int n0, float* scr, int lane) {
    if (srccol >= 0) {
#pragma unroll 8
        for (int i = 0; i < 32; ++i) { const int kk = 2 * i + (lane >> 5); scr[kk * 33 + (lane & 31)] = W[(size_t)(k0 + kk) * N + srccol + (lane & 31)]; }
    } else {
#pragma unroll 8
        for (int i = 0; i < 32; ++i) { const int kk = 2 * i + (lane >> 5); scr[kk * 33 + (lane & 31)] = 0.f; }
    }
    __builtin_amdgcn_s_waitcnt(0xC07F); asm volatile("" ::: "memory");
    const int c = lane & 7;
#pragma unroll
    for (int j = 0; j < 4; ++j) {
        const int n = (lane >> 3) + 8 * j; const float* s = scr + (8 * c) * 33 + n;
        u32x4 o; o.x = pk2(s[0 * 33], s[1 * 33]); o.y = pk2(s[2 * 33], s[3 * 33]); o.z = pk2(s[4 * 33], s[5 * 33]); o.w = pk2(s[6 * 33], s[7 * 33]);
        *(u32x4*)(WT + (size_t)(n0 + n) * K + k0 + 8 * c) = o;
    }
    __builtin_amdgcn_s_waitcnt(0xC07F); asm volatile("" ::: "memory");
}
__device__ void phase_convw(const Params& p, int layer, float* lds, int blk, int nblk) {
    const int tid = threadIdx.x, lane = tid & 63, wave = tid >> 6, nw = blockDim.x >> 6;
    float* scr = lds + wave * (64 * 33);
    const int gw = blk * nw + wave, NGW = nblk * nw;
    const float* win = p.in[6] + (size_t)layer * DM * NPROJ;
    const float* wout = p.in[7] + (size_t)layer * DMIX * DM;
    bf16_t* wint = (bf16_t*)(p.ws + WS_WINT); bf16_t* woutt = (bf16_t*)(p.ws + WS_WOUTT);
    constexpr int I_IN = (DM / 64) * (NPAD / 32), I_OUT = (DMIX / 64) * (DM / 32);
    for (int it = gw; it < I_IN + I_OUT; it += NGW) {
        if (it < I_IN) { const int nb = it % (NPAD / 32), kb = it / (NPAD / 32); transpose_item(win, DM, NPROJ, win_src_col(nb * 32), wint, kb * 64, nb * 32, scr, lane); }
        else { const int r = it - I_IN; const int nb = r % (DM / 32), kb = r / (DM / 32); transpose_item(wout, DMIX, DM, nb * 32, woutt, kb * 64, nb * 32, scr, lane); }
    }
}

__device__ void phase_norm(const Params& p, int layer, int blk, int nblk) {
    const int tid = threadIdx.x, lane = tid & 63, wave = tid >> 6, nw = blockDim.x >> 6;
    const float* ctl = (const float*)(p.ws + WS_CTL);
    bf16_t* H = (bf16_t*)(p.ws + WS_H);
    const float* xl = layer == 0 ? p.in[0] : p.out;
    const float* xc = layer == 0 ? p.in[2] : (const float*)(p.ws + WS_CTXN);
    for (int r = blk * nw + wave; r < MT; r += nblk * nw) {
        const RowInfo ri = row_info(r);
        const float* xr = ri.isctx ? xc + (size_t)(r - ML) * DM : xl + (size_t)r * DM;
        const float* mod = ctl + CF_MOD + (layer * 3 + (ri.isctx ? 2 : ri.b)) * 3072;
        f32x4 v[4]; float s = 0.f;
#pragma unroll
        for (int j = 0; j < 4; ++j) { v[j] = *(const f32x4*)(xr + 256 * j + 4 * lane); s += v[j].x * v[j].x + v[j].y * v[j].y + v[j].z * v[j].z + v[j].w * v[j].w; }
        const float rs = rsqrtf(wave_sum(s) * (1.f / DM) + EPS);
#pragma unroll
        for (int j = 0; j < 4; ++j) {
            const int c0 = 256 * j + 4 * lane;
            const f32x4 sh = *(const f32x4*)(mod + c0), sc = *(const f32x4*)(mod + 1024 + c0);
            const float o0 = v[j].x * rs * (1.f + sc.x) + sh.x, o1 = v[j].y * rs * (1.f + sc.y) + sh.y, o2 = v[j].z * rs * (1.f + sc.z) + sh.z, o3 = v[j].w * rs * (1.f + sc.w) + sh.w;
            uint2 o; o.x = pk2(o0, o1); o.y = pk2(o2, o3);
            *(uint2*)(H + (size_t)r * DM + c0) = o;
        }
    }
}


namespace pg8 {
#define PG8_LAS __attribute__((address_space(3)))
constexpr int BM = 256, BK = 64, HALF = 128, HTB = HALF * BK * 2, STAGE_BYTES = 8 * HTB, NXCD = 8, WGM = 8;
__host__ __device__ __forceinline__ int lds_byte(int r, int c) { const int st = (r >> 4) * 2 + (c >> 5), rr = r & 15, cc = c & 31, ob = rr * 64 + cc * 2; return st * 1024 + (ob ^ (((ob >> 9) & 1) << 5)); }
__host__ __device__ __forceinline__ void stage_rc(int b, int& R, int& C) { const int st = b / 1024, sb = b % 1024, swz = sb ^ (((sb >> 9) & 1) << 5); R = (st >> 1) * 16 + swz / 64; C = (st & 1) * 32 + (swz % 64) / 2; }
__host__ __device__ __forceinline__ int perm32(int rho) { const int n = rho >> 4, i = rho & 15; return 8 * (i >> 2) + 4 * n + (i & 3); }
struct Unit { int pm, pn; };
struct Gemm { const bf16_t* A; const bf16_t* Bt; int M, N, K, lda; };
struct StaticOrder {
    int nM, nN, nwg, G, c;
    __host__ __device__ void init(int M, int N, int G_, int c_) { nM = M / BM; nN = N / BM; nwg = nM * nN; G = G_; c = c_; }
    __host__ __device__ bool next(int i, Unit& u) const {
        const long L = (long)i * G + c; if (L >= nwg) return false;
        int wgid = (int)L; { const int q = nwg / NXCD, r = nwg % NXCD, xcd = wgid % NXCD, off = wgid / NXCD; wgid = (xcd < r ? xcd * (q + 1) : r * (q + 1) + (xcd - r) * q) + off; }
        const int nig = WGM * nN, gid = wgid / nig, fm = gid * WGM, gsz = (nM - fm) < WGM ? (nM - fm) : WGM;
        u.pm = fm + ((wgid % nig) % gsz); u.pn = (wgid % nig) / gsz; return true;
    }
    __device__ __forceinline__ void a_ready(const Unit&) const {}
    __device__ __forceinline__ void done(const Unit&) const {}
};
__device__ __forceinline__ unsigned cvt_pk_bf16(float lo, float hi) { unsigned r; asm volatile("v_cvt_pk_bf16_f32 %0, %1, %2" : "=v"(r) : "v"(lo), "v"(hi)); return r; }
struct EpiProj {
    static constexpr bool PERM = true, AFTER_DRAIN = false;
    bf16_t* O;
    __device__ __forceinline__ void operator()(const f32x4 (&acc)[2][2][4][2], const Unit& u, int wr, int wc, int fr, int fq) const {
        const int row0 = u.pm * BM + wr * 64 + fr, col0 = u.pn * BM + wc * 32 + 8 * fq;
#pragma unroll
        for (int ai = 0; ai < 2; ++ai)
#pragma unroll
            for (int m = 0; m < 4; ++m) { bf16_t* rowp = O + (size_t)(row0 + ai * HALF + m * 16) * PITCH + col0;
#pragma unroll
                for (int bj = 0; bj < 2; ++bj) { const f32x4 v0 = acc[ai][bj][m][0], v1 = acc[ai][bj][m][1];
                    u32x4 w; w.x = cvt_pk_bf16(v0[0], v0[1]); w.y = cvt_pk_bf16(v0[2], v0[3]); w.z = cvt_pk_bf16(v1[0], v1[1]); w.w = cvt_pk_bf16(v1[2], v1[3]);
                    if (col0 + bj * HALF + 8 <= PITCH) *(u32x4*)(rowp + bj * HALF) = w; } }
    }
};
struct EpiResid {
    static constexpr bool PERM = false, AFTER_DRAIN = false;
    const float* xlat; float* olat; const float* xctx; float* octx; const float* mod;
    __device__ __forceinline__ void operator()(const f32x4 (&acc)[2][2][4][2], const Unit& u, int wr, int wc, int fr, int fq) const {
        const bool isctx = u.pm >= 64;
        const float* xb = isctx ? xctx : xlat; float* ob = isctx ? octx : olat;
        const int prow = (isctx ? u.pm - 64 : u.pm) * BM + wr * 64 + fr;
        const float* gv = mod + (isctx ? 2 : (u.pm >> 5)) * 3072 + 2048;
        const int col0 = u.pn * BM + wc * 32 + 4 * fq;
#pragma unroll
        for (int bj = 0; bj < 2; ++bj)
#pragma unroll
            for (int n = 0; n < 2; ++n) { const int col = col0 + bj * HALF + n * 16; const f32x4 g = *(const f32x4*)(gv + col);
#pragma unroll
                for (int ai = 0; ai < 2; ++ai)
#pragma unroll
                    for (int m = 0; m < 4; ++m) { const size_t off = (size_t)(prow + ai * HALF + m * 16) * DM + col;
                        const f32x4 xin = *(const f32x4*)(xb + off); *(f32x4*)(ob + off) = xin + g * acc[ai][bj][m][n]; } }
    }
};
template <class Epi, class Sched, bool ALIGN_EPI = false, bool SP2 = false>
__device__ __forceinline__ void gemm_phase(PG8_LAS unsigned char* lds, const Gemm g, const Sched& S, const Epi& E) {
    const int tid = threadIdx.x, wid = __builtin_amdgcn_readfirstlane(tid >> 6), lane = tid & 63, wr = wid >> 2, wc = wid & 3, fr = lane & 15, fq = lane >> 4;
    const int K = g.K, lda = g.lda, nt = K / BK;
    unsigned voffA[2], voffB[2];
#pragma unroll
    for (int i = 0; i < 2; ++i) { int R, C; stage_rc(tid * 16 + i * 8192, R, C); const int Rb = Epi::PERM ? ((R & ~31) + perm32(R & 31)) : R;
        voffA[i] = (unsigned)(R * lda + C) * 2u; voffB[i] = (unsigned)(Rb * K + C) * 2u; }
    const size_t kstep = (size_t)(BK * 2);
    const size_t hstepA = (size_t)HALF * lda * 2, hstepB = (size_t)HALF * K * 2;
    const size_t tstepA = 2 * hstepA, tstepB = 2 * hstepB;
    const unsigned ldsw = (unsigned)wid * 1024u;
    const int aoff = lds_byte(wr * 64 + fr, fq * 8), boff = lds_byte(wc * 32 + fr, fq * 8);
#define PG8_SA(b, h) (((b) * 2 + (h)) * HTB)
#define PG8_SB(b, h) ((4 + (b) * 2 + (h)) * HTB)
#define PG8_STAGE(bufoff, gbase, voff) do { _Pragma("unroll") for (int _i = 0; _i < 2; ++_i) \
        __builtin_amdgcn_global_load_lds((const unsigned*)((const char*)(gbase) + (voff)[_i]), (PG8_LAS unsigned*)(lds + (bufoff) + ldsw + _i * 8192), 16, 0, 0); } while (0)
#define PG8_LDA(dst, b, h) do { _Pragma("unroll") for (int m = 0; m < 4; ++m) _Pragma("unroll") for (int k = 0; k < 2; ++k) dst[m][k] = *(const PG8_LAS bf16x8*)(lds + PG8_SA(b, h) + aoff + m * 2048 + k * 1024); } while (0)
#define PG8_LDB(dst, b, h) do { _Pragma("unroll") for (int n = 0; n < 2; ++n) _Pragma("unroll") for (int k = 0; k < 2; ++k) dst[n][k] = *(const PG8_LAS bf16x8*)(lds + PG8_SB(b, h) + boff + n * 2048 + k * 1024); } while (0)
#define PG8_MMA(ai, bj, At, Bt) do { __builtin_amdgcn_s_setprio(1); _Pragma("unroll") for (int m = 0; m < 4; ++m) _Pragma("unroll") for (int n = 0; n < 2; ++n) _Pragma("unroll") for (int k = 0; k < 2; ++k) \
        acc[ai][bj][m][n] = __builtin_amdgcn_mfma_f32_16x16x32_bf16(Bt[n][k], At[m][k], acc[ai][bj][m][n], 0, 0, 0); __builtin_amdgcn_s_setprio(0); } while (0)
#define PG8_WAIT_V(n) asm volatile("s_waitcnt vmcnt(" #n ")" ::: "memory")
#define PG8_WAIT_L(n) asm volatile("s_waitcnt lgkmcnt(" #n ")" ::: "memory")
#define PG8_BAR __builtin_amdgcn_s_barrier()
#define PG8_SCHED __builtin_amdgcn_sched_barrier(0)
    Unit cur, nxt; int ui = 0;
    if (!S.next(0, cur)) return;
    f32x4 acc[2][2][4][2];
#pragma unroll
    for (int a = 0; a < 2; ++a)
#pragma unroll
        for (int b = 0; b < 2; ++b)
#pragma unroll
            for (int m = 0; m < 4; ++m)
#pragma unroll
                for (int n = 0; n < 2; ++n) acc[a][b][m][n] = (f32x4){0.f, 0.f, 0.f, 0.f};
    bf16x8 At[4][2], B0[2][2], B1[2][2];
    const char* cA = (const char*)g.A + (size_t)cur.pm * tstepA; const char* cB = (const char*)g.Bt + (size_t)cur.pn * tstepB;
    S.a_ready(cur);
    if constexpr (SP2) {
        PG8_STAGE(PG8_SB(0, 0), cB, voffB); PG8_STAGE(PG8_SB(0, 1), cB + hstepB, voffB); PG8_STAGE(PG8_SA(0, 0), cA, voffA); PG8_STAGE(PG8_SA(0, 1), cA + hstepA, voffA);
        if (wr == 1) PG8_BAR;
        PG8_WAIT_V(2); PG8_BAR;
        PG8_STAGE(PG8_SB(1, 0), cB + kstep, voffB); PG8_STAGE(PG8_SA(1, 0), cA + kstep, voffA); PG8_STAGE(PG8_SB(1, 1), cB + hstepB + kstep, voffB);
        PG8_WAIT_V(6); PG8_BAR;
    } else {
        PG8_STAGE(PG8_SB(0, 0), cB, voffB); PG8_STAGE(PG8_SA(0, 0), cA, voffA); PG8_STAGE(PG8_SB(0, 1), cB + hstepB, voffB); PG8_STAGE(PG8_SA(0, 1), cA + hstepA, voffA);
        if (wr == 1) PG8_BAR;
        PG8_WAIT_V(4); PG8_BAR;
        PG8_STAGE(PG8_SB(1, 0), cB + kstep, voffB); PG8_STAGE(PG8_SA(1, 0), cA + kstep, voffA); PG8_STAGE(PG8_SB(1, 1), cB + hstepB + kstep, voffB);
        PG8_WAIT_V(6); PG8_BAR;
    }
    for (;;) {
        const bool has_next = S.next(ui + 1, nxt);
        const char* nA = has_next ? (const char*)g.A + (size_t)nxt.pm * tstepA : cA; const char* nB = has_next ? (const char*)g.Bt + (size_t)nxt.pn * tstepB : cB;
        for (int t = 0; t < nt; t += 2) {
            const bool last = (t == nt - 2);
            const char* a1 = cA + (size_t)(t + 1) * kstep;
            const char* a2 = last ? nA : cA + (size_t)(t + 2) * kstep; const char* b2 = last ? nB : cB + (size_t)(t + 2) * kstep;
            const char* a3 = a2 + kstep; const char* b3 = b2 + kstep;
            if (last && has_next) S.a_ready(nxt);
            if constexpr (SP2) {
            PG8_LDB(B0, 0, 0); PG8_LDB(B1, 0, 1); PG8_SCHED; PG8_LDA(At, 0, 0); PG8_STAGE(PG8_SA(1, 1), a1 + hstepA, voffA);
            PG8_WAIT_V(8); PG8_WAIT_L(0); PG8_BAR; PG8_MMA(0, 0, At, B0); PG8_MMA(0, 1, At, B1); PG8_BAR; PG8_SCHED;
            PG8_LDA(At, 0, 1); PG8_STAGE(PG8_SB(0, 0), b2, voffB); PG8_STAGE(PG8_SB(0, 1), b2 + hstepB, voffB); PG8_STAGE(PG8_SA(0, 0), a2, voffA);
            PG8_WAIT_V(8); PG8_WAIT_L(0); PG8_BAR; PG8_MMA(1, 0, At, B0); PG8_MMA(1, 1, At, B1); PG8_BAR; PG8_SCHED;
            PG8_LDB(B0, 1, 0); PG8_LDB(B1, 1, 1); PG8_SCHED; PG8_LDA(At, 1, 0); PG8_STAGE(PG8_SA(0, 1), a2 + hstepA, voffA);
            PG8_WAIT_V(8); PG8_WAIT_L(0); PG8_BAR; PG8_MMA(0, 0, At, B0); PG8_MMA(0, 1, At, B1); PG8_BAR; PG8_SCHED;
            PG8_LDA(At, 1, 1); PG8_STAGE(PG8_SB(1, 0), b3, voffB); PG8_STAGE(PG8_SB(1, 1), b3 + hstepB, voffB); PG8_STAGE(PG8_SA(1, 0), a3, voffA);
            PG8_WAIT_V(8); PG8_WAIT_L(0); PG8_BAR; PG8_MMA(1, 0, At, B0); PG8_MMA(1, 1, At, B1); PG8_BAR; PG8_SCHED;
            } else {
            PG8_LDB(B0, 0, 0); PG8_SCHED; PG8_LDA(At, 0, 0); PG8_STAGE(PG8_SA(1, 1), a1 + hstepA, voffA);
            PG8_WAIT_L(8); PG8_BAR; PG8_WAIT_L(0); PG8_MMA(0, 0, At, B0); PG8_BAR; PG8_SCHED;
            PG8_LDB(B1, 0, 1); PG8_STAGE(PG8_SB(0, 0), b2, voffB);
            PG8_BAR; PG8_WAIT_L(0); PG8_MMA(0, 1, At, B1); PG8_BAR;
            PG8_LDA(At, 0, 1); PG8_STAGE(PG8_SA(0, 0), a2, voffA);
            PG8_BAR; PG8_WAIT_L(0); PG8_MMA(1, 0, At, B0); PG8_BAR; PG8_SCHED;
            PG8_STAGE(PG8_SB(0, 1), b2 + hstepB, voffB);
            PG8_WAIT_V(6); PG8_BAR; PG8_MMA(1, 1, At, B1); PG8_BAR;
            PG8_LDB(B0, 1, 0); PG8_SCHED; PG8_LDA(At, 1, 0); PG8_STAGE(PG8_SA(0, 1), a2 + hstepA, voffA);
            PG8_WAIT_L(8); PG8_BAR; PG8_WAIT_L(0); PG8_MMA(0, 0, At, B0); PG8_BAR; PG8_SCHED;
            PG8_LDB(B1, 1, 1); PG8_STAGE(PG8_SB(1, 0), b3, voffB);
            PG8_BAR; PG8_WAIT_L(0); PG8_MMA(0, 1, At, B1); PG8_BAR;
            PG8_LDA(At, 1, 1); PG8_STAGE(PG8_SA(1, 0), a3, voffA);
            PG8_BAR; PG8_WAIT_L(0); PG8_MMA(1, 0, At, B0); PG8_BAR; PG8_SCHED;
            PG8_STAGE(PG8_SB(1, 1), b3 + hstepB, voffB);
            PG8_WAIT_V(6); PG8_BAR; PG8_MMA(1, 1, At, B1); PG8_BAR;
            }
        }
        if constexpr (ALIGN_EPI) { if (wr == 0) PG8_BAR; }
        if constexpr (!Epi::AFTER_DRAIN) { E(acc, cur, wr, wc, fr, fq); S.done(cur); }
        if (!has_next) break;
#pragma unroll
        for (int a = 0; a < 2; ++a)
#pragma unroll
            for (int b = 0; b < 2; ++b)
#pragma unroll
                for (int m = 0; m < 4; ++m)
#pragma unroll
                    for (int n = 0; n < 2; ++n) acc[a][b][m][n] = (f32x4){0.f, 0.f, 0.f, 0.f};
        cur = nxt; cA = nA; cB = nB; ++ui;
        if constexpr (ALIGN_EPI) { if (wr == 1) PG8_BAR; }
    }
    PG8_WAIT_V(0);
    if constexpr (!ALIGN_EPI) { if (wr == 0) PG8_BAR; }
    PG8_BAR;
    if constexpr (Epi::AFTER_DRAIN) { E.fused(acc, cur, wr, wc, fr, fq, lds, wid, lane); S.done(cur); }
#undef PG8_SA
#undef PG8_SB
#undef PG8_STAGE
#undef PG8_LDA
#undef PG8_LDB
#undef PG8_MMA
#undef PG8_WAIT_V
#undef PG8_WAIT_L
#undef PG8_BAR
#undef PG8_SCHED
}
}

__device__ __forceinline__ int crow(int r, int hi) { return (r & 3) + 8 * (r >> 2) + 4 * hi; }
__device__ __forceinline__ void glds16(const void* gsrc, unsigned lds_dst) { unsigned keep;
    asm volatile("s_mov_b32 %0, m0\n\ts_mov_b32 m0, %2\n\ts_nop 0\n\tglobal_load_lds_dwordx4 %1, off\n\ts_mov_b32 m0, %0" : "=&s"(keep) : "v"(gsrc), "s"(lds_dst) : "memory"); }
typedef float f32x2_t __attribute__((ext_vector_type(2))); typedef __bf16 bf16x2_t __attribute__((ext_vector_type(2)));
__device__ __forceinline__ unsigned cvtpk(float lo, float hi) { f32x2_t v = {lo, hi}; bf16x2_t b = __builtin_convertvector(v, bf16x2_t); return __builtin_bit_cast(unsigned, b); }
typedef short v4i16_t __attribute__((ext_vector_type(4)));
__device__ __forceinline__ s16x4 vtr(const LAS char* p) { return __builtin_bit_cast(s16x4, __builtin_amdgcn_ds_read_tr16_b64_v4i16((LAS v4i16_t*)p)); }
#define WAIT_BAR(N) asm volatile("s_waitcnt vmcnt(" #N ") lgkmcnt(0)\n\ts_barrier" ::: "memory")
constexpr int AT_SLOT = 32768, AT_NSLOT = 4, AT_WSF = AT_SLOT * AT_NSLOT, AT_XS = 132;

__device__ __forceinline__ void attn_unit(const Params& p, int layer, LAS char* lds, int b, int h, int q0, int isctx) {
    const int tid = threadIdx.x, lane = tid & 63, r32 = lane & 31, hi = lane >> 5;
    const int wave = __builtin_amdgcn_readfirstlane(tid >> 6), qg = wave & 3, map = wave >> 2;
    const float* ctl = (const float*)(p.ws + WS_CTL);
    const float lam = ctl[CF_LAM + layer], mb = ctl[CF_MB + layer];
    bf16_t* P = (bf16_t*)(p.ws + WS_PROJ);
    const unsigned lds0 = (unsigned)(uintptr_t)lds;
    const int NT = isctx ? CTXL / 64 : (SEQ + CTXL) / 64;
    const int rowq0 = seq_row0(b, isctx) + q0 + qg * 32;
#define AT_KROW0(t) (isctx ? (ML + b * CTXL + (t) * 64) : ((t) < SEQ / 64 ? (b * SEQ + (t) * 64) : (ML + b * CTXL + ((t) - SEQ / 64) * 64)))
#define AT_DMA(t) do { const int kr0_ = AT_KROW0(t); const unsigned sl_ = lds0 + (unsigned)(((t) & 3) * AT_SLOT); \
        const bf16_t* kb_ = P + (size_t)(kr0_ + lane) * PITCH + C_AK + h * 128; \
        glds16(kb_ + wave * 8, (unsigned)__builtin_amdgcn_readfirstlane(sl_ + wave * 1024)); \
        glds16(kb_ + (wave + 8) * 8, (unsigned)__builtin_amdgcn_readfirstlane(sl_ + (wave + 8) * 1024)); \
        const bf16_t* vb_ = P + (size_t)(kr0_ + 16 * (wave & 3) + (lane >> 2)) * PITCH + C_AV + h * 128 + (lane & 3) * 8; \
        glds16(vb_ + (wave >> 2) * 32, (unsigned)__builtin_amdgcn_readfirstlane(sl_ + 16384 + (wave >> 2) * 4096 + (wave & 3) * 1024)); \
        glds16(vb_ + ((wave >> 2) + 2) * 32, (unsigned)__builtin_amdgcn_readfirstlane(sl_ + 16384 + ((wave >> 2) + 2) * 4096 + (wave & 3) * 1024)); } while (0)
    AT_DMA(0); AT_DMA(1); AT_DMA(2);
    bf16x8 qr[4];
    {
        const bf16_t* qp = P + (size_t)(rowq0 + r32) * PITCH + C_AQ + h * 128 + map * 64 + hi * 8;
#pragma unroll
        for (int ks = 0; ks < 4; ++ks) qr[ks] = *(const bf16x8*)(qp + ks * 16);
    }
    asm volatile("" : "+v"(qr[0]), "+v"(qr[1]), "+v"(qr[2]), "+v"(qr[3]));
    f32x16 o[4];
#pragma unroll
    for (int d = 0; d < 4; ++d)
#pragma unroll
        for (int r = 0; r < 16; ++r) o[d][r] = 0.f;
    f32x16 negm;
#pragma unroll
    for (int r = 0; r < 16; ++r) negm[r] = -mb;
    float l = 0.f;
    const int koff = map * 8192 + hi * 1024 + r32 * 16;
    const int voff = 16384 + ((lane >> 4) & 1) * 32 + (lane & 3) * 8 + (4 * hi + ((lane & 15) >> 2)) * 64;
    for (int t = 0; t < NT; ++t) {
        const int ahead = NT - 1 - t;
        if (ahead >= 2) { WAIT_BAR(8); } else if (ahead == 1) { WAIT_BAR(4); } else { WAIT_BAR(0); }
        if (t + 3 < NT) AT_DMA(t + 3);
        const LAS char* sl = lds + (t & 3) * AT_SLOT;
        const LAS char* kp = sl + koff; const LAS char* vp = sl + voff;
        f32x16 p0 = negm, p1 = negm;
#pragma unroll
        for (int ks = 0; ks < 4; ++ks) {
            const bf16x8 a0 = *(const LAS bf16x8*)(kp + ks * 2048), a1 = *(const LAS bf16x8*)(kp + ks * 2048 + 512);
            p0 = __builtin_amdgcn_mfma_f32_32x32x16_bf16(a0, qr[ks], p0, 0, 0, 0);
            p1 = __builtin_amdgcn_mfma_f32_32x32x16_bf16(a1, qr[ks], p1, 0, 0, 0);
        }
        float sacc = 0.f;
#pragma unroll
        for (int r = 0; r < 16; ++r) { p0[r] = __builtin_amdgcn_exp2f(p0[r]); p1[r] = __builtin_amdgcn_exp2f(p1[r]); sacc += p0[r] + p1[r]; }
        l += sacc;
        u32x4 pw[4];
#pragma unroll
        for (int j = 0; j < 4; ++j) { pw[0][j] = cvtpk(p0[2 * j], p0[2 * j + 1]); pw[1][j] = cvtpk(p0[8 + 2 * j], p0[8 + 2 * j + 1]);
                                      pw[2][j] = cvtpk(p1[2 * j], p1[2 * j + 1]); pw[3][j] = cvtpk(p1[8 + 2 * j], p1[8 + 2 * j + 1]); }
#pragma unroll
        for (int d0 = 0; d0 < 4; ++d0)
#pragma unroll
            for (int ks = 0; ks < 4; ++ks) {
                const s16x4 lo = vtr(vp + d0 * 4096 + ks * 1024), hh = vtr(vp + d0 * 4096 + ks * 1024 + 512);
                const bf16x8 vf = (bf16x8){lo[0], lo[1], lo[2], lo[3], hh[0], hh[1], hh[2], hh[3]};
                o[d0] = __builtin_amdgcn_mfma_f32_32x32x16_bf16(__builtin_bit_cast(bf16x8, pw[ks]), vf, o[d0], 0, 0, 0);
            }
    }
    l += __shfl_xor(l, 32);
    WAIT_BAR(0);
    LAS float* wsf = (LAS float*)(lds + AT_WSF) + wave * 32;
    if (hi == 0) wsf[r32] = l;
    asm volatile("s_waitcnt lgkmcnt(0)" ::: "memory");
    LAS float* X = (LAS float*)lds + qg * (32 * AT_XS);
    const float fm = map ? lam : 1.f;
    if (map == 1) {
#pragma unroll
        for (int r = 0; r < 16; ++r) { const int row = crow(r, hi); const float f = fm / wsf[row];
#pragma unroll
            for (int d0 = 0; d0 < 4; ++d0) X[row * AT_XS + d0 * 32 + r32] = o[d0][r] * f; }
    }
    WAIT_BAR(0);
    if (map == 0) {
#pragma unroll
        for (int r = 0; r < 16; ++r) { const int row = crow(r, hi); const float f = fm / wsf[row];
#pragma unroll
            for (int d0 = 0; d0 < 4; ++d0) { const int xi = row * AT_XS + d0 * 32 + r32; X[xi] = o[d0][r] * f - X[xi]; } }
        asm volatile("s_waitcnt lgkmcnt(0)" ::: "memory");
        const int row = lane >> 1, half = lane & 1;
        float xv[64]; float ss = 0.f;
#pragma unroll
        for (int i = 0; i < 64; i += 4) { const f32x4 v = *(const LAS f32x4*)(X + row * AT_XS + half * 64 + i); xv[i] = v[0]; xv[i + 1] = v[1]; xv[i + 2] = v[2]; xv[i + 3] = v[3];
            ss += v[0] * v[0] + v[1] * v[1] + v[2] * v[2] + v[3] * v[3]; }
        ss += __shfl_xor(ss, 1);
        const float rs = rsqrtf(ss * (1.f / 128.f) + EPS) * (1.f - lam_init_of(layer));
        const float* sub = p.in[14] + layer * 128 + half * 64;
        bf16_t* gp = P + (size_t)(rowq0 + row) * PITCH + C_AG + h * 128 + half * 64;
        bf16_t* op = P + (size_t)(rowq0 + row) * PITCH + C_AQ + h * 128 + half * 64;
#pragma unroll
        for (int i = 0; i < 64; i += 8) {
            const u32x4 gw = *(const u32x4*)(gp + i);
            const float g0 = __uint_as_float(gw.x << 16), g1 = __uint_as_float(gw.x & 0xffff0000u), g2 = __uint_as_float(gw.y << 16), g3 = __uint_as_float(gw.y & 0xffff0000u);
            const float g4 = __uint_as_float(gw.z << 16), g5 = __uint_as_float(gw.z & 0xffff0000u), g6 = __uint_as_float(gw.w << 16), g7 = __uint_as_float(gw.w & 0xffff0000u);
            u32x4 w;
            w.x = pk2(xv[i] * rs * sub[i] * siluf(g0), xv[i + 1] * rs * sub[i + 1] * siluf(g1));
            w.y = pk2(xv[i + 2] * rs * sub[i + 2] * siluf(g2), xv[i + 3] * rs * sub[i + 3] * siluf(g3));
            w.z = pk2(xv[i + 4] * rs * sub[i + 4] * siluf(g4), xv[i + 5] * rs * sub[i + 5] * siluf(g5));
            w.w = pk2(xv[i + 6] * rs * sub[i + 6] * siluf(g6), xv[i + 7] * rs * sub[i + 7] * siluf(g7));
            *(u32x4*)(op + i) = w;
        }
    }
    WAIT_BAR(0);
#undef AT_DMA
#undef AT_KROW0
}
__device__ __forceinline__ void phase_attn(const Params& p, int layer, LAS char* lds, int blk, int nblk) {
    const int nunits = 512 + (layer == 0 ? 16 : 0);
    for (int u = blk; u < nunits; u += nblk) {
        if (u < 512) { const int bh = u & 7, qb = u >> 3; attn_unit(p, layer, lds, bh >> 2, bh & 3, qb * 128, 0); }
        else { const int j = u - 512; attn_unit(p, layer, lds, j >> 3, (j >> 1) & 3, (j & 1) * 128, 1); }
    }
}

template <int EPI>
__global__ __launch_bounds__(256) void k_gemm_naive(Params p, const bf16_t* A, int lda, const bf16_t* Bt, int K) {
    const int tid = threadIdx.x, lane = tid & 63, wave = tid >> 6, wr = wave >> 1, wc = wave & 1;
    const int row0 = blockIdx.y * 128 + wr * 64, col0 = blockIdx.x * 128 + wc * 64;
    f32x4 acc[4][4];
#pragma unroll
    for (int i = 0; i < 4; ++i)
#pragma unroll
        for (int j = 0; j < 4; ++j) acc[i][j] = (f32x4){0.f, 0.f, 0.f, 0.f};
    const int fr = lane & 15, fq = lane >> 4;
    for (int k0 = 0; k0 < K; k0 += 32) {
        bf16x8 a[4], b[4];
#pragma unroll
        for (int i = 0; i < 4; ++i) a[i] = *(const bf16x8*)(A + (size_t)(row0 + i * 16 + fr) * lda + k0 + fq * 8);
#pragma unroll
        for (int j = 0; j < 4; ++j) b[j] = *(const bf16x8*)(Bt + (size_t)(col0 + j * 16 + fr) * K + k0 + fq * 8);
#pragma unroll
        for (int i = 0; i < 4; ++i)
#pragma unroll
            for (int j = 0; j < 4; ++j) acc[i][j] = __builtin_amdgcn_mfma_f32_16x16x32_bf16(a[i], b[j], acc[i][j], 0, 0, 0);
    }
    const float* ctl = (const float*)(p.ws + WS_CTL);
#pragma unroll
    for (int i = 0; i < 4; ++i)
#pragma unroll
        for (int j = 0; j < 4; ++j)
#pragma unroll
            for (int r = 0; r < 4; ++r) {
                const int row = row0 + i * 16 + fq * 4 + r, col = col0 + j * 16 + fr;
                const float v = acc[i][j][r];
                if (EPI == 0) { if (col < PITCH) ((bf16_t*)(p.ws + WS_PROJ))[(size_t)row * PITCH + col] = f2bf(v); }
                else {
                    const RowInfo ri = row_info(row);
                    const float g = ctl[CF_MOD + (p.layer * 3 + (ri.isctx ? 2 : ri.b)) * 3072 + 2048 + col];
                    if (!ri.isctx) { const float* xin = p.layer == 0 ? p.in[0] : p.out; p.out[(size_t)row * DM + col] = xin[(size_t)row * DM + col] + g * v; }
                    else if (p.layer == 0) { const size_t o = (size_t)(row - ML) * DM + col; ((float*)(p.ws + WS_CTXN))[o] = p.in[2][o] + g * v; }
                }
            }
}

__device__ void phase_prep(const Params& p, int layer, int blk, int nblk) {
    const int tid = threadIdx.x, lane = tid & 63, wave = tid >> 6, nw = blockDim.x >> 6;
    bf16_t* P = (bf16_t*)(p.ws + WS_PROJ);
    const float gq = p.in[8][layer * 64 + lane], gk = p.in[9][layer * 64 + lane];
    const int ai = lane & 31;
    const float invf = exp2f(-(float)(ai & 15) * (13.287712379549449f / 16.f));
    for (int r = blk * nw + wave; r < MT; r += nblk * nw) {
        const RowInfo ri = row_info(r);
        float cs = 1.f, sn = 0.f;
        if (!ri.isctx) { const float pos = (ai < 16) ? (float)(ri.t >> 6) : (float)(ri.t & 63); const float ang = pos * invf; cs = cosf(ang); sn = sinf(ang); }
        bf16_t* row = P + (size_t)r * PITCH;
#pragma unroll
        for (int v = 0; v < 16; ++v) {
            bf16_t* ptr = row + (v < 8 ? C_AQ + v * 64 : C_AK + (v - 8) * 64) + lane;
            float x = bf2f(*ptr);
            const float ss = wave_sum(x * x);
            x = x * rsqrtf(ss * (1.f / 64.f) + EPS) * (v < 8 ? gq : gk);
            const float o = __shfl_xor(x, 32);
            float y = (lane < 32) ? (x * cs - o * sn) : (o * sn + x * cs);
            if (v < 8) y *= 0.125f * LOG2E;
            *ptr = f2bf(y);
        }
#pragma unroll
        for (int v = 0; v < 8; ++v) {
            bf16_t* ptr = row + (v < 4 ? C_RQ + v * 64 : C_RK + (v - 4) * 64) + lane;
            float x = bf2f(*ptr);
            const float o = __shfl_xor(x, 32);
            float y = (lane < 32) ? (x * cs - o * sn) : (o * sn + x * cs);
            if (v >= 4) y *= 0.125f;
            *ptr = f2bf(y);
        }
    }
}

__global__ __launch_bounds__(256) void k_attn_naive(Params p) {
    __shared__ __attribute__((aligned(16))) float sm[8448];
    float* Ks = sm; float* Vs = sm + 32 * 128;
    const int tid = threadIdx.x, q = tid & 127, map = tid >> 7;
    int u = blockIdx.x; int b, h, q0, isctx;
    if (u < 512) { isctx = 0; b = u >> 8; h = (u >> 6) & 3; q0 = (u & 63) * 128; }
    else { u -= 512; isctx = 1; b = u >> 3; h = (u >> 1) & 3; q0 = (u & 1) * 128; }
    const float* ctl = (const float*)(p.ws + WS_CTL);
    const float lam = ctl[CF_LAM + p.layer], mb = ctl[CF_MB + p.layer];
    bf16_t* P = (bf16_t*)(p.ws + WS_PROJ);
    const int qrow = seq_row0(b, isctx) + q0 + q;
    float qv[64];
    {
        const bf16_t* qp = P + (size_t)qrow * PITCH + C_AQ + h * 128 + map * 64;
#pragma unroll
        for (int d = 0; d < 64; d += 8) { const u32x4 w = *(const u32x4*)(qp + d);
            qv[d] = __uint_as_float(w.x << 16); qv[d + 1] = __uint_as_float(w.x & 0xffff0000u); qv[d + 2] = __uint_as_float(w.y << 16); qv[d + 3] = __uint_as_float(w.y & 0xffff0000u);
            qv[d + 4] = __uint_as_float(w.z << 16); qv[d + 5] = __uint_as_float(w.z & 0xffff0000u); qv[d + 6] = __uint_as_float(w.w << 16); qv[d + 7] = __uint_as_float(w.w & 0xffff0000u); }
    }
    float o[128];
#pragma unroll
    for (int e = 0; e < 128; ++e) o[e] = 0.f;
    float l = 0.f;
    const int nkeys = isctx ? CTXL : SEQ + CTXL;
    for (int k0 = 0; k0 < nkeys; k0 += 32) {
        __syncthreads();
#pragma unroll
        for (int i = 0; i < 2; ++i) {
            const int ch = tid + i * 256, kr = ch >> 4, c8 = (ch & 15) * 8;
            const int kk = k0 + kr;
            const int krow = isctx ? (ML + b * CTXL + kk) : (kk < SEQ ? b * SEQ + kk : ML + b * CTXL + (kk - SEQ));
            const u32x4 wk = *(const u32x4*)(P + (size_t)krow * PITCH + C_AK + h * 128 + c8);
            const u32x4 wv = *(const u32x4*)(P + (size_t)krow * PITCH + C_AV + h * 128 + c8);
            float* kd = Ks + kr * 128 + c8; float* vd = Vs + kr * 128 + c8;
            kd[0] = __uint_as_float(wk.x << 16); kd[1] = __uint_as_float(wk.x & 0xffff0000u); kd[2] = __uint_as_float(wk.y << 16); kd[3] = __uint_as_float(wk.y & 0xffff0000u);
            kd[4] = __uint_as_float(wk.z << 16); kd[5] = __uint_as_float(wk.z & 0xffff0000u); kd[6] = __uint_as_float(wk.w << 16); kd[7] = __uint_as_float(wk.w & 0xffff0000u);
            vd[0] = __uint_as_float(wv.x << 16); vd[1] = __uint_as_float(wv.x & 0xffff0000u); vd[2] = __uint_as_float(wv.y << 16); vd[3] = __uint_as_float(wv.y & 0xffff0000u);
            vd[4] = __uint_as_float(wv.z << 16); vd[5] = __uint_as_float(wv.z & 0xffff0000u); vd[6] = __uint_as_float(wv.w << 16); vd[7] = __uint_as_float(wv.w & 0xffff0000u);
        }
        __syncthreads();
        for (int kr = 0; kr < 32; ++kr) {
            const float* kp = Ks + kr * 128 + map * 64;
            float s = 0.f;
#pragma unroll
            for (int d = 0; d < 64; d += 4) { const f32x4 kv = *(const f32x4*)(kp + d); s += qv[d] * kv.x + qv[d + 1] * kv.y + qv[d + 2] * kv.z + qv[d + 3] * kv.w; }
            const float pr = exp2f(s - mb);
            l += pr;
            const float* vp = Vs + kr * 128;
#pragma unroll
            for (int e = 0; e < 128; e += 4) { const f32x4 vv = *(const f32x4*)(vp + e); o[e] += pr * vv.x; o[e + 1] += pr * vv.y; o[e + 2] += pr * vv.z; o[e + 3] += pr * vv.w; }
        }
    }
    const float f = (map == 0) ? 1.f / l : lam / l;
#pragma unroll
    for (int half = 0; half < 2; ++half) {
        __syncthreads();
        if (map == 1) {
#pragma unroll
            for (int e = 0; e < 64; ++e) sm[q * 65 + e] = o[half * 64 + e] * f;
        }
        __syncthreads();
        if (map == 0) {
#pragma unroll
            for (int e = 0; e < 64; ++e) o[half * 64 + e] = o[half * 64 + e] * f - sm[q * 65 + e];
        }
    }
    if (map == 0) {
        float ss = 0.f;
#pragma unroll
        for (int e = 0; e < 128; ++e) ss += o[e] * o[e];
        const float rs = rsqrtf(ss * (1.f / 128.f) + EPS) * (1.f - lam_init_of(p.layer));
        const float* sub = p.in[14] + p.layer * 128;
        const bf16_t* gp = P + (size_t)qrow * PITCH + C_AG + h * 128;
        bf16_t* op = P + (size_t)qrow * PITCH + C_AQ + h * 128;
#pragma unroll
        for (int e = 0; e < 128; e += 2) {
            const unsigned gw = *(const unsigned*)(gp + e);
            const float g0 = __uint_as_float(gw << 16), g1 = __uint_as_float(gw & 0xffff0000u);
            *(unsigned*)(op + e) = pk2(o[e] * rs * sub[e] * siluf(g0), o[e + 1] * rs * sub[e + 1] * siluf(g1));
        }
    }
}

template <int KIND>
__global__ __launch_bounds__(KIND == 0 ? 64 : 128) void k_scan_naive(Params p) {
    constexpr int N = KIND == 0 ? 128 : 64, PD = KIND == 0 ? 64 : 128, TC = 32;
    __shared__ float qs[TC][N], ks[TC][N], vs[TC][PD], as_[TC];
    const int tid = threadIdx.x, layer = p.layer;
    const int nh = KIND == 0 ? 16 : 4;
    const int b = blockIdx.x / nh, head = blockIdx.x % nh, g = head >> 3;
    bf16_t* P = (bf16_t*)(p.ws + WS_PROJ);
    const float* cw = p.in[15] + (size_t)layer * 3 * 1536; const float* cb = p.in[16] + (size_t)layer * 1536;
    const float Dh = KIND == 0 ? p.in[19][layer * 16 + head] : 0.f;
    float S[N];
    for (int dir = 0; dir < 2; ++dir) {
#pragma unroll
        for (int n = 0; n < N; ++n) S[n] = 0.f;
        float dtb = 0.f, aexp = 0.f, lar = 0.f;
        if (KIND == 0) { dtb = p.in[17][(layer * 2 + dir) * 16 + head]; aexp = expf(p.in[18][(layer * 2 + dir) * 16 + head]); }
        else { const float e = (dir == 0 ? 5.0f : 5.5f) + (float)head; lar = log1pf(-exp2f(-e)); }
        for (int seg = 0; seg < 2; ++seg) {
            const int isctx = seg == 0, L = isctx ? CTXL : SEQ, r0 = seq_row0(b, isctx);
            for (int c0 = 0; c0 < L; c0 += TC) {
                const int tbase = dir == 0 ? c0 : L - TC - c0;
                __syncthreads();
                if (KIND == 0) {
                    for (int i = tid; i < TC * 320; i += blockDim.x) {
                        const int tt = i / 320, cc = i % 320;
                        const int col = cc < 64 ? head * 64 + cc : (cc < 192 ? 1024 + g * 128 + (cc - 64) : 1280 + g * 128 + (cc - 192));
                        const int t = tbase + tt;
                        float acc = cb[col];
#pragma unroll
                        for (int k = 0; k < 3; ++k) { const int ts = t + k - 1; if (ts >= 0 && ts < L) acc += cw[k * 1536 + col] * bf2f(P[(size_t)(r0 + ts) * PITCH + C_XBC + col]); }
                        const float uu = siluf(acc);
                        if (cc < 64) vs[tt][cc] = uu; else if (cc < 192) ks[tt][cc - 64] = uu; else qs[tt][cc - 192] = uu;
                    }
                    if (tid < TC) {
                        const float dtr = bf2f(P[(size_t)(r0 + tbase + tid) * PITCH + C_DTR + dir * 16 + head]) + dtb;
                        const float dt = dtr > 20.f ? dtr : log1pf(expf(dtr));
                        as_[tid] = dt;
                    }
                } else {
                    for (int i = tid; i < TC * 256; i += blockDim.x) {
                        const int tt = i / 256, cc = i % 256; const size_t rr = (size_t)(r0 + tbase + tt) * PITCH;
                        if (cc < 64) qs[tt][cc] = bf2f(P[rr + C_RQ + head * 64 + cc]);
                        else if (cc < 128) ks[tt][cc - 64] = bf2f(P[rr + C_RK + head * 64 + cc - 64]);
                        else vs[tt][cc - 128] = bf2f(P[rr + C_RV + head * 128 + cc - 128]);
                    }
                }
                __syncthreads();
                for (int s = 0; s < TC; ++s) {
                    const int tt = dir == 0 ? s : TC - 1 - s;
                    float a, v;
                    if (KIND == 0) { const float dt = as_[tt]; a = expf(-dt * aexp); v = vs[tt][tid] * dt; }
                    else { a = expf(lar); v = vs[tt][tid]; }
                    float y = 0.f;
#pragma unroll
                    for (int n = 0; n < N; ++n) { S[n] = a * S[n] + ks[tt][n] * v; y += qs[tt][n] * S[n]; }
                    bf16_t* yp = P + (size_t)(r0 + tbase + tt) * PITCH + (KIND == 0 ? C_YS + head * 64 : C_YR + head * 128) + tid;
                    if (dir == 0) *yp = f2bf(y);
                    else { float tot = bf2f(*yp) + y; if (KIND == 0) tot += Dh * vs[tt][tid]; *yp = f2bf(tot); }
                }
            }
        }
    }
}

__device__ void phase_fin(const Params& p, int layer, int blk, int nblk) {
    const int tid = threadIdx.x, lane = tid & 63, wave = tid >> 6, nw = blockDim.x >> 6;
    bf16_t* P = (bf16_t*)(p.ws + WS_PROJ);
    const float* snorm = p.in[20] + layer * 1024; const float* rnorm = p.in[21] + layer * 128;
    for (int r = blk * nw + wave; r < MT; r += nblk * nw) {
        bf16_t* row = P + (size_t)r * PITCH;
#pragma unroll
        for (int g = 0; g < 2; ++g) {
            const int c0 = g * 512 + lane * 8;
            float v[8]; float ss = 0.f;
#pragma unroll
            for (int j = 0; j < 8; ++j) { v[j] = bf2f(row[C_YS + c0 + j]) * siluf(bf2f(row[C_Z + c0 + j])); ss += v[j] * v[j]; }
            const float rs = rsqrtf(wave_sum(ss) * (1.f / 512.f) + EPS);
#pragma unroll
            for (int j = 0; j < 8; ++j) row[C_Z + c0 + j] = f2bf(v[j] * rs * snorm[c0 + j]);
        }
        {
            const int c0 = lane * 8;
            float v[8]; float ss = 0.f;
#pragma unroll
            for (int j = 0; j < 8; ++j) { v[j] = bf2f(row[C_YR + c0 + j]); ss += v[j] * v[j]; }
#pragma unroll
            for (int o = 1; o < 16; o <<= 1) ss += __shfl_xor(ss, o);
            const float rs = rsqrtf(ss * (1.f / 128.f) + EPS);
#pragma unroll
            for (int j = 0; j < 8; ++j) row[C_RG + c0 + j] = f2bf(v[j] * rs * rnorm[(c0 + j) & 127] * siluf(bf2f(row[C_RG + c0 + j])));
        }
    }
}

constexpr int CONV_LDS_BYTES = 8 * 64 * 33 * 4;
__global__ __launch_bounds__(512) void k_init(Params p) {
    extern __shared__ __attribute__((aligned(16))) float lds[];
    phase_ada(p, lds, blockIdx.x, gridDim.x);
    __syncthreads();
    phase_convw(p, 0, lds, blockIdx.x, gridDim.x);
}
__global__ __launch_bounds__(512) void k_norm(Params p) {
    extern __shared__ __attribute__((aligned(16))) float lds[];
    if (p.layer > 0) phase_convw(p, p.layer, lds, blockIdx.x, gridDim.x);
    phase_norm(p, p.layer, blockIdx.x, gridDim.x);
}
template <int EPI>
__global__ __launch_bounds__(512, 2) void k_gemm_fast(Params p) {
    extern __shared__ __attribute__((aligned(16))) unsigned char ldsb[];
    LAS unsigned char* lds = (LAS unsigned char*)ldsb;
    const int layer = p.layer;
    if (EPI == 0) {
        pg8::Gemm g{(const bf16_t*)(p.ws + WS_H), (const bf16_t*)(p.ws + WS_WINT), MT, NPAD, DM, DM};
        pg8::StaticOrder S; S.init(MT, NPAD, gridDim.x, blockIdx.x);
        pg8::EpiProj E{(bf16_t*)(p.ws + WS_PROJ)};
        pg8::gemm_phase<pg8::EpiProj, pg8::StaticOrder, true, true>(lds, g, S, E);
    } else {
        const int M = layer == 0 ? MT : ML;
        pg8::Gemm g{(const bf16_t*)(p.ws + WS_PROJ), (const bf16_t*)(p.ws + WS_WOUTT), M, DM, DMIX, PITCH};
        pg8::StaticOrder S; S.init(M, DM, gridDim.x, blockIdx.x);
        pg8::EpiResid E{layer == 0 ? p.in[0] : p.out, p.out, p.in[2], (float*)(p.ws + WS_CTXN), (const float*)(p.ws + WS_CTL) + CF_MOD + layer * 3 * 3072};
        pg8::gemm_phase<pg8::EpiResid, pg8::StaticOrder, true, true>(lds, g, S, E);
    }
}
__global__ __launch_bounds__(512, 2) void k_attn_fast(Params p) {
    extern __shared__ __attribute__((aligned(16))) unsigned char ldsb[];
    phase_attn(p, p.layer, (LAS char*)ldsb, blockIdx.x, gridDim.x);
}
__global__ __launch_bounds__(512) void k_prep(Params p) { phase_prep(p, p.layer, blockIdx.x, gridDim.x); }
__global__ __launch_bounds__(512) void k_fin(Params p) { phase_fin(p, p.layer, blockIdx.x, gridDim.x); }

extern "C" void kernel_launch(void* const* d_in, const int* in_sizes, int n_in, void* d_out, int out_size, void* d_ws, size_t ws_size, hipStream_t stream) {
    if (n_in != 22 || ws_size < WS_END || out_size != ML * DM) { fprintf(stderr, "kernel_launch: unexpected shapes (n_in %d, ws %zu, out %d)\n", n_in, ws_size, out_size); return; }
    Params p{};
    for (int i = 0; i < 22; ++i) p.in[i] = (const float*)d_in[i];
    p.out = (float*)d_out; p.ws = (unsigned char*)d_ws; p.layer = 0; p.pad = 0;
    const bf16_t* H = (const bf16_t*)((unsigned char*)d_ws + WS_H);
    const bf16_t* WINT = (const bf16_t*)((unsigned char*)d_ws + WS_WINT);
    const bf16_t* WOUTT = (const bf16_t*)((unsigned char*)d_ws + WS_WOUTT);
    const bf16_t* PROJ = (const bf16_t*)((unsigned char*)d_ws + WS_PROJ);
    static int attr_done = 0;
    if (!attr_done) {
        (void)hipFuncSetAttribute((const void*)k_init, hipFuncAttributeMaxDynamicSharedMemorySize, CONV_LDS_BYTES);
        (void)hipFuncSetAttribute((const void*)k_norm, hipFuncAttributeMaxDynamicSharedMemorySize, CONV_LDS_BYTES);
        (void)hipFuncSetAttribute((const void*)k_gemm_fast<0>, hipFuncAttributeMaxDynamicSharedMemorySize, LDS_BYTES);
        (void)hipFuncSetAttribute((const void*)k_gemm_fast<1>, hipFuncAttributeMaxDynamicSharedMemorySize, LDS_BYTES);
        (void)hipFuncSetAttribute((const void*)k_attn_fast, hipFuncAttributeMaxDynamicSharedMemorySize, LDS_BYTES);
        attr_done = 1;
    }
    hipLaunchKernelGGL(k_init, dim3(256), dim3(512), CONV_LDS_BYTES, stream, p);
    for (int layer = 0; layer < DEPTH; ++layer) {
        p.layer = layer;
        hipLaunchKernelGGL(k_norm, dim3(256), dim3(512), CONV_LDS_BYTES, stream, p);
        hipLaunchKernelGGL(k_gemm_fast<0>, dim3(256), dim3(512), LDS_BYTES, stream, p);
        hipLaunchKernelGGL(k_prep, dim3(256), dim3(512), 0, stream, p);
        hipLaunchKernelGGL(k_attn_fast, dim3(256), dim3(512), LDS_BYTES, stream, p);
        hipLaunchKernelGGL(k_scan_naive<0>, dim3(NB * 16), dim3(64), 0, stream, p);
        hipLaunchKernelGGL(k_scan_naive<1>, dim3(NB * 4), dim3(128), 0, stream, p);
        hipLaunchKernelGGL(k_fin, dim3(256), dim3(512), 0, stream, p);
        hipLaunchKernelGGL(k_gemm_fast<1>, dim3(256), dim3(512), LDS_BYTES, stream, p);
    }
}
```

```cpp
#include <hip/hip_runtime.h>
#include <hip/hip_cooperative_groups.h>
namespace cg = cooperative_groups;
#include <cstdio>
#include <cstdint>

constexpr int DM = 1024, NB = 2, SEQ = 8192, CTXL = 256, DEPTH = 2;
constexpr int ML = NB * SEQ, MC = NB * CTXL, MT = ML + MC;
constexpr int NPROJ = 6176, NPAD = 6400, PITCH = 6208, DMIX = 2048;
constexpr int C_AQ = 0, C_Z = 512, C_RG = 1536, C_AK = 2048, C_AV = 2560, C_AG = 3072, C_XBC = 3584, C_XS = 3584, C_BM = 4608, C_CM = 4864,
              C_RQ = 5120, C_RK = 5376, C_RV = 5632, C_DTR = 6144;
constexpr int C_YS = 2048  , C_YR = 3072  ;
constexpr float EPS = 1e-6f;
constexpr float LOG2E = 1.4426950408889634f;

typedef unsigned short bf16_t;
typedef short bf16x8 __attribute__((ext_vector_type(8)));
typedef float f32x4 __attribute__((ext_vector_type(4)));
typedef unsigned u32x4 __attribute__((ext_vector_type(4)));
typedef float f32x16 __attribute__((ext_vector_type(16)));
typedef short s16x4 __attribute__((ext_vector_type(4)));
#define LAS __attribute__((address_space(3)))
constexpr int LDS_BYTES = 147456;

constexpr size_t MiB = 1u << 20;
constexpr size_t WS_CTL = 0;
constexpr size_t WS_PROJ = 1 * MiB;
constexpr size_t PROJ_BYTES = (size_t)MT * PITCH * 2;
constexpr size_t WS_H = WS_PROJ + ((PROJ_BYTES + 4095) / 4096) * 4096;
constexpr size_t H_BYTES = (size_t)MT * DM * 2;
constexpr size_t WS_WINT = WS_H + H_BYTES;
constexpr size_t WINT_BYTES = (size_t)NPAD * DM * 2;
constexpr size_t WS_WOUTT = WS_WINT + WINT_BYTES;
constexpr size_t WOUTT_BYTES = (size_t)DM * DMIX * 2;
constexpr size_t WS_CTXN = WS_WOUTT + WOUTT_BYTES;
constexpr size_t CTXN_BYTES = (size_t)MC * DM * 4;
constexpr size_t WS_END = WS_CTXN + CTXN_BYTES;
static_assert(WS_END <= 256 * MiB, "workspace map exceeds 256 MiB");
constexpr int CF_MOD = 1024;
constexpr int CF_LAM = 512, CF_MB = 516;

struct Params {
    const float* in[22];
    float* out;
    unsigned char* ws;
    int layer; int pad;
};
typedef const __attribute__((address_space(4))) Params* KP;
__device__ __forceinline__ KP kargs() { KP k = (KP)__builtin_amdgcn_kernarg_segment_ptr(); asm volatile("" : "+s"(k)); return k; }

__device__ __forceinline__ int tid_opaque() { int t = threadIdx.x; asm volatile("" : "+v"(t)); return t; }
__device__ __forceinline__ float bf2f(bf16_t v) { return __uint_as_float((unsigned)v << 16); }
__device__ __forceinline__ bf16_t f2bf(float f) { unsigned u = __float_as_uint(f); return (bf16_t)((u + 0x7fffu + ((u >> 16) & 1u)) >> 16); }
__device__ __forceinline__ unsigned pk2(float lo, float hi) { return (unsigned)f2bf(lo) | ((unsigned)f2bf(hi) << 16); }
__device__ __forceinline__ float siluf(float x) { return x / (1.f + __expf(-x)); }
__device__ __forceinline__ float wave_sum(float v) {
#pragma unroll
    for (int o = 1; o < 64; o <<= 1) v += __shfl_xor(v, o);
    return v;
}
__device__ __forceinline__ float lam_init_of(int layer) { return 0.8f - 0.6f * __expf(-0.3f * (float)layer); }

struct RowInfo { int b, t, L, isctx; };
__device__ __forceinline__ RowInfo row_info(int r) {
    RowInfo i;
    if (r < ML) { i.b = r >> 13; i.t = r & (SEQ - 1); i.L = SEQ; i.isctx = 0; }
    else { const int rr = r - ML; i.b = rr >> 8; i.t = rr & (CTXL - 1); i.L = CTXL; i.isctx = 1; }
    return i;
}
__device__ __forceinline__ int seq_row0(int b, int isctx) { return isctx ? ML + b * CTXL : b * SEQ; }

__device__ __forceinline__ void phase_ada(KP p, float* lds, int blk, int nblk) {
    const int tid = tid_opaque();
    float* ctl = (float*)(p->ws + WS_CTL);
    const float* c = p->in[1]; const float* cc = p->in[3];
    for (int i = tid; i < 3 * DM; i += blockDim.x) {
        const int v = i / DM, k = i % DM;
        const float x = (v < 2) ? c[v * DM + k] : cc[k];
        lds[i] = siluf(x);
    }
    __syncthreads();
    float* red = lds + 3 * DM;
    for (int grp = blk; grp < 256; grp += nblk) {
        const int layer = grp / 128, col0 = (grp % 128) * 24;
        const float* w = p->in[4] + (size_t)layer * DM * 3072;
        const int cl = tid & 31, kg = tid >> 5;
        float a0 = 0.f, a1 = 0.f, a2 = 0.f;
        if (cl < 24) {
            for (int i = 0; i < 64; ++i) {
                const int k = kg * 64 + i;
                const float wv = w[(size_t)k * 3072 + col0 + cl];
                a0 += lds[k] * wv; a1 += lds[DM + k] * wv; a2 += lds[2 * DM + k] * wv;
            }
        }
        red[(kg * 32 + cl) * 3 + 0] = a0; red[(kg * 32 + cl) * 3 + 1] = a1; red[(kg * 32 + cl) * 3 + 2] = a2;
        __syncthreads();
        if (tid < 72) {
            const int v = tid / 24, cc2 = tid % 24;
            float s = 0.f;
            for (int g = 0; g < 16; ++g) s += red[(g * 32 + cc2) * 3 + v];
            s += p->in[5][layer * 3072 + col0 + cc2];
            ctl[CF_MOD + (layer * 3 + v) * 3072 + col0 + cc2] = s;
        }
        __syncthreads();
    }
    if (blk == 0 && tid < 64) {
        for (int layer = 0; layer < DEPTH; ++layer) {
            const float q1 = p->in[10][layer * 64 + tid] * p->in[11][layer * 64 + tid];
            const float q2 = p->in[12][layer * 64 + tid] * p->in[13][layer * 64 + tid];
            const float s1 = wave_sum(q1), s2 = wave_sum(q2);
            float gq = fabsf(p->in[8][layer * 64 + tid]), gk = fabsf(p->in[9][layer * 64 + tid]);
#pragma unroll
            for (int o = 1; o < 64; o <<= 1) { gq = fmaxf(gq, __shfl_xor(gq, o)); gk = fmaxf(gk, __shfl_xor(gk, o)); }
            if (tid == 0) {
                ctl[CF_LAM + layer] = expf(s1) - expf(s2) + lam_init_of(layer);
                ctl[CF_MB + layer] = 8.0f * gq * gk * LOG2E * 1.03f + 0.5f;
            }
        }
    }
}

__device__ __forceinline__ int win_src_col(int n) {
    if (n < 512) return n;
    if (n < 1536) return 3616 + (n - 512);
    if (n < 2048) return 5664 + (n - 1536);
    if (n < 2560) return 512 + (n - 2048);
    if (n < 3072) return 1024 + (n - 2560);
    if (n < 3584) return 1536 + (n - 3072);
    if (n < 5120) return 2048 + (n - 3584);
    if (n < 5376) return 4640 + (n - 5120);
    if (n < 5632) return 4896 + (n - 5376);
    if (n < 6144) return 5152 + (n - 5632);
    if (n < 6176) return 3584 + (n - 6144);
    return -1;
}
__device__ __forceinline__ void transpose_item(const float* W, int K, int N, int srccol, bf16_t* WT, int k0, int n0, float* scr, int lane) {
    if (srccol >= 0) {
#pragma unroll 8
        for (int i = 0; i < 32; ++i) { const int kk = 2 * i + (lane >> 5); scr[kk * 33 + (lane & 31)] = W[(size_t)(k0 + kk) * N + srccol + (lane & 31)]; }
    } else {
#pragma unroll 8
        for (int i = 0; i < 32; ++i) { const int kk = 2 * i + (lane >> 5); scr[kk * 33 + (lane & 31)] = 0.f; }
    }
    __builtin_amdgcn_s_waitcnt(0xC07F); asm volatile("" ::: "memory");
    const int c = lane & 7;
#pragma unroll
    for (int j = 0; j < 4; ++j) {
        const int n = (lane >> 3) + 8 * j; const float* s = scr + (8 * c) * 33 + n;
        u32x4 o; o.x = pk2(s[0 * 33], s[1 * 33]); o.y = pk2(s[2 * 33], s[3 * 33]); o.z = pk2(s[4 * 33], s[5 * 33]); o.w = pk2(s[6 * 33], s[7 * 33]);
        *(u32x4*)(WT + (size_t)(n0 + n) * K + k0 + 8 * c) = o;
    }
    __builtin_amdgcn_s_waitcnt(0xC07F); asm volatile("" ::: "memory");
}
__device__ __forceinline__ void phase_convw(KP p, int layer, float* lds, int blk, int nblk) {
    const int tid = tid_opaque(), lane = tid & 63, wave = tid >> 6, nw = blockDim.x >> 6;
    float* scr = lds + wave * (64 * 33);
    const int gw = blk * nw + wave, NGW = nblk * nw;
    const float* win = p->in[6] + (size_t)layer * DM * NPROJ;
    const float* wout = p->in[7] + (size_t)layer * DMIX * DM;
    bf16_t* wint = (bf16_t*)(p->ws + WS_WINT); bf16_t* woutt = (bf16_t*)(p->ws + WS_WOUTT);
    constexpr int I_IN = (DM / 64) * (NPAD / 32), I_OUT = (DMIX / 64) * (DM / 32);
    for (int it = gw; it < I_IN + I_OUT; it += NGW) {
        if (it < I_IN) { const int nb = it % (NPAD / 32), kb = it / (NPAD / 32); transpose_item(win, DM, NPROJ, win_src_col(nb * 32), wint, kb * 64, nb * 32, scr, lane); }
        else { const int r = it - I_IN; const int nb = r % (DM / 32), kb = r / (DM / 32); transpose_item(wout, DMIX, DM, nb * 32, woutt, kb * 64, nb * 32, scr, lane); }
    }
}

__device__ __forceinline__ void phase_norm(KP p, int layer, int blk, int nblk) {
    const int tid = tid_opaque(), lane = tid & 63, wave = tid >> 6, nw = blockDim.x >> 6;
    const float* ctl = (const float*)(p->ws + WS_CTL);
    bf16_t* H = (bf16_t*)(p->ws + WS_H);
    const float* xl = layer == 0 ? p->in[0] : p->out;
    const float* xc = layer == 0 ? p->in[2] : (const float*)(p->ws + WS_CTXN);
    for (int r = blk * nw + wave; r < MT; r += nblk * nw) {
        const RowInfo ri = row_info(r);
        const float* xr = ri.isctx ? xc + (size_t)(r - ML) * DM : xl + (size_t)r * DM;
        const float* mod = ctl + CF_MOD + (layer * 3 + (ri.isctx ? 2 : ri.b)) * 3072;
        f32x4 v[4]; float s = 0.f;
#pragma unroll
        for (int j = 0; j < 4; ++j) { v[j] = *(const f32x4*)(xr + 256 * j + 4 * lane); s += v[j].x * v[j].x + v[j].y * v[j].y + v[j].z * v[j].z + v[j].w * v[j].w; }
        const float rs = rsqrtf(wave_sum(s) * (1.f / DM) + EPS);
#pragma unroll
        for (int j = 0; j < 4; ++j) {
            const int c0 = 256 * j + 4 * lane;
            const f32x4 sh = *(const f32x4*)(mod + c0), sc = *(const f32x4*)(mod + 1024 + c0);
            const float o0 = v[j].x * rs * (1.f + sc.x) + sh.x, o1 = v[j].y * rs * (1.f + sc.y) + sh.y, o2 = v[j].z * rs * (1.f + sc.z) + sh.z, o3 = v[j].w * rs * (1.f + sc.w) + sh.w;
            uint2 o; o.x = pk2(o0, o1); o.y = pk2(o2, o3);
            *(uint2*)(H + (size_t)r * DM + c0) = o;
        }
    }
}


namespace pg8 {
#define PG8_LAS __attribute__((address_space(3)))
constexpr int BM = 256, BK = 64, HALF = 128, HTB = HALF * BK * 2, STAGE_BYTES = 8 * HTB, NXCD = 8, WGM = 8;
__host__ __device__ __forceinline__ int lds_byte(int r, int c) { const int st = (r >> 4) * 2 + (c >> 5), rr = r & 15, cc = c & 31, ob = rr * 64 + cc * 2; return st * 1024 + (ob ^ (((ob >> 9) & 1) << 5)); }
__host__ __device__ __forceinline__ void stage_rc(int b, int& R, int& C) { const int st = b / 1024, sb = b % 1024, swz = sb ^ (((sb >> 9) & 1) << 5); R = (st >> 1) * 16 + swz / 64; C = (st & 1) * 32 + (swz % 64) / 2; }
__host__ __device__ __forceinline__ int perm32(int rho) { const int n = rho >> 4, i = rho & 15; return 8 * (i >> 2) + 4 * n + (i & 3); }
struct Unit { int pm, pn; };
struct Gemm { const bf16_t* A; const bf16_t* Bt; int M, N, K, lda; };
struct StaticOrder {
    int nM, nN, nwg, G, c;
    __host__ __device__ void init(int M, int N, int G_, int c_) { nM = M / BM; nN = N / BM; nwg = nM * nN; G = G_; c = c_; }
    __host__ __device__ bool next(int i, Unit& u) const {
        const long L = (long)i * G + c; if (L >= nwg) return false;
        int wgid = (int)L; { const int q = nwg / NXCD, r = nwg % NXCD, xcd = wgid % NXCD, off = wgid / NXCD; wgid = (xcd < r ? xcd * (q + 1) : r * (q + 1) + (xcd - r) * q) + off; }
        const int nig = WGM * nN, gid = wgid / nig, fm = gid * WGM, gsz = (nM - fm) < WGM ? (nM - fm) : WGM;
        u.pm = fm + ((wgid % nig) % gsz); u.pn = (wgid % nig) / gsz; return true;
    }
    __device__ __forceinline__ void a_ready(const Unit&) const {}
    __device__ __forceinline__ void done(const Unit&) const {}
};
__device__ __forceinline__ unsigned cvt_pk_bf16(float lo, float hi) { unsigned r; asm volatile("v_cvt_pk_bf16_f32 %0, %1, %2" : "=v"(r) : "v"(lo), "v"(hi)); return r; }
struct EpiProj {
    static constexpr bool PERM = true, AFTER_DRAIN = false;
    bf16_t* O;
    __device__ __forceinline__ void operator()(const f32x4 (&acc)[2][2][4][2], const Unit& u, int wr, int wc, int fr, int fq) const {
        const int row0 = u.pm * BM + wr * 64 + fr, col0 = u.pn * BM + wc * 32 + 8 * fq;
#pragma unroll
        for (int ai = 0; ai < 2; ++ai)
#pragma unroll
            for (int m = 0; m < 4; ++m) { bf16_t* rowp = O + (size_t)(row0 + ai * HALF + m * 16) * PITCH + col0;
#pragma unroll
                for (int bj = 0; bj < 2; ++bj) { const f32x4 v0 = acc[ai][bj][m][0], v1 = acc[ai][bj][m][1];
                    u32x4 w; w.x = cvt_pk_bf16(v0[0], v0[1]); w.y = cvt_pk_bf16(v0[2], v0[3]); w.z = cvt_pk_bf16(v1[0], v1[1]); w.w = cvt_pk_bf16(v1[2], v1[3]);
                    if (col0 + bj * HALF + 8 <= PITCH) *(u32x4*)(rowp + bj * HALF) = w; } }
    }
};
struct EpiResid {
    static constexpr bool PERM = false, AFTER_DRAIN = false;
    const float* xlat; float* olat; const float* xctx; float* octx; const float* mod;
    __device__ __forceinline__ void operator()(const f32x4 (&acc)[2][2][4][2], const Unit& u, int wr, int wc, int fr, int fq) const {
        const bool isctx = u.pm >= 64;
        const float* xb = isctx ? xctx : xlat; float* ob = isctx ? octx : olat;
        const int prow = (isctx ? u.pm - 64 : u.pm) * BM + wr * 64 + fr;
        const float* gv = mod + (isctx ? 2 : (u.pm >> 5)) * 3072 + 2048;
        const int col0 = u.pn * BM + wc * 32 + 4 * fq;
#pragma unroll
        for (int bj = 0; bj < 2; ++bj)
#pragma unroll
            for (int n = 0; n < 2; ++n) { const int col = col0 + bj * HALF + n * 16; const f32x4 g = *(const f32x4*)(gv + col);
#pragma unroll
                for (int ai = 0; ai < 2; ++ai)
#pragma unroll
                    for (int m = 0; m < 4; ++m) { const size_t off = (size_t)(prow + ai * HALF + m * 16) * DM + col;
                        const f32x4 xin = *(const f32x4*)(xb + off); *(f32x4*)(ob + off) = xin + g * acc[ai][bj][m][n]; } }
    }
};
template <class Epi, class Sched, bool ALIGN_EPI = false, bool SP2 = false>
__device__ __forceinline__ void gemm_phase(PG8_LAS unsigned char* lds, const Gemm g, const Sched& S, const Epi& E) {
    const int tid = tid_opaque(), wid = __builtin_amdgcn_readfirstlane(tid >> 6), lane = tid & 63, wr = wid >> 2, wc = wid & 3, fr = lane & 15, fq = lane >> 4;
    const int K = g.K, lda = g.lda, nt = K / BK;
    unsigned voffA[2], voffB[2];
#pragma unroll
    for (int i = 0; i < 2; ++i) { int R, C; stage_rc(tid * 16 + i * 8192, R, C); const int Rb = Epi::PERM ? ((R & ~31) + perm32(R & 31)) : R;
        voffA[i] = (unsigned)(R * lda + C) * 2u; voffB[i] = (unsigned)(Rb * K + C) * 2u; }
    const size_t kstep = (size_t)(BK * 2);
    const size_t hstepA = (size_t)HALF * lda * 2, hstepB = (size_t)HALF * K * 2;
    const size_t tstepA = 2 * hstepA, tstepB = 2 * hstepB;
    const unsigned ldsw = (unsigned)wid * 1024u;
    const int aoff = lds_byte(wr * 64 + fr, fq * 8), boff = lds_byte(wc * 32 + fr, fq * 8);
#define PG8_SA(b, h) (((b) * 2 + (h)) * HTB)
#define PG8_SB(b, h) ((4 + (b) * 2 + (h)) * HTB)
#define PG8_STAGE(bufoff, gbase, voff) do { _Pragma("unroll") for (int _i = 0; _i < 2; ++_i) \
        __builtin_amdgcn_global_load_lds((const unsigned*)((const char*)(gbase) + (voff)[_i]), (PG8_LAS unsigned*)(lds + (bufoff) + ldsw + _i * 8192), 16, 0, 0); } while (0)
#define PG8_LDA(dst, b, h) do { _Pragma("unroll") for (int m = 0; m < 4; ++m) _Pragma("unroll") for (int k = 0; k < 2; ++k) dst[m][k] = *(const PG8_LAS bf16x8*)(lds + PG8_SA(b, h) + aoff + m * 2048 + k * 1024); } while (0)
#define PG8_LDB(dst, b, h) do { _Pragma("unroll") for (int n = 0; n < 2; ++n) _Pragma("unroll") for (int k = 0; k < 2; ++k) dst[n][k] = *(const PG8_LAS bf16x8*)(lds + PG8_SB(b, h) + boff + n * 2048 + k * 1024); } while (0)
#define PG8_MMA(ai, bj, At, Bt) do { __builtin_amdgcn_s_setprio(1); _Pragma("unroll") for (int m = 0; m < 4; ++m) _Pragma("unroll") for (int n = 0; n < 2; ++n) _Pragma("unroll") for (int k = 0; k < 2; ++k) \
        acc[ai][bj][m][n] = __builtin_amdgcn_mfma_f32_16x16x32_bf16(Bt[n][k], At[m][k], acc[ai][bj][m][n], 0, 0, 0); __builtin_amdgcn_s_setprio(0); } while (0)
#define PG8_WAIT_V(n) asm volatile("s_waitcnt vmcnt(" #n ")" ::: "memory")
#define PG8_WAIT_L(n) asm volatile("s_waitcnt lgkmcnt(" #n ")" ::: "memory")
#define PG8_BAR __builtin_amdgcn_s_barrier()
#define PG8_SCHED __builtin_amdgcn_sched_barrier(0)
    Unit cur, nxt; int ui = 0;
    if (!S.next(0, cur)) return;
    f32x4 acc[2][2][4][2];
#pragma unroll
    for (int a = 0; a < 2; ++a)
#pragma unroll
        for (int b = 0; b < 2; ++b)
#pragma unroll
            for (int m = 0; m < 4; ++m)
#pragma unroll
                for (int n = 0; n < 2; ++n) acc[a][b][m][n] = (f32x4){0.f, 0.f, 0.f, 0.f};
    bf16x8 At[4][2], B0[2][2], B1[2][2];
    const char* cA = (const char*)g.A + (size_t)cur.pm * tstepA; const char* cB = (const char*)g.Bt + (size_t)cur.pn * tstepB;
    S.a_ready(cur);
    if constexpr (SP2) {
        PG8_STAGE(PG8_SB(0, 0), cB, voffB); PG8_STAGE(PG8_SB(0, 1), cB + hstepB, voffB); PG8_STAGE(PG8_SA(0, 0), cA, voffA); PG8_STAGE(PG8_SA(0, 1), cA + hstepA, voffA);
        if (wr == 1) PG8_BAR;
        PG8_WAIT_V(2); PG8_BAR;
        PG8_STAGE(PG8_SB(1, 0), cB + kstep, voffB); PG8_STAGE(PG8_SA(1, 0), cA + kstep, voffA); PG8_STAGE(PG8_SB(1, 1), cB + hstepB + kstep, voffB);
        PG8_WAIT_V(6); PG8_BAR;
    } else {
        PG8_STAGE(PG8_SB(0, 0), cB, voffB); PG8_STAGE(PG8_SA(0, 0), cA, voffA); PG8_STAGE(PG8_SB(0, 1), cB + hstepB, voffB); PG8_STAGE(PG8_SA(0, 1), cA + hstepA, voffA);
        if (wr == 1) PG8_BAR;
        PG8_WAIT_V(4); PG8_BAR;
        PG8_STAGE(PG8_SB(1, 0), cB + kstep, voffB); PG8_STAGE(PG8_SA(1, 0), cA + kstep, voffA); PG8_STAGE(PG8_SB(1, 1), cB + hstepB + kstep, voffB);
        PG8_WAIT_V(6); PG8_BAR;
    }
    for (;;) {
        const bool has_next = S.next(ui + 1, nxt);
        const char* nA = has_next ? (const char*)g.A + (size_t)nxt.pm * tstepA : cA; const char* nB = has_next ? (const char*)g.Bt + (size_t)nxt.pn * tstepB : cB;
        for (int t = 0; t < nt; t += 2) {
            const bool last = (t == nt - 2);
            const char* a1 = cA + (size_t)(t + 1) * kstep;
            const char* a2 = last ? nA : cA + (size_t)(t + 2) * kstep; const char* b2 = last ? nB : cB + (size_t)(t + 2) * kstep;
            const char* a3 = a2 + kstep; const char* b3 = b2 + kstep;
            if (last && has_next) S.a_ready(nxt);
            if constexpr (SP2) {
            PG8_LDB(B0, 0, 0); PG8_LDB(B1, 0, 1); PG8_SCHED; PG8_LDA(At, 0, 0); PG8_STAGE(PG8_SA(1, 1), a1 + hstepA, voffA);
            PG8_WAIT_V(8); PG8_WAIT_L(0); PG8_BAR; PG8_MMA(0, 0, At, B0); PG8_MMA(0, 1, At, B1); PG8_BAR; PG8_SCHED;
            PG8_LDA(At, 0, 1); PG8_STAGE(PG8_SB(0, 0), b2, voffB); PG8_STAGE(PG8_SB(0, 1), b2 + hstepB, voffB); PG8_STAGE(PG8_SA(0, 0), a2, voffA);
            PG8_WAIT_V(8); PG8_WAIT_L(0); PG8_BAR; PG8_MMA(1, 0, At, B0); PG8_MMA(1, 1, At, B1); PG8_BAR; PG8_SCHED;
            PG8_LDB(B0, 1, 0); PG8_LDB(B1, 1, 1); PG8_SCHED; PG8_LDA(At, 1, 0); PG8_STAGE(PG8_SA(0, 1), a2 + hstepA, voffA);
            PG8_WAIT_V(8); PG8_WAIT_L(0); PG8_BAR; PG8_MMA(0, 0, At, B0); PG8_MMA(0, 1, At, B1); PG8_BAR; PG8_SCHED;
            PG8_LDA(At, 1, 1); PG8_STAGE(PG8_SB(1, 0), b3, voffB); PG8_STAGE(PG8_SB(1, 1), b3 + hstepB, voffB); PG8_STAGE(PG8_SA(1, 0), a3, voffA);
            PG8_WAIT_V(8); PG8_WAIT_L(0); PG8_BAR; PG8_MMA(1, 0, At, B0); PG8_MMA(1, 1, At, B1); PG8_BAR; PG8_SCHED;
            } else {
            PG8_LDB(B0, 0, 0); PG8_SCHED; PG8_LDA(At, 0, 0); PG8_STAGE(PG8_SA(1, 1), a1 + hstepA, voffA);
            PG8_WAIT_L(8); PG8_BAR; PG8_WAIT_L(0); PG8_MMA(0, 0, At, B0); PG8_BAR; PG8_SCHED;
            PG8_LDB(B1, 0, 1); PG8_STAGE(PG8_SB(0, 0), b2, voffB);
            PG8_BAR; PG8_WAIT_L(0); PG8_MMA(0, 1, At, B1); PG8_BAR;
            PG8_LDA(At, 0, 1); PG8_STAGE(PG8_SA(0, 0), a2, voffA);
            PG8_BAR; PG8_WAIT_L(0); PG8_MMA(1, 0, At, B0); PG8_BAR; PG8_SCHED;
            PG8_STAGE(PG8_SB(0, 1), b2 + hstepB, voffB);
            PG8_WAIT_V(6); PG8_BAR; PG8_MMA(1, 1, At, B1); PG8_BAR;
            PG8_LDB(B0, 1, 0); PG8_SCHED; PG8_LDA(At, 1, 0); PG8_STAGE(PG8_SA(0, 1), a2 + hstepA, voffA);
            PG8_WAIT_L(8); PG8_BAR; PG8_WAIT_L(0); PG8_MMA(0, 0, At, B0); PG8_BAR; PG8_SCHED;
            PG8_LDB(B1, 1, 1); PG8_STAGE(PG8_SB(1, 0), b3, voffB);
            PG8_BAR; PG8_WAIT_L(0); PG8_MMA(0, 1, At, B1); PG8_BAR;
            PG8_LDA(At, 1, 1); PG8_STAGE(PG8_SA(1, 0), a3, voffA);
            PG8_BAR; PG8_WAIT_L(0); PG8_MMA(1, 0, At, B0); PG8_BAR; PG8_SCHED;
            PG8_STAGE(PG8_SB(1, 1), b3 + hstepB, voffB);
            PG8_WAIT_V(6); PG8_BAR; PG8_MMA(1, 1, At, B1); PG8_BAR;
            }
        }
        if constexpr (ALIGN_EPI) { if (wr == 0) PG8_BAR; }
        if constexpr (!Epi::AFTER_DRAIN) { E(acc, cur, wr, wc, fr, fq); S.done(cur); }
        if (!has_next) break;
#pragma unroll
        for (int a = 0; a < 2; ++a)
#pragma unroll
            for (int b = 0; b < 2; ++b)
#pragma unroll
                for (int m = 0; m < 4; ++m)
#pragma unroll
                    for (int n = 0; n < 2; ++n) acc[a][b][m][n] = (f32x4){0.f, 0.f, 0.f, 0.f};
        cur = nxt; cA = nA; cB = nB; ++ui;
        if constexpr (ALIGN_EPI) { if (wr == 1) PG8_BAR; }
    }
    PG8_WAIT_V(0);
    if constexpr (!ALIGN_EPI) { if (wr == 0) PG8_BAR; }
    PG8_BAR;
    if constexpr (Epi::AFTER_DRAIN) { E.fused(acc, cur, wr, wc, fr, fq, lds, wid, lane); S.done(cur); }
#undef PG8_SA
#undef PG8_SB
#undef PG8_STAGE
#undef PG8_LDA
#undef PG8_LDB
#undef PG8_MMA
#undef PG8_WAIT_V
#undef PG8_WAIT_L
#undef PG8_BAR
#undef PG8_SCHED
}
}

__device__ __forceinline__ int crow(int r, int hi) { return (r & 3) + 8 * (r >> 2) + 4 * hi; }
__device__ __forceinline__ void glds16(const void* gsrc, unsigned lds_dst) { unsigned keep;
    asm volatile("s_mov_b32 %0, m0\n\ts_mov_b32 m0, %2\n\ts_nop 0\n\tglobal_load_lds_dwordx4 %1, off\n\ts_mov_b32 m0, %0" : "=&s"(keep) : "v"(gsrc), "s"(lds_dst) : "memory"); }
typedef float f32x2_t __attribute__((ext_vector_type(2))); typedef __bf16 bf16x2_t __attribute__((ext_vector_type(2)));
__device__ __forceinline__ unsigned cvtpk(float lo, float hi) { f32x2_t v = {lo, hi}; bf16x2_t b = __builtin_convertvector(v, bf16x2_t); return __builtin_bit_cast(unsigned, b); }
typedef short v4i16_t __attribute__((ext_vector_type(4)));
__device__ __forceinline__ s16x4 vtr(const LAS char* p) { return __builtin_bit_cast(s16x4, __builtin_amdgcn_ds_read_tr16_b64_v4i16((LAS v4i16_t*)p)); }
#define WAIT_BAR(N) asm volatile("s_waitcnt vmcnt(" #N ") lgkmcnt(0)\n\ts_barrier" ::: "memory")
constexpr int AT_SLOT = 32768, AT_NSLOT = 4, AT_WSF = AT_SLOT * AT_NSLOT, AT_XS = 132;

__device__ __forceinline__ void attn_unit(KP p, int layer, LAS char* lds, int b, int h, int q0, int isctx) {
    const int tid = tid_opaque(), lane = tid & 63, r32 = lane & 31, hi = lane >> 5;
    const int wave = __builtin_amdgcn_readfirstlane(tid >> 6), qg = wave & 3, map = wave >> 2;
    const float* ctl = (const float*)(p->ws + WS_CTL);
    const float lam = ctl[CF_LAM + layer], mb = ctl[CF_MB + layer];
    bf16_t* P = (bf16_t*)(p->ws + WS_PROJ);
    const unsigned lds0 = (unsigned)(uintptr_t)lds;
    const int NT = isctx ? CTXL / 64 : (SEQ + CTXL) / 64;
    const int rowq0 = seq_row0(b, isctx) + q0 + qg * 32;
#define AT_KROW0(t) (isctx ? (ML + b * CTXL + (t) * 64) : ((t) < SEQ / 64 ? (b * SEQ + (t) * 64) : (ML + b * CTXL + ((t) - SEQ / 64) * 64)))
#define AT_DMA(t) do { const int kr0_ = AT_KROW0(t); const unsigned sl_ = lds0 + (unsigned)(((t) & 3) * AT_SLOT); \
        const bf16_t* kb_ = P + (size_t)(kr0_ + lane) * PITCH + C_AK + h * 128; \
        glds16(kb_ + wave * 8, (unsigned)__builtin_amdgcn_readfirstlane(sl_ + wave * 1024)); \
        glds16(kb_ + (wave + 8) * 8, (unsigned)__builtin_amdgcn_readfirstlane(sl_ + (wave + 8) * 1024)); \
        const bf16_t* vb_ = P + (size_t)(kr0_ + 16 * (wave & 3) + (lane >> 2)) * PITCH + C_AV + h * 128 + (lane & 3) * 8; \
        glds16(vb_ + (wave >> 2) * 32, (unsigned)__builtin_amdgcn_readfirstlane(sl_ + 16384 + (wave >> 2) * 4096 + (wave & 3) * 1024)); \
        glds16(vb_ + ((wave >> 2) + 2) * 32, (unsigned)__builtin_amdgcn_readfirstlane(sl_ + 16384 + ((wave >> 2) + 2) * 4096 + (wave & 3) * 1024)); } while (0)
    AT_DMA(0); AT_DMA(1); AT_DMA(2);
    bf16x8 qr[4];
    {
        const bf16_t* qp = P + (size_t)(rowq0 + r32) * PITCH + C_AQ + h * 128 + map * 64 + hi * 8;
#pragma unroll
        for (int ks = 0; ks < 4; ++ks) qr[ks] = *(const bf16x8*)(qp + ks * 16);
    }
    asm volatile("" : "+v"(qr[0]), "+v"(qr[1]), "+v"(qr[2]), "+v"(qr[3]));
    f32x16 o[4];
#pragma unroll
    for (int d = 0; d < 4; ++d)
#pragma unroll
        for (int r = 0; r < 16; ++r) o[d][r] = 0.f;
    f32x16 negm;
#pragma unroll
    for (int r = 0; r < 16; ++r) negm[r] = -mb;
    float l = 0.f;
    const int koff = map * 8192 + hi * 1024 + r32 * 16;
    const int voff = 16384 + ((lane >> 4) & 1) * 32 + (lane & 3) * 8 + (4 * hi + ((lane & 15) >> 2)) * 64;
    for (int t = 0; t < NT; ++t) {
        const int ahead = NT - 1 - t;
        if (ahead >= 2) { WAIT_BAR(8); } else if (ahead == 1) { WAIT_BAR(4); } else { WAIT_BAR(0); }
        if (t + 3 < NT) AT_DMA(t + 3);
        const LAS char* sl = lds + (t & 3) * AT_SLOT;
        const LAS char* kp = sl + koff; const LAS char* vp = sl + voff;
        f32x16 p0 = negm, p1 = negm;
#pragma unroll
        for (int ks = 0; ks < 4; ++ks) {
            const bf16x8 a0 = *(const LAS bf16x8*)(kp + ks * 2048), a1 = *(const LAS bf16x8*)(kp + ks * 2048 + 512);
            p0 = __builtin_amdgcn_mfma_f32_32x32x16_bf16(a0, qr[ks], p0, 0, 0, 0);
            p1 = __builtin_amdgcn_mfma_f32_32x32x16_bf16(a1, qr[ks], p1, 0, 0, 0);
        }
        float sacc = 0.f;
#pragma unroll
        for (int r = 0; r < 16; ++r) { p0[r] = __builtin_amdgcn_exp2f(p0[r]); p1[r] = __builtin_amdgcn_exp2f(p1[r]); sacc += p0[r] + p1[r]; }
        l += sacc;
        u32x4 pw[4];
#pragma unroll
        for (int j = 0; j < 4; ++j) { pw[0][j] = cvtpk(p0[2 * j], p0[2 * j + 1]); pw[1][j] = cvtpk(p0[8 + 2 * j], p0[8 + 2 * j + 1]);
                                      pw[2][j] = cvtpk(p1[2 * j], p1[2 * j + 1]); pw[3][j] = cvtpk(p1[8 + 2 * j], p1[8 + 2 * j + 1]); }
#pragma unroll
        for (int d0 = 0; d0 < 4; ++d0)
#pragma unroll
            for (int ks = 0; ks < 4; ++ks) {
                const s16x4 lo = vtr(vp + d0 * 4096 + ks * 1024), hh = vtr(vp + d0 * 4096 + ks * 1024 + 512);
                const bf16x8 vf = (bf16x8){lo[0], lo[1], lo[2], lo[3], hh[0], hh[1], hh[2], hh[3]};
                o[d0] = __builtin_amdgcn_mfma_f32_32x32x16_bf16(__builtin_bit_cast(bf16x8, pw[ks]), vf, o[d0], 0, 0, 0);
            }
    }
    l += __shfl_xor(l, 32);
    WAIT_BAR(0);
    LAS float* wsf = (LAS float*)(lds + AT_WSF) + wave * 32;
    if (hi == 0) wsf[r32] = l;
    asm volatile("s_waitcnt lgkmcnt(0)" ::: "memory");
    LAS float* X = (LAS float*)lds + qg * (32 * AT_XS);
    const float fm = map ? lam : 1.f;
    if (map == 1) {
#pragma unroll
        for (int r = 0; r < 16; ++r) { const int row = crow(r, hi); const float f = fm / wsf[row];
#pragma unroll
            for (int d0 = 0; d0 < 4; ++d0) X[row * AT_XS + d0 * 32 + r32] = o[d0][r] * f; }
    }
    WAIT_BAR(0);
    if (map == 0) {
#pragma unroll
        for (int r = 0; r < 16; ++r) { const int row = crow(r, hi); const float f = fm / wsf[row];
#pragma unroll
            for (int d0 = 0; d0 < 4; ++d0) { const int xi = row * AT_XS + d0 * 32 + r32; X[xi] = o[d0][r] * f - X[xi]; } }
        asm volatile("s_waitcnt lgkmcnt(0)" ::: "memory");
        const int row = lane >> 1, half = lane & 1;
        float xv[64]; float ss = 0.f;
#pragma unroll
        for (int i = 0; i < 64; i += 4) { const f32x4 v = *(const LAS f32x4*)(X + row * AT_XS + half * 64 + i); xv[i] = v[0]; xv[i + 1] = v[1]; xv[i + 2] = v[2]; xv[i + 3] = v[3];
            ss += v[0] * v[0] + v[1] * v[1] + v[2] * v[2] + v[3] * v[3]; }
        ss += __shfl_xor(ss, 1);
        const float rs = rsqrtf(ss * (1.f / 128.f) + EPS) * (1.f - lam_init_of(layer));
        const float* sub = p->in[14] + layer * 128 + half * 64;
        bf16_t* gp = P + (size_t)(rowq0 + row) * PITCH + C_AG + h * 128 + half * 64;
        bf16_t* op = P + (size_t)(rowq0 + row) * PITCH + C_AQ + h * 128 + half * 64;
#pragma unroll
        for (int i = 0; i < 64; i += 8) {
            const u32x4 gw = *(const u32x4*)(gp + i);
            const float g0 = __uint_as_float(gw.x << 16), g1 = __uint_as_float(gw.x & 0xffff0000u), g2 = __uint_as_float(gw.y << 16), g3 = __uint_as_float(gw.y & 0xffff0000u);
            const float g4 = __uint_as_float(gw.z << 16), g5 = __uint_as_float(gw.z & 0xffff0000u), g6 = __uint_as_float(gw.w << 16), g7 = __uint_as_float(gw.w & 0xffff0000u);
            u32x4 w;
            w.x = pk2(xv[i] * rs * sub[i] * siluf(g0), xv[i + 1] * rs * sub[i + 1] * siluf(g1));
            w.y = pk2(xv[i + 2] * rs * sub[i + 2] * siluf(g2), xv[i + 3] * rs * sub[i + 3] * siluf(g3));
            w.z = pk2(xv[i + 4] * rs * sub[i + 4] * siluf(g4), xv[i + 5] * rs * sub[i + 5] * siluf(g5));
            w.w = pk2(xv[i + 6] * rs * sub[i + 6] * siluf(g6), xv[i + 7] * rs * sub[i + 7] * siluf(g7));
            *(u32x4*)(op + i) = w;
        }
    }
    WAIT_BAR(0);
#undef AT_DMA
#undef AT_KROW0
}
__device__ __forceinline__ void phase_attn(KP p, int layer, LAS char* lds, int blk, int nblk) {
    const int nunits = 512 + (layer == 0 ? 16 : 0);
    for (int u = blk; u < nunits; u += nblk) {
        if (u < 512) { const int bh = u & 7, qb = u >> 3; attn_unit(p, layer, lds, bh >> 2, bh & 3, qb * 128, 0); }
        else { const int j = u - 512; attn_unit(p, layer, lds, j >> 3, (j >> 1) & 3, (j & 1) * 128, 1); }
    }
}

__device__ __forceinline__ void phase_prep(KP p, int layer, int blk, int nblk) {
    const int tid = tid_opaque(), lane = tid & 63, wave = tid >> 6, nw = blockDim.x >> 6;
    bf16_t* P = (bf16_t*)(p->ws + WS_PROJ);
    const float gq = p->in[8][layer * 64 + lane], gk = p->in[9][layer * 64 + lane];
    const int ai = lane & 31;
    const float invf = exp2f(-(float)(ai & 15) * (13.287712379549449f / 16.f));
    for (int r = blk * nw + wave; r < MT; r += nblk * nw) {
        const RowInfo ri = row_info(r);
        float cs = 1.f, sn = 0.f;
        if (!ri.isctx) { const float pos = (ai < 16) ? (float)(ri.t >> 6) : (float)(ri.t & 63); const float ang = pos * invf; cs = cosf(ang); sn = sinf(ang); }
        bf16_t* row = P + (size_t)r * PITCH;
#pragma unroll
        for (int v = 0; v < 16; ++v) {
            bf16_t* ptr = row + (v < 8 ? C_AQ + v * 64 : C_AK + (v - 8) * 64) + lane;
            float x = bf2f(*ptr);
            const float ss = wave_sum(x * x);
            x = x * rsqrtf(ss * (1.f / 64.f) + EPS) * (v < 8 ? gq : gk);
            const float o = __shfl_xor(x, 32);
            float y = (lane < 32) ? (x * cs - o * sn) : (o * sn + x * cs);
            if (v < 8) y *= 0.125f * LOG2E;
            *ptr = f2bf(y);
        }
#pragma unroll
        for (int v = 0; v < 8; ++v) {
            bf16_t* ptr = row + (v < 4 ? C_RQ + v * 64 : C_RK + (v - 4) * 64) + lane;
            float x = bf2f(*ptr);
            const float o = __shfl_xor(x, 32);
            float y = (lane < 32) ? (x * cs - o * sn) : (o * sn + x * cs);
            if (v >= 4) y *= 0.125f;
            *ptr = f2bf(y);
        }
    }
}

template <int KIND>
__device__ __forceinline__ void scan_naive_unit(KP p, int layer, float* ldsf, int b, int head) {
    constexpr int N = KIND == 0 ? 128 : 64, PD = KIND == 0 ? 64 : 128, TC = 32;
    float (*qs)[N] = (float (*)[N])ldsf; float (*ks)[N] = (float (*)[N])(ldsf + TC * N); float (*vs)[PD] = (float (*)[PD])(ldsf + 2 * TC * N); float* as_ = ldsf + 2 * TC * N + TC * PD;
    const int tid = tid_opaque();
    const int g = head >> 3;
    bf16_t* P = (bf16_t*)(p->ws + WS_PROJ);
    const float* cw = p->in[15] + (size_t)layer * 3 * 1536; const float* cb = p->in[16] + (size_t)layer * 1536;
    const float Dh = KIND == 0 ? p->in[19][layer * 16 + head] : 0.f;
    float S[N];
    for (int dir = 0; dir < 2; ++dir) {
#pragma unroll
        for (int n = 0; n < N; ++n) S[n] = 0.f;
        float dtb = 0.f, aexp = 0.f, lar = 0.f;
        if (KIND == 0) { dtb = p->in[17][(layer * 2 + dir) * 16 + head]; aexp = expf(p->in[18][(layer * 2 + dir) * 16 + head]); }
        else { const float e = (dir == 0 ? 5.0f : 5.5f) + (float)head; lar = log1pf(-exp2f(-e)); }
        for (int seg = 0; seg < 2; ++seg) {
            const int isctx = seg == 0, L = isctx ? CTXL : SEQ, r0 = seq_row0(b, isctx);
            for (int c0 = 0; c0 < L; c0 += TC) {
                const int tbase = dir == 0 ? c0 : L - TC - c0;
                __syncthreads();
                if (KIND == 0) {
                    for (int i = tid; i < TC * 320; i += blockDim.x) {
                        const int tt = i / 320, cc = i % 320;
                        const int col = cc < 64 ? head * 64 + cc : (cc < 192 ? 1024 + g * 128 + (cc - 64) : 1280 + g * 128 + (cc - 192));
                        const int t = tbase + tt;
                        float acc = cb[col];
#pragma unroll
                        for (int k = 0; k < 3; ++k) { const int ts = t + k - 1; if (ts >= 0 && ts < L) acc += cw[k * 1536 + col] * bf2f(P[(size_t)(r0 + ts) * PITCH + C_XBC + col]); }
                        const float uu = siluf(acc);
                        if (cc < 64) vs[tt][cc] = uu; else if (cc < 192) ks[tt][cc - 64] = uu; else qs[tt][cc - 192] = uu;
                    }
                    if (tid < TC) {
                        const float dtr = bf2f(P[(size_t)(r0 + tbase + tid) * PITCH + C_DTR + dir * 16 + head]) + dtb;
                        const float dt = dtr > 20.f ? dtr : log1pf(expf(dtr));
                        as_[tid] = dt;
                    }
                } else {
                    for (int i = tid; i < TC * 256; i += blockDim.x) {
                        const int tt = i / 256, cc = i % 256; const size_t rr = (size_t)(r0 + tbase + tt) * PITCH;
                        if (cc < 64) qs[tt][cc] = bf2f(P[rr + C_RQ + head * 64 + cc]);
                        else if (cc < 128) ks[tt][cc - 64] = bf2f(P[rr + C_RK + head * 64 + cc - 64]);
                        else vs[tt][cc - 128] = bf2f(P[rr + C_RV + head * 128 + cc - 128]);
                    }
                }
                __syncthreads();
                if (tid < PD)
                for (int s = 0; s < TC; ++s) {
                    const int tt = dir == 0 ? s : TC - 1 - s;
                    float a, v;
                    if (KIND == 0) { const float dt = as_[tt]; a = expf(-dt * aexp); v = vs[tt][tid] * dt; }
                    else { a = expf(lar); v = vs[tt][tid]; }
                    float y = 0.f;
#pragma unroll
                    for (int n = 0; n < N; ++n) { S[n] = a * S[n] + ks[tt][n] * v; y += qs[tt][n] * S[n]; }
                    bf16_t* yp = P + (size_t)(r0 + tbase + tt) * PITCH + (KIND == 0 ? C_YS + head * 64 : C_YR + head * 128) + tid;
                    if (dir == 0) *yp = f2bf(y);
                    else { float tot = bf2f(*yp) + y; if (KIND == 0) tot += Dh * vs[tt][tid]; *yp = f2bf(tot); }
                }
            }
        }
    }
}

__device__ __forceinline__ void phase_fin(KP p, int layer, int blk, int nblk) {
    const int tid = tid_opaque(), lane = tid & 63, wave = tid >> 6, nw = blockDim.x >> 6;
    bf16_t* P = (bf16_t*)(p->ws + WS_PROJ);
    const float* snorm = p->in[20] + layer * 1024; const float* rnorm = p->in[21] + layer * 128;
    for (int r = blk * nw + wave; r < MT; r += nblk * nw) {
        bf16_t* row = P + (size_t)r * PITCH;
#pragma unroll
        for (int g = 0; g < 2; ++g) {
            const int c0 = g * 512 + lane * 8;
            float v[8]; float ss = 0.f;
#pragma unroll
            for (int j = 0; j < 8; ++j) { v[j] = bf2f(row[C_YS + c0 + j]) * siluf(bf2f(row[C_Z + c0 + j])); ss += v[j] * v[j]; }
            const float rs = rsqrtf(wave_sum(ss) * (1.f / 512.f) + EPS);
#pragma unroll
            for (int j = 0; j < 8; ++j) row[C_Z + c0 + j] = f2bf(v[j] * rs * snorm[c0 + j]);
        }
        {
            const int c0 = lane * 8;
            float v[8]; float ss = 0.f;
#pragma unroll
            for (int j = 0; j < 8; ++j) { v[j] = bf2f(row[C_YR + c0 + j]); ss += v[j] * v[j]; }
#pragma unroll
            for (int o = 1; o < 16; o <<= 1) ss += __shfl_xor(ss, o);
            const float rs = rsqrtf(ss * (1.f / 128.f) + EPS);
#pragma unroll
            for (int j = 0; j < 8; ++j) row[C_RG + c0 + j] = f2bf(v[j] * rs * rnorm[(c0 + j) & 127] * siluf(bf2f(row[C_RG + c0 + j])));
        }
    }
}

__global__ __launch_bounds__(512, 2) void hybrid_fwd(Params p_) {
    extern __shared__ __attribute__((aligned(16))) unsigned char ldsb[];
    cg::grid_group grid = cg::this_grid();
    LAS char* lds = (LAS char*)ldsb;
    float* ldsf = (float*)ldsb;
    const int blk = blockIdx.x, nblk = gridDim.x;

    phase_ada(kargs(), ldsf, blk, nblk);
    __syncthreads();
    phase_convw(kargs(), 0, ldsf, blk, nblk);
    grid.sync();
    for (int layer = 0; layer < DEPTH; ++layer) {
        if (layer > 0) phase_convw(kargs(), layer, ldsf, blk, nblk);
        phase_norm(kargs(), layer, blk, nblk);
        grid.sync();
        {
            KP p = kargs();
            pg8::Gemm g{(const bf16_t*)(p->ws + WS_H), (const bf16_t*)(p->ws + WS_WINT), MT, NPAD, DM, DM};
            pg8::StaticOrder S; S.init(MT, NPAD, nblk, blk);
            pg8::EpiProj E{(bf16_t*)(p->ws + WS_PROJ)};
            pg8::gemm_phase<pg8::EpiProj, pg8::StaticOrder, true, true>((LAS unsigned char*)lds, g, S, E);
        }
        grid.sync();
        phase_prep(kargs(), layer, blk, nblk);
        grid.sync();
        phase_attn(kargs(), layer, lds, blk, nblk);
        grid.sync();
        for (int u = blk; u < 40; u += nblk) {
            if (u < 32) scan_naive_unit<0>(kargs(), layer, ldsf, u >> 4, u & 15);
            else scan_naive_unit<1>(kargs(), layer, ldsf, (u - 32) >> 2, (u - 32) & 3);
        }
        grid.sync();
        phase_fin(kargs(), layer, blk, nblk);
        grid.sync();
        {
            KP p = kargs(); const float* ctl = (const float*)(p->ws + WS_CTL);
            const int M = layer == 0 ? MT : ML;
            pg8::Gemm g{(const bf16_t*)(p->ws + WS_PROJ), (const bf16_t*)(p->ws + WS_WOUTT), M, DM, DMIX, PITCH};
            pg8::StaticOrder S; S.init(M, DM, nblk, blk);
            pg8::EpiResid E{layer == 0 ? p->in[0] : p->out, p->out, p->in[2], (float*)(p->ws + WS_CTXN), ctl + CF_MOD + layer * 3 * 3072};
            pg8::gemm_phase<pg8::EpiResid, pg8::StaticOrder, true, true>((LAS unsigned char*)lds, g, S, E);
        }
        if (layer + 1 < DEPTH) grid.sync();
    }
}

extern "C" void kernel_launch(void* const* d_in, const int* in_sizes, int n_in, void* d_out, int out_size, void* d_ws, size_t ws_size, hipStream_t stream) {
    if (n_in != 22 || ws_size < WS_END || out_size != ML * DM) { fprintf(stderr, "kernel_launch: unexpected shapes (n_in %d, ws %zu, out %d)\n", n_in, ws_size, out_size); return; }
    static int grid_blocks = 0;
    if (!grid_blocks) {
        int dev = 0, cus = 0, per_cu = 0;
        (void)hipGetDevice(&dev);
        (void)hipDeviceGetAttribute(&cus, hipDeviceAttributeMultiprocessorCount, dev);
        (void)hipFuncSetAttribute((const void*)hybrid_fwd, hipFuncAttributeMaxDynamicSharedMemorySize, LDS_BYTES);
        (void)hipOccupancyMaxActiveBlocksPerMultiprocessor(&per_cu, (const void*)hybrid_fwd, 512, LDS_BYTES);
        if (per_cu < 1) { fprintf(stderr, "kernel_launch: occupancy query says %d blocks per CU\n", per_cu); per_cu = 1; }
        grid_blocks = cus;
        (void)hipGetLastError();
    }
    Params p{};
    for (int i = 0; i < 22; ++i) p.in[i] = (const float*)d_in[i];
    p.out = (float*)d_out; p.ws = (unsigned char*)d_ws; p.layer = 0; p.pad = 0;
    void* args[] = {&p};
    hipError_t e = hipLaunchCooperativeKernel((const void*)hybrid_fwd, dim3(grid_blocks), dim3(512), args, LDS_BYTES, stream);
    if (e != hipSuccess) fprintf(stderr, "cooperative launch failed: %s (grid %d)\n", hipGetErrorString(e), grid_blocks);
}
```

```cpp
#include <hip/hip_runtime.h>
#include <hip/hip_cooperative_groups.h>
namespace cg = cooperative_groups;
#include <cstdio>
#include <cstdint>

constexpr int DM = 1024, NB = 2, SEQ = 8192, CTXL = 256, DEPTH = 2;
constexpr int ML = NB * SEQ, MC = NB * CTXL, MT = ML + MC;
constexpr int NPROJ = 6176, NPAD = 6400, PITCH = 6208, DMIX = 2048;
constexpr int C_AQ = 0, C_Z = 512, C_RG = 1536, C_AK = 2048, C_AV = 2560, C_AG = 3072, C_XBC = 3584, C_XS = 3584, C_BM = 4608, C_CM = 4864,
              C_RQ = 5120, C_RK = 5376, C_RV = 5632, C_DTR = 6144;
constexpr int C_YS = 2048  , C_YR = 3072  ;
constexpr float EPS = 1e-6f;
constexpr float LOG2E = 1.4426950408889634f;

typedef unsigned short bf16_t;
typedef short bf16x8 __attribute__((ext_vector_type(8)));
typedef float f32x4 __attribute__((ext_vector_type(4)));
typedef unsigned u32x4 __attribute__((ext_vector_type(4)));
typedef float f32x16 __attribute__((ext_vector_type(16)));
typedef short s16x4 __attribute__((ext_vector_type(4)));
typedef unsigned u32x2 __attribute__((ext_vector_type(2)));
#define LAS __attribute__((address_space(3)))
constexpr int LDS_BYTES = 147456;

constexpr size_t MiB = 1u << 20;
constexpr size_t WS_CTL = 0;
constexpr size_t WS_PROJ = 1 * MiB;
constexpr size_t PROJ_BYTES = (size_t)MT * PITCH * 2;
constexpr size_t WS_H = WS_PROJ + ((PROJ_BYTES + 4095) / 4096) * 4096;
constexpr size_t H_BYTES = (size_t)MT * DM * 2;
constexpr size_t WS_WINT = WS_H + H_BYTES;
constexpr size_t WINT_BYTES = (size_t)NPAD * DM * 2;
constexpr size_t WS_WOUTT = WS_WINT + WINT_BYTES;
constexpr size_t WOUTT_BYTES = (size_t)DM * DMIX * 2;
constexpr size_t WS_CTXN = WS_WOUTT + WOUTT_BYTES;
constexpr size_t CTXN_BYTES = (size_t)MC * DM * 4;
constexpr size_t WS_END = WS_CTXN + CTXN_BYTES;
static_assert(WS_END <= 256 * MiB, "workspace map exceeds 256 MiB");
constexpr int CF_MOD = 1024;
constexpr int CF_LAM = 512, CF_MB = 516;

struct Params {
    const float* in[22];
    float* out;
    unsigned char* ws;
    int layer; int pad;
};
typedef const __attribute__((address_space(4))) Params* KP;
__device__ __forceinline__ KP kargs() { KP k = (KP)__builtin_amdgcn_kernarg_segment_ptr(); asm volatile("" : "+s"(k)); return k; }

__device__ __forceinline__ int tid_opaque() { int t = threadIdx.x; asm volatile("" : "+v"(t)); return t; }
__device__ __forceinline__ float bf2f(bf16_t v) { return __uint_as_float((unsigned)v << 16); }
__device__ __forceinline__ bf16_t f2bf(float f) { unsigned u = __float_as_uint(f); return (bf16_t)((u + 0x7fffu + ((u >> 16) & 1u)) >> 16); }
__device__ __forceinline__ unsigned pk2(float lo, float hi) { return (unsigned)f2bf(lo) | ((unsigned)f2bf(hi) << 16); }
__device__ __forceinline__ float siluf(float x) { return x / (1.f + __expf(-x)); }
__device__ __forceinline__ float wave_sum(float v) {
#pragma unroll
    for (int o = 1; o < 64; o <<= 1) v += __shfl_xor(v, o);
    return v;
}
__device__ __forceinline__ float lam_init_of(int layer) { return 0.8f - 0.6f * __expf(-0.3f * (float)layer); }

struct RowInfo { int b, t, L, isctx; };
__device__ __forceinline__ RowInfo row_info(int r) {
    RowInfo i;
    if (r < ML) { i.b = r >> 13; i.t = r & (SEQ - 1); i.L = SEQ; i.isctx = 0; }
    else { const int rr = r - ML; i.b = rr >> 8; i.t = rr & (CTXL - 1); i.L = CTXL; i.isctx = 1; }
    return i;
}
__device__ __forceinline__ int seq_row0(int b, int isctx) { return isctx ? ML + b * CTXL : b * SEQ; }

__device__ __forceinline__ void phase_ada(KP p, float* lds, int blk, int nblk) {
    const int tid = tid_opaque();
    float* ctl = (float*)(p->ws + WS_CTL);
    const float* c = p->in[1]; const float* cc = p->in[3];
    for (int i = tid; i < 3 * DM; i += blockDim.x) {
        const int v = i / DM, k = i % DM;
        const float x = (v < 2) ? c[v * DM + k] : cc[k];
        lds[i] = siluf(x);
    }
    __syncthreads();
    float* red = lds + 3 * DM;
    for (int grp = blk; grp < 256; grp += nblk) {
        const int layer = grp / 128, col0 = (grp % 128) * 24;
        const float* w = p->in[4] + (size_t)layer * DM * 3072;
        const int cl = tid & 31, kg = tid >> 5;
        float a0 = 0.f, a1 = 0.f, a2 = 0.f;
        if (cl < 24) {
            for (int i = 0; i < 64; ++i) {
                const int k = kg * 64 + i;
                const float wv = w[(size_t)k * 3072 + col0 + cl];
                a0 += lds[k] * wv; a1 += lds[DM + k] * wv; a2 += lds[2 * DM + k] * wv;
            }
        }
        red[(kg * 32 + cl) * 3 + 0] = a0; red[(kg * 32 + cl) * 3 + 1] = a1; red[(kg * 32 + cl) * 3 + 2] = a2;
        __syncthreads();
        if (tid < 72) {
            const int v = tid / 24, cc2 = tid % 24;
            float s = 0.f;
            for (int g = 0; g < 16; ++g) s += red[(g * 32 + cc2) * 3 + v];
            s += p->in[5][layer * 3072 + col0 + cc2];
            ctl[CF_MOD + (layer * 3 + v) * 3072 + col0 + cc2] = s;
        }
        __syncthreads();
    }
    if (blk == 0 && tid < 64) {
        for (int layer = 0; layer < DEPTH; ++layer) {
            const float q1 = p->in[10][layer * 64 + tid] * p->in[11][layer * 64 + tid];
            const float q2 = p->in[12][layer * 64 + tid] * p->in[13][layer * 64 + tid];
            const float s1 = wave_sum(q1), s2 = wave_sum(q2);
            float gq = fabsf(p->in[8][layer * 64 + tid]), gk = fabsf(p->in[9][layer * 64 + tid]);
#pragma unroll
            for (int o = 1; o < 64; o <<= 1) { gq = fmaxf(gq, __shfl_xor(gq, o)); gk = fmaxf(gk, __shfl_xor(gk, o)); }
            if (tid == 0) {
                ctl[CF_LAM + layer] = expf(s1) - expf(s2) + lam_init_of(layer);
                ctl[CF_MB + layer] = 8.0f * gq * gk * LOG2E * 1.03f + 0.5f;
            }
        }
    }
}

__device__ __forceinline__ int win_src_col(int n) {
    if (n < 512) return n;
    if (n < 1536) return 3616 + (n - 512);
    if (n < 2048) return 5664 + (n - 1536);
    if (n < 2560) return 512 + (n - 2048);
    if (n < 3072) return 1024 + (n - 2560);
    if (n < 3584) return 1536 + (n - 3072);
    if (n < 5120) return 2048 + (n - 3584);
    if (n < 5376) return 4640 + (n - 5120);
    if (n < 5632) return 4896 + (n - 5376);
    if (n < 6144) return 5152 + (n - 5632);
    if (n < 6176) return 3584 + (n - 6144);
    return -1;
}
__device__ __forceinline__ void transpose_item(const float* W, int K, int N, int srccol, bf16_t* WT, int k0, int n0, float* scr, int lane) {
    if (srccol >= 0) {
#pragma unroll 8
        for (int i = 0; i < 32; ++i) { const int kk = 2 * i + (lane >> 5); scr[kk * 33 + (lane & 31)] = W[(size_t)(k0 + kk) * N + srccol + (lane & 31)]; }
    } else {
#pragma unroll 8
        for (int i = 0; i < 32; ++i) { const int kk = 2 * i + (lane >> 5); scr[kk * 33 + (lane & 31)] = 0.f; }
    }
    __builtin_amdgcn_s_waitcnt(0xC07F); asm volatile("" ::: "memory");
    const int c = lane & 7;
#pragma unroll
    for (int j = 0; j < 4; ++j) {
        const int n = (lane >> 3) + 8 * j; const float* s = scr + (8 * c) * 33 + n;
        u32x4 o; o.x = pk2(s[0 * 33], s[1 * 33]); o.y = pk2(s[2 * 33], s[3 * 33]); o.z = pk2(s[4 * 33], s[5 * 33]); o.w = pk2(s[6 * 33], s[7 * 33]);
        *(u32x4*)(WT + (size_t)(n0 + n) * K + k0 + 8 * c) = o;
    }
    __builtin_amdgcn_s_waitcnt(0xC07F); asm volatile("" ::: "memory");
}
__device__ __forceinline__ void phase_convw(KP p, int layer, float* lds, int blk, int nblk) {
    const int tid = tid_opaque(), lane = tid & 63, wave = tid >> 6, nw = blockDim.x >> 6;
    float* scr = lds + wave * (64 * 33);
    const int gw = blk * nw + wave, NGW = nblk * nw;
    const float* win = p->in[6] + (size_t)layer * DM * NPROJ;
    const float* wout = p->in[7] + (size_t)layer * DMIX * DM;
    bf16_t* wint = (bf16_t*)(p->ws + WS_WINT); bf16_t* woutt = (bf16_t*)(p->ws + WS_WOUTT);
    constexpr int I_IN = (DM / 64) * (NPAD / 32), I_OUT = (DMIX / 64) * (DM / 32);
    for (int it = gw; it < I_IN + I_OUT; it += NGW) {
        if (it < I_IN) { const int nb = it % (NPAD / 32), kb = it / (NPAD / 32); transpose_item(win, DM, NPROJ, win_src_col(nb * 32), wint, kb * 64, nb * 32, scr, lane); }
        else { const int r = it - I_IN; const int nb = r % (DM / 32), kb = r / (DM / 32); transpose_item(wout, DMIX, DM, nb * 32, woutt, kb * 64, nb * 32, scr, lane); }
    }
}

__device__ __forceinline__ void phase_norm(KP p, int layer, int blk, int nblk) {
    const int tid = tid_opaque(), lane = tid & 63, wave = tid >> 6, nw = blockDim.x >> 6;
    const float* ctl = (const float*)(p->ws + WS_CTL);
    bf16_t* H = (bf16_t*)(p->ws + WS_H);
    const float* xl = layer == 0 ? p->in[0] : p->out;
    const float* xc = layer == 0 ? p->in[2] : (const float*)(p->ws + WS_CTXN);
    for (int r = blk * nw + wave; r < MT; r += nblk * nw) {
        const RowInfo ri = row_info(r);
        const float* xr = ri.isctx ? xc + (size_t)(r - ML) * DM : xl + (size_t)r * DM;
        const float* mod = ctl + CF_MOD + (layer * 3 + (ri.isctx ? 2 : ri.b)) * 3072;
        f32x4 v[4]; float s = 0.f;
#pragma unroll
        for (int j = 0; j < 4; ++j) { v[j] = *(const f32x4*)(xr + 256 * j + 4 * lane); s += v[j].x * v[j].x + v[j].y * v[j].y + v[j].z * v[j].z + v[j].w * v[j].w; }
        const float rs = rsqrtf(wave_sum(s) * (1.f / DM) + EPS);
#pragma unroll
        for (int j = 0; j < 4; ++j) {
            const int c0 = 256 * j + 4 * lane;
            const f32x4 sh = *(const f32x4*)(mod + c0), sc = *(const f32x4*)(mod + 1024 + c0);
            const float o0 = v[j].x * rs * (1.f + sc.x) + sh.x, o1 = v[j].y * rs * (1.f + sc.y) + sh.y, o2 = v[j].z * rs * (1.f + sc.z) + sh.z, o3 = v[j].w * rs * (1.f + sc.w) + sh.w;
            uint2 o; o.x = pk2(o0, o1); o.y = pk2(o2, o3);
            *(uint2*)(H + (size_t)r * DM + c0) = o;
        }
    }
}


namespace pg8 {
#define PG8_LAS __attribute__((address_space(3)))
constexpr int BM = 256, BK = 64, HALF = 128, HTB = HALF * BK * 2, STAGE_BYTES = 8 * HTB, NXCD = 8, WGM = 8;
__host__ __device__ __forceinline__ int lds_byte(int r, int c) { const int st = (r >> 4) * 2 + (c >> 5), rr = r & 15, cc = c & 31, ob = rr * 64 + cc * 2; return st * 1024 + (ob ^ (((ob >> 9) & 1) << 5)); }
__host__ __device__ __forceinline__ void stage_rc(int b, int& R, int& C) { const int st = b / 1024, sb = b % 1024, swz = sb ^ (((sb >> 9) & 1) << 5); R = (st >> 1) * 16 + swz / 64; C = (st & 1) * 32 + (swz % 64) / 2; }
__host__ __device__ __forceinline__ int perm32(int rho) { const int n = rho >> 4, i = rho & 15; return 8 * (i >> 2) + 4 * n + (i & 3); }
struct Unit { int pm, pn; };
struct Gemm { const bf16_t* A; const bf16_t* Bt; int M, N, K, lda; };
struct StaticOrder {
    int nM, nN, nwg, G, c;
    __host__ __device__ void init(int M, int N, int G_, int c_) { nM = M / BM; nN = N / BM; nwg = nM * nN; G = G_; c = c_; }
    __host__ __device__ bool next(int i, Unit& u) const {
        const long L = (long)i * G + c; if (L >= nwg) return false;
        int wgid = (int)L; { const int q = nwg / NXCD, r = nwg % NXCD, xcd = wgid % NXCD, off = wgid / NXCD; wgid = (xcd < r ? xcd * (q + 1) : r * (q + 1) + (xcd - r) * q) + off; }
        const int nig = WGM * nN, gid = wgid / nig, fm = gid * WGM, gsz = (nM - fm) < WGM ? (nM - fm) : WGM;
        u.pm = fm + ((wgid % nig) % gsz); u.pn = (wgid % nig) / gsz; return true;
    }
    __device__ __forceinline__ void a_ready(const Unit&) const {}
    __device__ __forceinline__ void done(const Unit&) const {}
};
__device__ __forceinline__ unsigned cvt_pk_bf16(float lo, float hi) { unsigned r; asm volatile("v_cvt_pk_bf16_f32 %0, %1, %2" : "=v"(r) : "v"(lo), "v"(hi)); return r; }
struct EpiProj {
    static constexpr bool PERM = true, AFTER_DRAIN = false;
    bf16_t* O;
    __device__ __forceinline__ void operator()(const f32x4 (&acc)[2][2][4][2], const Unit& u, int wr, int wc, int fr, int fq) const {
        const int row0 = u.pm * BM + wr * 64 + fr, col0 = u.pn * BM + wc * 32 + 8 * fq;
#pragma unroll
        for (int ai = 0; ai < 2; ++ai)
#pragma unroll
            for (int m = 0; m < 4; ++m) { bf16_t* rowp = O + (size_t)(row0 + ai * HALF + m * 16) * PITCH + col0;
#pragma unroll
                for (int bj = 0; bj < 2; ++bj) { const f32x4 v0 = acc[ai][bj][m][0], v1 = acc[ai][bj][m][1];
                    u32x4 w; w.x = cvt_pk_bf16(v0[0], v0[1]); w.y = cvt_pk_bf16(v0[2], v0[3]); w.z = cvt_pk_bf16(v1[0], v1[1]); w.w = cvt_pk_bf16(v1[2], v1[3]);
                    if (col0 + bj * HALF + 8 <= PITCH) *(u32x4*)(rowp + bj * HALF) = w; } }
    }
};
struct EpiResid {
    static constexpr bool PERM = false, AFTER_DRAIN = false;
    const float* xlat; float* olat; const float* xctx; float* octx; const float* mod;
    __device__ __forceinline__ void operator()(const f32x4 (&acc)[2][2][4][2], const Unit& u, int wr, int wc, int fr, int fq) const {
        const bool isctx = u.pm >= 64;
        const float* xb = isctx ? xctx : xlat; float* ob = isctx ? octx : olat;
        const int prow = (isctx ? u.pm - 64 : u.pm) * BM + wr * 64 + fr;
        const float* gv = mod + (isctx ? 2 : (u.pm >> 5)) * 3072 + 2048;
        const int col0 = u.pn * BM + wc * 32 + 4 * fq;
#pragma unroll
        for (int bj = 0; bj < 2; ++bj)
#pragma unroll
            for (int n = 0; n < 2; ++n) { const int col = col0 + bj * HALF + n * 16; const f32x4 g = *(const f32x4*)(gv + col);
#pragma unroll
                for (int ai = 0; ai < 2; ++ai)
#pragma unroll
                    for (int m = 0; m < 4; ++m) { const size_t off = (size_t)(prow + ai * HALF + m * 16) * DM + col;
                        const f32x4 xin = *(const f32x4*)(xb + off); *(f32x4*)(ob + off) = xin + g * acc[ai][bj][m][n]; } }
    }
};
template <class Epi, class Sched, bool ALIGN_EPI = false, bool SP2 = false>
__device__ __forceinline__ void gemm_phase(PG8_LAS unsigned char* lds, const Gemm g, const Sched& S, const Epi& E) {
    const int tid = tid_opaque(), wid = __builtin_amdgcn_readfirstlane(tid >> 6), lane = tid & 63, wr = wid >> 2, wc = wid & 3, fr = lane & 15, fq = lane >> 4;
    const int K = g.K, lda = g.lda, nt = K / BK;
    unsigned voffA[2], voffB[2];
#pragma unroll
    for (int i = 0; i < 2; ++i) { int R, C; stage_rc(tid * 16 + i * 8192, R, C); const int Rb = Epi::PERM ? ((R & ~31) + perm32(R & 31)) : R;
        voffA[i] = (unsigned)(R * lda + C) * 2u; voffB[i] = (unsigned)(Rb * K + C) * 2u; }
    const size_t kstep = (size_t)(BK * 2);
    const size_t hstepA = (size_t)HALF * lda * 2, hstepB = (size_t)HALF * K * 2;
    const size_t tstepA = 2 * hstepA, tstepB = 2 * hstepB;
    const unsigned ldsw = (unsigned)wid * 1024u;
    const int aoff = lds_byte(wr * 64 + fr, fq * 8), boff = lds_byte(wc * 32 + fr, fq * 8);
#define PG8_SA(b, h) (((b) * 2 + (h)) * HTB)
#define PG8_SB(b, h) ((4 + (b) * 2 + (h)) * HTB)
#define PG8_STAGE(bufoff, gbase, voff) do { _Pragma("unroll") for (int _i = 0; _i < 2; ++_i) \
        __builtin_amdgcn_global_load_lds((const unsigned*)((const char*)(gbase) + (voff)[_i]), (PG8_LAS unsigned*)(lds + (bufoff) + ldsw + _i * 8192), 16, 0, 0); } while (0)
#define PG8_LDA(dst, b, h) do { _Pragma("unroll") for (int m = 0; m < 4; ++m) _Pragma("unroll") for (int k = 0; k < 2; ++k) dst[m][k] = *(const PG8_LAS bf16x8*)(lds + PG8_SA(b, h) + aoff + m * 2048 + k * 1024); } while (0)
#define PG8_LDB(dst, b, h) do { _Pragma("unroll") for (int n = 0; n < 2; ++n) _Pragma("unroll") for (int k = 0; k < 2; ++k) dst[n][k] = *(const PG8_LAS bf16x8*)(lds + PG8_SB(b, h) + boff + n * 2048 + k * 1024); } while (0)
#define PG8_MMA(ai, bj, At, Bt) do { __builtin_amdgcn_s_setprio(1); _Pragma("unroll") for (int m = 0; m < 4; ++m) _Pragma("unroll") for (int n = 0; n < 2; ++n) _Pragma("unroll") for (int k = 0; k < 2; ++k) \
        acc[ai][bj][m][n] = __builtin_amdgcn_mfma_f32_16x16x32_bf16(Bt[n][k], At[m][k], acc[ai][bj][m][n], 0, 0, 0); __builtin_amdgcn_s_setprio(0); } while (0)
#define PG8_WAIT_V(n) asm volatile("s_waitcnt vmcnt(" #n ")" ::: "memory")
#define PG8_WAIT_L(n) asm volatile("s_waitcnt lgkmcnt(" #n ")" ::: "memory")
#define PG8_BAR __builtin_amdgcn_s_barrier()
#define PG8_SCHED __builtin_amdgcn_sched_barrier(0)
    Unit cur, nxt; int ui = 0;
    if (!S.next(0, cur)) return;
    f32x4 acc[2][2][4][2];
#pragma unroll
    for (int a = 0; a < 2; ++a)
#pragma unroll
        for (int b = 0; b < 2; ++b)
#pragma unroll
            for (int m = 0; m < 4; ++m)
#pragma unroll
                for (int n = 0; n < 2; ++n) acc[a][b][m][n] = (f32x4){0.f, 0.f, 0.f, 0.f};
    bf16x8 At[4][2], B0[2][2], B1[2][2];
    const char* cA = (const char*)g.A + (size_t)cur.pm * tstepA; const char* cB = (const char*)g.Bt + (size_t)cur.pn * tstepB;
    S.a_ready(cur);
    if constexpr (SP2) {
        PG8_STAGE(PG8_SB(0, 0), cB, voffB); PG8_STAGE(PG8_SB(0, 1), cB + hstepB, voffB); PG8_STAGE(PG8_SA(0, 0), cA, voffA); PG8_STAGE(PG8_SA(0, 1), cA + hstepA, voffA);
        if (wr == 1) PG8_BAR;
        PG8_WAIT_V(2); PG8_BAR;
        PG8_STAGE(PG8_SB(1, 0), cB + kstep, voffB); PG8_STAGE(PG8_SA(1, 0), cA + kstep, voffA); PG8_STAGE(PG8_SB(1, 1), cB + hstepB + kstep, voffB);
        PG8_WAIT_V(6); PG8_BAR;
    } else {
        PG8_STAGE(PG8_SB(0, 0), cB, voffB); PG8_STAGE(PG8_SA(0, 0), cA, voffA); PG8_STAGE(PG8_SB(0, 1), cB + hstepB, voffB); PG8_STAGE(PG8_SA(0, 1), cA + hstepA, voffA);
        if (wr == 1) PG8_BAR;
        PG8_WAIT_V(4); PG8_BAR;
        PG8_STAGE(PG8_SB(1, 0), cB + kstep, voffB); PG8_STAGE(PG8_SA(1, 0), cA + kstep, voffA); PG8_STAGE(PG8_SB(1, 1), cB + hstepB + kstep, voffB);
        PG8_WAIT_V(6); PG8_BAR;
    }
    for (;;) {
        const bool has_next = S.next(ui + 1, nxt);
        const char* nA = has_next ? (const char*)g.A + (size_t)nxt.pm * tstepA : cA; const char* nB = has_next ? (const char*)g.Bt + (size_t)nxt.pn * tstepB : cB;
        for (int t = 0; t < nt; t += 2) {
            const bool last = (t == nt - 2);
            const char* a1 = cA + (size_t)(t + 1) * kstep;
            const char* a2 = last ? nA : cA + (size_t)(t + 2) * kstep; const char* b2 = last ? nB : cB + (size_t)(t + 2) * kstep;
            const char* a3 = a2 + kstep; const char* b3 = b2 + kstep;
            if (last && has_next) S.a_ready(nxt);
            if constexpr (SP2) {
            PG8_LDB(B0, 0, 0); PG8_LDB(B1, 0, 1); PG8_SCHED; PG8_LDA(At, 0, 0); PG8_STAGE(PG8_SA(1, 1), a1 + hstepA, voffA);
            PG8_WAIT_V(8); PG8_WAIT_L(0); PG8_BAR; PG8_MMA(0, 0, At, B0); PG8_MMA(0, 1, At, B1); PG8_BAR; PG8_SCHED;
            PG8_LDA(At, 0, 1); PG8_STAGE(PG8_SB(0, 0), b2, voffB); PG8_STAGE(PG8_SB(0, 1), b2 + hstepB, voffB); PG8_STAGE(PG8_SA(0, 0), a2, voffA);
            PG8_WAIT_V(8); PG8_WAIT_L(0); PG8_BAR; PG8_MMA(1, 0, At, B0); PG8_MMA(1, 1, At, B1); PG8_BAR; PG8_SCHED;
            PG8_LDB(B0, 1, 0); PG8_LDB(B1, 1, 1); PG8_SCHED; PG8_LDA(At, 1, 0); PG8_STAGE(PG8_SA(0, 1), a2 + hstepA, voffA);
            PG8_WAIT_V(8); PG8_WAIT_L(0); PG8_BAR; PG8_MMA(0, 0, At, B0); PG8_MMA(0, 1, At, B1); PG8_BAR; PG8_SCHED;
            PG8_LDA(At, 1, 1); PG8_STAGE(PG8_SB(1, 0), b3, voffB); PG8_STAGE(PG8_SB(1, 1), b3 + hstepB, voffB); PG8_STAGE(PG8_SA(1, 0), a3, voffA);
            PG8_WAIT_V(8); PG8_WAIT_L(0); PG8_BAR; PG8_MMA(1, 0, At, B0); PG8_MMA(1, 1, At, B1); PG8_BAR; PG8_SCHED;
            } else {
            PG8_LDB(B0, 0, 0); PG8_SCHED; PG8_LDA(At, 0, 0); PG8_STAGE(PG8_SA(1, 1), a1 + hstepA, voffA);
            PG8_WAIT_L(8); PG8_BAR; PG8_WAIT_L(0); PG8_MMA(0, 0, At, B0); PG8_BAR; PG8_SCHED;
            PG8_LDB(B1, 0, 1); PG8_STAGE(PG8_SB(0, 0), b2, voffB);
            PG8_BAR; PG8_WAIT_L(0); PG8_MMA(0, 1, At, B1); PG8_BAR;
            PG8_LDA(At, 0, 1); PG8_STAGE(PG8_SA(0, 0), a2, voffA);
            PG8_BAR; PG8_WAIT_L(0); PG8_MMA(1, 0, At, B0); PG8_BAR; PG8_SCHED;
            PG8_STAGE(PG8_SB(0, 1), b2 + hstepB, voffB);
            PG8_WAIT_V(6); PG8_BAR; PG8_MMA(1, 1, At, B1); PG8_BAR;
            PG8_LDB(B0, 1, 0); PG8_SCHED; PG8_LDA(At, 1, 0); PG8_STAGE(PG8_SA(0, 1), a2 + hstepA, voffA);
            PG8_WAIT_L(8); PG8_BAR; PG8_WAIT_L(0); PG8_MMA(0, 0, At, B0); PG8_BAR; PG8_SCHED;
            PG8_LDB(B1, 1, 1); PG8_STAGE(PG8_SB(1, 0), b3, voffB);
            PG8_BAR; PG8_WAIT_L(0); PG8_MMA(0, 1, At, B1); PG8_BAR;
            PG8_LDA(At, 1, 1); PG8_STAGE(PG8_SA(1, 0), a3, voffA);
            PG8_BAR; PG8_WAIT_L(0); PG8_MMA(1, 0, At, B0); PG8_BAR; PG8_SCHED;
            PG8_STAGE(PG8_SB(1, 1), b3 + hstepB, voffB);
            PG8_WAIT_V(6); PG8_BAR; PG8_MMA(1, 1, At, B1); PG8_BAR;
            }
        }
        if constexpr (ALIGN_EPI) { if (wr == 0) PG8_BAR; }
        if constexpr (!Epi::AFTER_DRAIN) { E(acc, cur, wr, wc, fr, fq); S.done(cur); }
        if (!has_next) break;
#pragma unroll
        for (int a = 0; a < 2; ++a)
#pragma unroll
            for (int b = 0; b < 2; ++b)
#pragma unroll
                for (int m = 0; m < 4; ++m)
#pragma unroll
                    for (int n = 0; n < 2; ++n) acc[a][b][m][n] = (f32x4){0.f, 0.f, 0.f, 0.f};
        cur = nxt; cA = nA; cB = nB; ++ui;
        if constexpr (ALIGN_EPI) { if (wr == 1) PG8_BAR; }
    }
    PG8_WAIT_V(0);
    if constexpr (!ALIGN_EPI) { if (wr == 0) PG8_BAR; }
    PG8_BAR;
    if constexpr (Epi::AFTER_DRAIN) { E.fused(acc, cur, wr, wc, fr, fq, lds, wid, lane); S.done(cur); }
#undef PG8_SA
#undef PG8_SB
#undef PG8_STAGE
#undef PG8_LDA
#undef PG8_LDB
#undef PG8_MMA
#undef PG8_WAIT_V
#undef PG8_WAIT_L
#undef PG8_BAR
#undef PG8_SCHED
}
}

__device__ __forceinline__ int crow(int r, int hi) { return (r & 3) + 8 * (r >> 2) + 4 * hi; }
__device__ __forceinline__ void glds16(const void* gsrc, unsigned lds_dst) { unsigned keep;
    asm volatile("s_mov_b32 %0, m0\n\ts_mov_b32 m0, %2\n\ts_nop 0\n\tglobal_load_lds_dwordx4 %1, off\n\ts_mov_b32 m0, %0" : "=&s"(keep) : "v"(gsrc), "s"(lds_dst) : "memory"); }
typedef float f32x2_t __attribute__((ext_vector_type(2))); typedef __bf16 bf16x2_t __attribute__((ext_vector_type(2)));
__device__ __forceinline__ unsigned cvtpk(float lo, float hi) { f32x2_t v = {lo, hi}; bf16x2_t b = __builtin_convertvector(v, bf16x2_t); return __builtin_bit_cast(unsigned, b); }
typedef short v4i16_t __attribute__((ext_vector_type(4)));
__device__ __forceinline__ s16x4 vtr(const LAS char* p) { return __builtin_bit_cast(s16x4, __builtin_amdgcn_ds_read_tr16_b64_v4i16((LAS v4i16_t*)p)); }
#define WAIT_BAR(N) asm volatile("s_waitcnt vmcnt(" #N ") lgkmcnt(0)\n\ts_barrier" ::: "memory")
constexpr int AT_SLOT = 32768, AT_NSLOT = 4, AT_WSF = AT_SLOT * AT_NSLOT, AT_XS = 132;

__device__ __forceinline__ void attn_unit(KP p, int layer, LAS char* lds, int b, int h, int q0, int isctx) {
    const int tid = tid_opaque(), lane = tid & 63, r32 = lane & 31, hi = lane >> 5;
    const int wave = __builtin_amdgcn_readfirstlane(tid >> 6), qg = wave & 3, map = wave >> 2;
    const float* ctl = (const float*)(p->ws + WS_CTL);
    const float lam = ctl[CF_LAM + layer], mb = ctl[CF_MB + layer];
    bf16_t* P = (bf16_t*)(p->ws + WS_PROJ);
    const unsigned lds0 = (unsigned)(uintptr_t)lds;
    const int NT = isctx ? CTXL / 64 : (SEQ + CTXL) / 64;
    const int rowq0 = seq_row0(b, isctx) + q0 + qg * 32;
#define AT_KROW0(t) (isctx ? (ML + b * CTXL + (t) * 64) : ((t) < SEQ / 64 ? (b * SEQ + (t) * 64) : (ML + b * CTXL + ((t) - SEQ / 64) * 64)))
#define AT_DMA(t) do { const int kr0_ = AT_KROW0(t); const unsigned sl_ = lds0 + (unsigned)(((t) & 3) * AT_SLOT); \
        const bf16_t* kb_ = P + (size_t)(kr0_ + lane) * PITCH + C_AK + h * 128; \
        glds16(kb_ + wave * 8, (unsigned)__builtin_amdgcn_readfirstlane(sl_ + wave * 1024)); \
        glds16(kb_ + (wave + 8) * 8, (unsigned)__builtin_amdgcn_readfirstlane(sl_ + (wave + 8) * 1024)); \
        const bf16_t* vb_ = P + (size_t)(kr0_ + 16 * (wave & 3) + (lane >> 2)) * PITCH + C_AV + h * 128 + (lane & 3) * 8; \
        glds16(vb_ + (wave >> 2) * 32, (unsigned)__builtin_amdgcn_readfirstlane(sl_ + 16384 + (wave >> 2) * 4096 + (wave & 3) * 1024)); \
        glds16(vb_ + ((wave >> 2) + 2) * 32, (unsigned)__builtin_amdgcn_readfirstlane(sl_ + 16384 + ((wave >> 2) + 2) * 4096 + (wave & 3) * 1024)); } while (0)
    AT_DMA(0); AT_DMA(1); AT_DMA(2);
    bf16x8 qr[4];
    {
        const bf16_t* qp = P + (size_t)(rowq0 + r32) * PITCH + C_AQ + h * 128 + map * 64 + hi * 8;
#pragma unroll
        for (int ks = 0; ks < 4; ++ks) qr[ks] = *(const bf16x8*)(qp + ks * 16);
    }
    asm volatile("" : "+v"(qr[0]), "+v"(qr[1]), "+v"(qr[2]), "+v"(qr[3]));
    f32x16 o[4];
#pragma unroll
    for (int d = 0; d < 4; ++d)
#pragma unroll
        for (int r = 0; r < 16; ++r) o[d][r] = 0.f;
    f32x16 negm;
#pragma unroll
    for (int r = 0; r < 16; ++r) negm[r] = -mb;
    float l = 0.f;
    const int koff = map * 8192 + hi * 1024 + r32 * 16;
    const int voff = 16384 + ((lane >> 4) & 1) * 32 + (lane & 3) * 8 + (4 * hi + ((lane & 15) >> 2)) * 64;
    for (int t = 0; t < NT; ++t) {
        const int ahead = NT - 1 - t;
        if (ahead >= 2) { WAIT_BAR(8); } else if (ahead == 1) { WAIT_BAR(4); } else { WAIT_BAR(0); }
        if (t + 3 < NT) AT_DMA(t + 3);
        const LAS char* sl = lds + (t & 3) * AT_SLOT;
        const LAS char* kp = sl + koff; const LAS char* vp = sl + voff;
        f32x16 p0 = negm, p1 = negm;
#pragma unroll
        for (int ks = 0; ks < 4; ++ks) {
            const bf16x8 a0 = *(const LAS bf16x8*)(kp + ks * 2048), a1 = *(const LAS bf16x8*)(kp + ks * 2048 + 512);
            p0 = __builtin_amdgcn_mfma_f32_32x32x16_bf16(a0, qr[ks], p0, 0, 0, 0);
            p1 = __builtin_amdgcn_mfma_f32_32x32x16_bf16(a1, qr[ks], p1, 0, 0, 0);
        }
        float sacc = 0.f;
#pragma unroll
        for (int r = 0; r < 16; ++r) { p0[r] = __builtin_amdgcn_exp2f(p0[r]); p1[r] = __builtin_amdgcn_exp2f(p1[r]); sacc += p0[r] + p1[r]; }
        l += sacc;
        u32x4 pw[4];
#pragma unroll
        for (int j = 0; j < 4; ++j) { pw[0][j] = cvtpk(p0[2 * j], p0[2 * j + 1]); pw[1][j] = cvtpk(p0[8 + 2 * j], p0[8 + 2 * j + 1]);
                                      pw[2][j] = cvtpk(p1[2 * j], p1[2 * j + 1]); pw[3][j] = cvtpk(p1[8 + 2 * j], p1[8 + 2 * j + 1]); }
#pragma unroll
        for (int d0 = 0; d0 < 4; ++d0)
#pragma unroll
            for (int ks = 0; ks < 4; ++ks) {
                const s16x4 lo = vtr(vp + d0 * 4096 + ks * 1024), hh = vtr(vp + d0 * 4096 + ks * 1024 + 512);
                const bf16x8 vf = (bf16x8){lo[0], lo[1], lo[2], lo[3], hh[0], hh[1], hh[2], hh[3]};
                o[d0] = __builtin_amdgcn_mfma_f32_32x32x16_bf16(__builtin_bit_cast(bf16x8, pw[ks]), vf, o[d0], 0, 0, 0);
            }
    }
    l += __shfl_xor(l, 32);
    WAIT_BAR(0);
    LAS float* wsf = (LAS float*)(lds + AT_WSF) + wave * 32;
    if (hi == 0) wsf[r32] = l;
    asm volatile("s_waitcnt lgkmcnt(0)" ::: "memory");
    LAS float* X = (LAS float*)lds + qg * (32 * AT_XS);
    const float fm = map ? lam : 1.f;
    if (map == 1) {
#pragma unroll
        for (int r = 0; r < 16; ++r) { const int row = crow(r, hi); const float f = fm / wsf[row];
#pragma unroll
            for (int d0 = 0; d0 < 4; ++d0) X[row * AT_XS + d0 * 32 + r32] = o[d0][r] * f; }
    }
    WAIT_BAR(0);
    if (map == 0) {
#pragma unroll
        for (int r = 0; r < 16; ++r) { const int row = crow(r, hi); const float f = fm / wsf[row];
#pragma unroll
            for (int d0 = 0; d0 < 4; ++d0) { const int xi = row * AT_XS + d0 * 32 + r32; X[xi] = o[d0][r] * f - X[xi]; } }
        asm volatile("s_waitcnt lgkmcnt(0)" ::: "memory");
        const int row = lane >> 1, half = lane & 1;
        float xv[64]; float ss = 0.f;
#pragma unroll
        for (int i = 0; i < 64; i += 4) { const f32x4 v = *(const LAS f32x4*)(X + row * AT_XS + half * 64 + i); xv[i] = v[0]; xv[i + 1] = v[1]; xv[i + 2] = v[2]; xv[i + 3] = v[3];
            ss += v[0] * v[0] + v[1] * v[1] + v[2] * v[2] + v[3] * v[3]; }
        ss += __shfl_xor(ss, 1);
        const float rs = rsqrtf(ss * (1.f / 128.f) + EPS) * (1.f - lam_init_of(layer));
        const float* sub = p->in[14] + layer * 128 + half * 64;
        bf16_t* gp = P + (size_t)(rowq0 + row) * PITCH + C_AG + h * 128 + half * 64;
        bf16_t* op = P + (size_t)(rowq0 + row) * PITCH + C_AQ + h * 128 + half * 64;
#pragma unroll
        for (int i = 0; i < 64; i += 8) {
            const u32x4 gw = *(const u32x4*)(gp + i);
            const float g0 = __uint_as_float(gw.x << 16), g1 = __uint_as_float(gw.x & 0xffff0000u), g2 = __uint_as_float(gw.y << 16), g3 = __uint_as_float(gw.y & 0xffff0000u);
            const float g4 = __uint_as_float(gw.z << 16), g5 = __uint_as_float(gw.z & 0xffff0000u), g6 = __uint_as_float(gw.w << 16), g7 = __uint_as_float(gw.w & 0xffff0000u);
            u32x4 w;
            w.x = pk2(xv[i] * rs * sub[i] * siluf(g0), xv[i + 1] * rs * sub[i + 1] * siluf(g1));
            w.y = pk2(xv[i + 2] * rs * sub[i + 2] * siluf(g2), xv[i + 3] * rs * sub[i + 3] * siluf(g3));
            w.z = pk2(xv[i + 4] * rs * sub[i + 4] * siluf(g4), xv[i + 5] * rs * sub[i + 5] * siluf(g5));
            w.w = pk2(xv[i + 6] * rs * sub[i + 6] * siluf(g6), xv[i + 7] * rs * sub[i + 7] * siluf(g7));
            *(u32x4*)(op + i) = w;
        }
    }
    WAIT_BAR(0);
#undef AT_DMA
#undef AT_KROW0
}
__device__ __forceinline__ void phase_attn(KP p, int layer, LAS char* lds, int blk, int nblk) {
    const int nunits = 512 + (layer == 0 ? 16 : 0);
    for (int u = blk; u < nunits; u += nblk) {
        if (u < 512) { const int bh = u & 7, qb = u >> 3; attn_unit(p, layer, lds, bh >> 2, bh & 3, qb * 128, 0); }
        else { const int j = u - 512; attn_unit(p, layer, lds, j >> 3, (j >> 1) & 3, (j & 1) * 128, 1); }
    }
}

__device__ __forceinline__ void phase_prep(KP p, int layer, int blk, int nblk) {
    const int tid = tid_opaque(), lane = tid & 63, wave = tid >> 6, nw = blockDim.x >> 6;
    bf16_t* P = (bf16_t*)(p->ws + WS_PROJ);
    const float gq = p->in[8][layer * 64 + lane], gk = p->in[9][layer * 64 + lane];
    const int ai = lane & 31;
    const float invf = exp2f(-(float)(ai & 15) * (13.287712379549449f / 16.f));
    for (int r = blk * nw + wave; r < MT; r += nblk * nw) {
        const RowInfo ri = row_info(r);
        float cs = 1.f, sn = 0.f;
        if (!ri.isctx) { const float pos = (ai < 16) ? (float)(ri.t >> 6) : (float)(ri.t & 63); const float ang = pos * invf; cs = cosf(ang); sn = sinf(ang); }
        bf16_t* row = P + (size_t)r * PITCH;
#pragma unroll
        for (int v = 0; v < 16; ++v) {
            bf16_t* ptr = row + (v < 8 ? C_AQ + v * 64 : C_AK + (v - 8) * 64) + lane;
            float x = bf2f(*ptr);
            const float ss = wave_sum(x * x);
            x = x * rsqrtf(ss * (1.f / 64.f) + EPS) * (v < 8 ? gq : gk);
            const float o = __shfl_xor(x, 32);
            float y = (lane < 32) ? (x * cs - o * sn) : (o * sn + x * cs);
            if (v < 8) y *= 0.125f * LOG2E;
            *ptr = f2bf(y);
        }
#pragma unroll
        for (int v = 0; v < 8; ++v) {
            bf16_t* ptr = row + (v < 4 ? C_RQ + v * 64 : C_RK + (v - 4) * 64) + lane;
            float x = bf2f(*ptr);
            const float o = __shfl_xor(x, 32);
            float y = (lane < 32) ? (x * cs - o * sn) : (o * sn + x * cs);
            if (v >= 4) y *= 0.125f;
            *ptr = f2bf(y);
        }
    }
}

constexpr int CF_TOT = 32768;
constexpr size_t WS_ST = WS_H;
static_assert((size_t)66 * 2 * 20 * 8192 * 2 <= H_BYTES + WINT_BYTES, "states overlay");
__device__ __forceinline__ size_t st_off(int blk, int dir, int head) { return (size_t)((blk * 2 + dir) * 20 + head) * 8192; }
__device__ __forceinline__ void unpack8(const u32x4 w, float* f) {
    f[0] = __uint_as_float(w.x << 16); f[1] = __uint_as_float(w.x & 0xffff0000u); f[2] = __uint_as_float(w.y << 16); f[3] = __uint_as_float(w.y & 0xffff0000u);
    f[4] = __uint_as_float(w.z << 16); f[5] = __uint_as_float(w.z & 0xffff0000u); f[6] = __uint_as_float(w.w << 16); f[7] = __uint_as_float(w.w & 0xffff0000u);
}
__device__ __forceinline__ u32x4 pack8(const float* f) { u32x4 w; w.x = cvtpk(f[0], f[1]); w.y = cvtpk(f[2], f[3]); w.z = cvtpk(f[4], f[5]); w.w = cvtpk(f[6], f[7]); return w; }
__device__ __forceinline__ int tr_laneoff(int lane) { return ((lane >> 4) & 1) * 32 + (lane & 3) * 8 + (4 * (lane >> 5) + ((lane & 15) >> 2)) * 64; }
__device__ __forceinline__ bf16x8 tr_frag(const LAS char* p) { const s16x4 lo = vtr(p), hh = vtr(p + 512); return (bf16x8){lo[0], lo[1], lo[2], lo[3], hh[0], hh[1], hh[2], hh[3]}; }
struct BlkInfo { int b, isctx, row0, t0, L, seqrow0; };
__device__ __forceinline__ BlkInfo blk_info(int blk) {
    BlkInfo i; i.b = blk / 33; const int k = blk % 33; i.isctx = (k == 0);
    if (i.isctx) { i.seqrow0 = ML + i.b * CTXL; i.t0 = 0; i.L = CTXL; } else { i.seqrow0 = i.b * SEQ; i.t0 = (k - 1) * 256; i.L = SEQ; }
    i.row0 = i.seqrow0 + i.t0; return i;
}
template <int NTOK, int CH = 8, class F>
__device__ __forceinline__ void conv_strip(const bf16_t* P, const BlkInfo& bi, int tb, int ch0, const float* cw, const float* cb, F&& emit) {
    float w0[CH], w1[CH], w2[CH], bb[CH];
#pragma unroll
    for (int j = 0; j < CH; ++j) { w0[j] = cw[ch0 + j]; w1[j] = cw[1536 + ch0 + j]; w2[j] = cw[3072 + ch0 + j]; bb[j] = cb[ch0 + j]; }
    float xm[CH], x0[CH], xp[CH];
    const bf16_t* base = P + (size_t)bi.seqrow0 * PITCH + C_XBC + ch0;
    auto ld = [&](int ts, float* f) { if (ts >= 0 && ts < bi.L) {
            if (CH == 8) unpack8(*(const u32x4*)(base + (size_t)ts * PITCH), f);
            else { const u32x2 w = *(const u32x2*)(base + (size_t)ts * PITCH); f[0] = __uint_as_float(w.x << 16); f[1] = __uint_as_float(w.x & 0xffff0000u); f[2] = __uint_as_float(w.y << 16); f[3] = __uint_as_float(w.y & 0xffff0000u); }
        } else {
#pragma unroll
            for (int j = 0; j < CH; ++j) f[j] = 0.f; } };
    const int ts0 = bi.t0 + tb;
    ld(ts0 - 1, xm); ld(ts0, x0);
#pragma unroll
    for (int tt = 0; tt < NTOK; ++tt) {
        ld(ts0 + tt + 1, xp);
        float u[CH];
#pragma unroll
        for (int j = 0; j < CH; ++j) { const float a = bb[j] + w0[j] * xm[j] + w1[j] * x0[j] + w2[j] * xp[j]; u[j] = siluf(a); }
        emit(tb + tt, u);
#pragma unroll
        for (int j = 0; j < CH; ++j) { xm[j] = x0[j]; x0[j] = xp[j]; }
    }
}
template <int KIND>
__device__ __forceinline__ void scan_tables(KP p, int layer, const bf16_t* P, const BlkInfo& bi, int hidx, int dir, int lane, float (&cum)[4], float (&dt)[4], float& tot) {
    float la[4];
    if (KIND == 0) {
        const float bias = p->in[17][(layer * 2 + dir) * 16 + hidx], A = expf(p->in[18][(layer * 2 + dir) * 16 + hidx]);
#pragma unroll
        for (int k = 0; k < 4; ++k) { const float x = bf2f(P[(size_t)(bi.row0 + 4 * lane + k) * PITCH + C_DTR + dir * 16 + hidx]) + bias; dt[k] = x > 20.f ? x : log1pf(expf(x)); la[k] = -dt[k] * A; }
    } else {
        const float lar = log1pf(-exp2f(-((dir == 0 ? 5.0f : 5.5f) + (float)hidx)));
        float one = 1.f; asm volatile("" : "+v"(one));
#pragma unroll
        for (int k = 0; k < 4; ++k) { dt[k] = one; la[k] = lar; }
    }
    if (dir == 0) {
        float c[4]; c[0] = la[0]; c[1] = c[0] + la[1]; c[2] = c[1] + la[2]; c[3] = c[2] + la[3];
        float incl = c[3];
#pragma unroll
        for (int o = 1; o < 64; o <<= 1) { const float t = __shfl_up(incl, o); if (lane >= o) incl += t; }
        const float excl = incl - c[3];
#pragma unroll
        for (int k = 0; k < 4; ++k) cum[k] = excl + c[k];
        tot = __shfl(incl, 63);
    } else {
        float c[4]; c[3] = la[3]; c[2] = c[3] + la[2]; c[1] = c[2] + la[1]; c[0] = c[1] + la[0];
        float incl = c[0];
#pragma unroll
        for (int o = 1; o < 64; o <<= 1) { const float t = __shfl_down(incl, o); if (lane + o < 64) incl += t; }
        const float excl = incl - c[0];
#pragma unroll
        for (int k = 0; k < 4; ++k) cum[k] = excl + c[k];
        tot = __shfl(incl, 0);
    }
}

__device__ __forceinline__ void scanA_ssd(KP p, int layer, LAS char* lds, int blk, int g) {
    const int tid = tid_opaque(), lane = tid & 63, r32 = lane & 31, hi = lane >> 5, wave = __builtin_amdgcn_readfirstlane(tid >> 6);
    const BlkInfo bi = blk_info(blk);
    const bf16_t* P = (const bf16_t*)(p->ws + WS_PROJ);
    bf16_t* ST = (bf16_t*)(p->ws + WS_ST); float* ctl = (float*)(p->ws + WS_CTL);
    const float* cw = p->in[15] + (size_t)layer * 3 * 1536; const float* cb = p->in[16] + (size_t)layer * 1536;
    LAS float* WA = (LAS float*)(lds + 131072);
#pragma unroll
    for (int q = 0; q < 2; ++q) {
        const int hd = 2 * wave + q, head = hd >> 1, dir = hd & 1;
        float cum[4], dt[4], tot;
        scan_tables<0>(p, layer, P, bi, g * 8 + head, dir, lane, cum, dt, tot);
        f32x4 w;
#pragma unroll
        for (int k = 0; k < 4; ++k) w[k] = dt[k] * __expf(tot - cum[k]);
        *(LAS f32x4*)(WA + hd * 256 + 4 * lane) = w;
        if (lane == 0) ctl[CF_TOT + (blk * 2 + dir) * 20 + g * 8 + head] = tot;
    }
    {
        const int c = tid & 15, tb = (tid >> 4) * 8;
        conv_strip<8>(P, bi, tb, 1024 + g * 128 + c * 8, cw, cb, [&](int t, const float* u) { *(LAS u32x4*)(lds + (c >> 2) * 16384 + t * 64 + (c & 3) * 16) = pack8(u); });
    }
    __syncthreads();
    const int lo_ = tr_laneoff(lane);
    for (int head = 0; head < 8; ++head) {
        {
            const int c = tid & 7, tb = (tid >> 3) * 4;
            conv_strip<4>(P, bi, tb, (g * 8 + head) * 64 + c * 8, cw, cb, [&](int t, const float* u) {
                const float wf = WA[(head * 2) * 256 + t], wb = WA[(head * 2 + 1) * 256 + t];
                float uf[8], ub[8];
#pragma unroll
                for (int j = 0; j < 8; ++j) { uf[j] = u[j] * wf; ub[j] = u[j] * wb; }
                const int off = (c >> 2) * 16384 + t * 64 + (c & 3) * 16;
                *(LAS u32x4*)(lds + 65536 + off) = pack8(uf); *(LAS u32x4*)(lds + 98304 + off) = pack8(ub); });
        }
        __syncthreads();
        const int pb = wave & 1, nb = wave >> 1;
#pragma unroll
        for (int dir = 0; dir < 2; ++dir) {
            f32x16 acc;
#pragma unroll
            for (int r = 0; r < 16; ++r) acc[r] = 0.f;
            const LAS char* xa = lds + 65536 + dir * 32768 + pb * 16384 + lo_; const LAS char* ba = lds + nb * 16384 + lo_;
#pragma unroll 4
            for (int s = 0; s < 16; ++s) acc = __builtin_amdgcn_mfma_f32_32x32x16_bf16(tr_frag(xa + s * 1024), tr_frag(ba + s * 1024), acc, 0, 0, 0);
            bf16_t* so = ST + st_off(blk, dir, g * 8 + head) + 32 * nb + r32;
#pragma unroll
            for (int r = 0; r < 16; ++r) so[(size_t)(32 * pb + crow(r, hi)) * 128] = f2bf(acc[r]);
        }
        __syncthreads();
    }
}
__device__ __forceinline__ void scanA_ret(KP p, int layer, LAS char* lds, int blk, int head) {
    const int tid = tid_opaque(), lane = tid & 63, r32 = lane & 31, hi = lane >> 5, wave = __builtin_amdgcn_readfirstlane(tid >> 6);
    const BlkInfo bi = blk_info(blk);
    const bf16_t* P = (const bf16_t*)(p->ws + WS_PROJ);
    bf16_t* ST = (bf16_t*)(p->ws + WS_ST); float* ctl = (float*)(p->ws + WS_CTL);
    const float laf = log1pf(-exp2f(-(5.0f + (float)head))), lab = log1pf(-exp2f(-(5.5f + (float)head)));
    if (tid < 2) ctl[CF_TOT + (blk * 2 + tid) * 20 + 16 + head] = 256.f * (tid == 0 ? laf : lab);
#pragma unroll
    for (int i = 0; i < 4; ++i) {
        const int it = tid + i * 512, c = it & 7, t = it >> 3;
        float f[8], ff[8], fb[8]; unpack8(*(const u32x4*)(P + (size_t)(bi.row0 + t) * PITCH + C_RK + head * 64 + c * 8), f);
        const float wf = __expf((float)(255 - t) * laf), wb = __expf((float)t * lab);
#pragma unroll
        for (int j = 0; j < 8; ++j) { ff[j] = f[j] * wf; fb[j] = f[j] * wb; }
        const int off = (c >> 2) * 16384 + t * 64 + (c & 3) * 16;
        *(LAS u32x4*)(lds + off) = pack8(ff); *(LAS u32x4*)(lds + 32768 + off) = pack8(fb);
    }
#pragma unroll
    for (int i = 0; i < 8; ++i) {
        const int it = tid + i * 512, c = it & 15, t = it >> 4;
        *(LAS u32x4*)(lds + 65536 + (c >> 2) * 16384 + t * 64 + (c & 3) * 16) = *(const u32x4*)(P + (size_t)(bi.row0 + t) * PITCH + C_RV + head * 128 + c * 8);
    }
    __syncthreads();
    const int lo_ = tr_laneoff(lane), pb = wave & 3, nb = wave >> 2;
#pragma unroll
    for (int dir = 0; dir < 2; ++dir) {
        f32x16 acc;
#pragma unroll
        for (int r = 0; r < 16; ++r) acc[r] = 0.f;
        const LAS char* va = lds + 65536 + pb * 16384 + lo_; const LAS char* ka = lds + dir * 32768 + nb * 16384 + lo_;
#pragma unroll 4
        for (int s = 0; s < 16; ++s) acc = __builtin_amdgcn_mfma_f32_32x32x16_bf16(tr_frag(va + s * 1024), tr_frag(ka + s * 1024), acc, 0, 0, 0);
        bf16_t* so = ST + st_off(blk, dir, 16 + head) + 32 * nb + r32;
#pragma unroll
        for (int r = 0; r < 16; ++r) so[(size_t)(32 * pb + crow(r, hi)) * 64] = f2bf(acc[r]);
    }
    __syncthreads();
}
__device__ __forceinline__ void phase_scanA(KP p, int layer, LAS char* lds, int blk, int nblk) {
    for (int u = blk; u < 132 + 264; u += nblk) {
        if (u < 132) scanA_ssd(p, layer, lds, u >> 1, u & 1);
        else { const int v = u - 132; scanA_ret(p, layer, lds, v >> 2, v & 3); }
    }
}

__device__ __forceinline__ void phase_scanB(KP p, int layer, int blk, int nblk) {
    const int tid = tid_opaque();
    bf16_t* ST = (bf16_t*)(p->ws + WS_ST); const float* ctl = (const float*)(p->ws + WS_CTL);
    for (int it = blk * 512 + tid; it < 2 * 2 * 20 * 1024; it += nblk * 512) {
        const int e8 = it & 1023, head = (it >> 10) % 20, bd = (it >> 10) / 20, dir = bd & 1, b = bd >> 1;
        float run[8]; float zero = 0.f; asm volatile("" : "+v"(zero));
#pragma unroll
        for (int j = 0; j < 8; ++j) run[j] = zero;
        for (int s = 0; s < 33; ++s) {
            const int k = (s == 0) ? 0 : (dir == 0 ? s : 33 - s);
            const int bk = b * 33 + k;
            bf16_t* sp = ST + st_off(bk, dir, head) + e8 * 8;
            float st[8]; unpack8(*(const u32x4*)sp, st);
            const float dec = __expf(ctl[CF_TOT + (bk * 2 + dir) * 20 + head]);
            *(u32x4*)sp = pack8(run);
#pragma unroll
            for (int j = 0; j < 8; ++j) run[j] = run[j] * dec + st[j];
        }
    }
}

template <int KIND>
__device__ __forceinline__ void scanC_unit(KP p, int layer, LAS char* lds, int blk, int gh) {
    constexpr int N = KIND == 0 ? 128 : 64, NKS = N / 16, NH = KIND == 0 ? 8 : 2;
    constexpr int QOFF = (N / 8) * 4096, XOFF = KIND == 0 ? 0 : 65536, TABOFF = 131072;
    const int tid = tid_opaque(), lane = tid & 63, r32 = lane & 31, hi = lane >> 5, it = __builtin_amdgcn_readfirstlane(tid >> 6);
    const BlkInfo bi = blk_info(blk);
    bf16_t* P = (bf16_t*)(p->ws + WS_PROJ);
    const bf16_t* ST = (const bf16_t*)(p->ws + WS_ST);
    const float* cw = p->in[15] + (size_t)layer * 3 * 1536; const float* cb = p->in[16] + (size_t)layer * 1536;
    if (KIND == 0) {
        const int c = tid & 31, tb = (tid >> 5) * 16;
        const int ch0 = (c < 16) ? 1024 + gh * 128 + c * 8 : 1280 + gh * 128 + (c - 16) * 8;
        LAS char* dst = lds + (c < 16 ? 0 : QOFF) + (c & 15) * 4096;
        conv_strip<16>(P, bi, tb, ch0, cw, cb, [&](int t, const float* u) { *(LAS u32x4*)(dst + t * 16) = pack8(u); });
    } else {
#pragma unroll
        for (int i = 0; i < 8; ++i) {
            const int itm = tid + i * 512, c = itm & 15, t = itm >> 4;
            const int col = (c < 8) ? C_RK + gh * 64 + c * 8 : C_RQ + gh * 64 + (c - 8) * 8;
            *(LAS u32x4*)(lds + (c < 8 ? 0 : QOFF) + (c & 7) * 4096 + t * 16) = *(const u32x4*)(P + (size_t)(bi.row0 + t) * PITCH + col);
        }
#pragma unroll
        for (int i = 0; i < 8; ++i) {
            const int itm = tid + i * 512, c = itm & 15, t = itm >> 4;
            *(LAS u32x4*)(lds + XOFF + (c >> 2) * 16384 + t * 64 + (c & 3) * 16) = *(const u32x4*)(P + (size_t)(bi.row0 + t) * PITCH + C_RV + gh * 128 + c * 8);
        }
    }
    __syncthreads();
    u32x4 Gs[8][2];
    const LAS char* qfrag = lds + QOFF + hi * 4096 + (32 * it + r32) * 16;
    {
        bf16x8 Cf[NKS];
#pragma unroll
        for (int ks = 0; ks < NKS; ++ks) Cf[ks] = *(const LAS bf16x8*)(qfrag + ks * 8192);
#pragma unroll
        for (int jt = 0; jt < 8; ++jt) {
            f32x16 a;
#pragma unroll
            for (int r = 0; r < 16; ++r) a[r] = 0.f;
#pragma unroll
            for (int ks = 0; ks < NKS; ++ks) a = __builtin_amdgcn_mfma_f32_32x32x16_bf16(*(const LAS bf16x8*)(lds + (2 * ks + hi) * 4096 + (32 * jt + r32) * 16), Cf[ks], a, 0, 0, 0);
#pragma unroll
            for (int s = 0; s < 2; ++s)
#pragma unroll
                for (int e = 0; e < 4; ++e) Gs[jt][s][e] = cvtpk(a[8 * s + 2 * e], a[8 * s + 2 * e + 1]);
        }
    }
    __syncthreads();
    auto stage_head = [&](int head) {
        const int tid = tid_opaque(), lane = tid & 63;
        if (it < 2 && (KIND == 0 || head == 0)) {
            const int dir = it;
            float cum[4], dt[4], tot;
            scan_tables<KIND>(p, layer, P, bi, KIND == 0 ? gh * 8 + head : gh, dir, lane, cum, dt, tot);
            const float cref = dir == 0 ? __shfl(cum[3], lane | 7) : __shfl(cum[0], lane & ~7);
            f32x4 c4, w4, d4;
#pragma unroll
            for (int k = 0; k < 4; ++k) { c4[k] = cum[k]; d4[k] = dt[k]; w4[k] = dt[k] * __expf(cref - cum[k]); }
            LAS float* T = (LAS float*)(lds + TABOFF) + ((KIND == 0 ? (head & 1) : 0) * 2 + dir) * 768;
            *(LAS f32x4*)(T + 4 * lane) = c4; *(LAS f32x4*)(T + 256 + 4 * lane) = w4; *(LAS f32x4*)(T + 512 + 4 * lane) = d4;
        }
        if (KIND == 0) {
            const int c = tid & 15, tb = (tid >> 4) * 8;
            LAS char* dst = lds + XOFF + (head & 1) * 32768 + (c >> 3) * 16384 + (c & 7) * 8;
            conv_strip<8, 4>(P, bi, tb, (gh * 8 + head) * 64 + c * 4, cw, cb, [&](int t, const float* u) { u32x2 w; w.x = cvtpk(u[0], u[1]); w.y = cvtpk(u[2], u[3]); *(LAS u32x2*)(dst + t * 64) = w; });
        }
    };
    stage_head(0);
    __syncthreads();
    const int lo_ = tr_laneoff(lane), i_tok = 32 * it + r32;
    bf16_t* orow = P + (size_t)(bi.row0 + i_tok) * PITCH;
    float ssq = 0.f;
    for (int head = 0; head < NH; ++head) {
        if (KIND == 0 && head + 1 < NH) stage_head(head + 1);
        const int hidx = KIND == 0 ? gh * 8 + head : gh;
        const LAS char* X = lds + XOFF + (head & 1) * 32768 + lo_;
        f32x16 acc[2];
#pragma unroll
        for (int pb = 0; pb < 2; ++pb)
#pragma unroll
            for (int r = 0; r < 16; ++r) acc[pb][r] = 0.f;
#pragma unroll 1
        for (int dir = 0; dir < 2; ++dir) {
            const LAS float* T = (const LAS float*)(lds + TABOFF) + ((KIND == 0 ? (head & 1) : 0) * 2 + dir) * 768;
            const float ci = T[i_tok];
#pragma unroll
            for (int jt = 0; jt < 8; ++jt) {
                const bool off = dir == 0 ? (jt < it) : (jt > it);
                if (off) {
                    const float wi = __expf(ci - T[dir == 0 ? 32 * jt + 31 : 32 * jt]);
#pragma unroll
                    for (int s = 0; s < 2; ++s) {
                        const int j0 = 32 * jt + 16 * s + 4 * hi;
                        const f32x4 wa = *(const LAS f32x4*)(T + 256 + j0), wb = *(const LAS f32x4*)(T + 256 + j0 + 8);
                        float gv[8]; unpack8(Gs[jt][s], gv);
#pragma unroll
                        for (int e = 0; e < 4; ++e) { gv[e] *= wa[e] * wi; gv[4 + e] *= wb[e] * wi; }
                        const bf16x8 mB = __builtin_bit_cast(bf16x8, pack8(gv));
#pragma unroll
                        for (int pb = 0; pb < 2; ++pb) acc[pb] = __builtin_amdgcn_mfma_f32_32x32x16_bf16(tr_frag(X + pb * 16384 + (32 * jt + 16 * s) * 64), mB, acc[pb], 0, 0, 0);
                    }
                } else if (jt == it) {
#pragma unroll
                    for (int s = 0; s < 2; ++s) {
                        const int j0 = 32 * jt + 16 * s + 4 * hi;
                        const f32x4 ca = *(const LAS f32x4*)(T + j0), cb4 = *(const LAS f32x4*)(T + j0 + 8), da = *(const LAS f32x4*)(T + 512 + j0), db = *(const LAS f32x4*)(T + 512 + j0 + 8);
                        float gv[8]; unpack8(Gs[jt][s], gv);
#pragma unroll
                        for (int e = 0; e < 4; ++e) {
                            const int ja = 16 * s + 4 * hi + e, jb = ja + 8;
                            const bool ka = dir == 0 ? (ja <= r32) : (ja >= r32), kb = dir == 0 ? (jb <= r32) : (jb >= r32);
                            gv[e] = ka ? gv[e] * da[e] * __expf(ci - ca[e]) : 0.f; gv[4 + e] = kb ? gv[4 + e] * db[e] * __expf(ci - cb4[e]) : 0.f;
                        }
                        const bf16x8 mB = __builtin_bit_cast(bf16x8, pack8(gv));
#pragma unroll
                        for (int pb = 0; pb < 2; ++pb) acc[pb] = __builtin_amdgcn_mfma_f32_32x32x16_bf16(tr_frag(X + pb * 16384 + (32 * jt + 16 * s) * 64), mB, acc[pb], 0, 0, 0);
                    }
                }
            }
            if (!bi.isctx) {
                const float ef = __expf(ci);
                const bf16_t* Sp = ST + st_off(blk, dir, KIND == 0 ? hidx : 16 + gh) + (size_t)((KIND == 0 ? 0 : 64 * head) + r32) * N + 8 * hi;
#pragma unroll
                for (int pb = 0; pb < 2; ++pb) {
                    __builtin_amdgcn_sched_barrier(0);
                    f32x16 a2;
#pragma unroll
                    for (int r = 0; r < 16; ++r) a2[r] = 0.f;
#pragma unroll
                    for (int ks = 0; ks < NKS; ++ks) a2 = __builtin_amdgcn_mfma_f32_32x32x16_bf16(*(const bf16x8*)(Sp + (size_t)(32 * pb) * N + 16 * ks), *(const LAS bf16x8*)(qfrag + ks * 8192), a2, 0, 0, 0);
#pragma unroll
                    for (int r = 0; r < 16; ++r) acc[pb][r] += ef * a2[r];
                }
            }
        }
        const float Dh = KIND == 0 ? p->in[19][layer * 16 + hidx] : 0.f;
#pragma unroll
        for (int pb = 0; pb < 2; ++pb)
#pragma unroll
            for (int rg = 0; rg < 4; ++rg) {
                if ((rg & 1) == 0) __builtin_amdgcn_sched_barrier(0);
                const int p0 = 32 * pb + 8 * rg + 4 * hi;
                const float a0 = acc[pb][4 * rg], a1 = acc[pb][4 * rg + 1], a2 = acc[pb][4 * rg + 2], a3 = acc[pb][4 * rg + 3];
                if (KIND == 0) {
                    const u32x2 xw = *(const LAS u32x2*)(X - lo_ + pb * 16384 + i_tok * 64 + (8 * rg + 4 * hi) * 2);
                    bf16_t* zp = orow + C_Z + hidx * 64 + p0;
                    const u32x2 zw = *(const u32x2*)zp;
                    const float x0 = __uint_as_float(xw.x << 16), x1 = __uint_as_float(xw.x & 0xffff0000u), x2 = __uint_as_float(xw.y << 16), x3 = __uint_as_float(xw.y & 0xffff0000u);
                    const float z0 = __uint_as_float(zw.x << 16), z1 = __uint_as_float(zw.x & 0xffff0000u), z2 = __uint_as_float(zw.y << 16), z3 = __uint_as_float(zw.y & 0xffff0000u);
                    const float v0 = (a0 + Dh * x0) * siluf(z0), v1 = (a1 + Dh * x1) * siluf(z1), v2 = (a2 + Dh * x2) * siluf(z2), v3 = (a3 + Dh * x3) * siluf(z3);
                    ssq += v0 * v0 + v1 * v1 + v2 * v2 + v3 * v3;
                    u32x2 o; o.x = pk2(v0, v1); o.y = pk2(v2, v3); *(u32x2*)zp = o;
                } else {
                    ssq += a0 * a0 + a1 * a1 + a2 * a2 + a3 * a3;
                    bf16_t* gp = orow + C_RG + gh * 128 + 64 * head + p0;
                    const u32x2 gw = *(const u32x2*)gp; const f32x4 nw = *(const f32x4*)(p->in[21] + layer * 128 + 64 * head + p0);
                    const float g0 = __uint_as_float(gw.x << 16), g1 = __uint_as_float(gw.x & 0xffff0000u), g2 = __uint_as_float(gw.y << 16), g3 = __uint_as_float(gw.y & 0xffff0000u);
                    u32x2 o; o.x = pk2(a0 * nw[0] * siluf(g0), a1 * nw[1] * siluf(g1)); o.y = pk2(a2 * nw[2] * siluf(g2), a3 * nw[3] * siluf(g3)); *(u32x2*)gp = o;
                }
            }
        __syncthreads();
    }
    ssq += __shfl_xor(ssq, 32);
    const float rs = rsqrtf(ssq * (KIND == 0 ? 1.f / 512.f : 1.f / 128.f) + EPS);
    for (int head = 0; head < NH; ++head)
#pragma unroll
        for (int pb = 0; pb < 2; ++pb)
#pragma unroll
            for (int rg = 0; rg < 4; ++rg) {
                const int p0 = 32 * pb + 8 * rg + 4 * hi;
                bf16_t* zp = KIND == 0 ? orow + C_Z + (gh * 8 + head) * 64 + p0 : orow + C_RG + gh * 128 + 64 * head + p0;
                const u32x2 vw = *(const u32x2*)zp;
                f32x4 nw = (f32x4){1.f, 1.f, 1.f, 1.f};
                if (KIND == 0) nw = *(const f32x4*)(p->in[20] + layer * 1024 + (gh * 8 + head) * 64 + p0);
                u32x2 o; o.x = pk2(__uint_as_float(vw.x << 16) * rs * nw[0], __uint_as_float(vw.x & 0xffff0000u) * rs * nw[1]);
                o.y = pk2(__uint_as_float(vw.y << 16) * rs * nw[2], __uint_as_float(vw.y & 0xffff0000u) * rs * nw[3]);
                *(u32x2*)zp = o;
            }
    __syncthreads();
}
__device__ __forceinline__ void phase_scanC(KP p, int layer, LAS char* lds, int blk, int nblk) {
    for (int u = blk; u < 132 + 264; u += nblk) {
        if (u < 132) { const int bk = u >> 1; if (layer + 1 < DEPTH || (bk % 33) != 0) scanC_unit<0>(p, layer, lds, bk, u & 1); }
        else { const int v = u - 132, bk = v >> 2; if (layer + 1 < DEPTH || (bk % 33) != 0) scanC_unit<1>(p, layer, lds, bk, v & 3); }
    }
}

__global__ __launch_bounds__(512, 2) void hybrid_fwd(Params p_) {
    extern __shared__ __attribute__((aligned(16))) unsigned char ldsb[];
    cg::grid_group grid = cg::this_grid();
    LAS char* lds = (LAS char*)ldsb;
    float* ldsf = (float*)ldsb;
    const int blk = blockIdx.x, nblk = gridDim.x;

    phase_ada(kargs(), ldsf, blk, nblk);
    __syncthreads();
    phase_convw(kargs(), 0, ldsf, blk, nblk);
    grid.sync();
    for (int layer = 0; layer < DEPTH; ++layer) {
        if (layer > 0) phase_convw(kargs(), layer, ldsf, blk, nblk);
        phase_norm(kargs(), layer, blk, nblk);
        grid.sync();
        {
            KP p = kargs();
            pg8::Gemm g{(const bf16_t*)(p->ws + WS_H), (const bf16_t*)(p->ws + WS_WINT), MT, NPAD, DM, DM};
            pg8::StaticOrder S; S.init(MT, NPAD, nblk, blk);
            pg8::EpiProj E{(bf16_t*)(p->ws + WS_PROJ)};
            pg8::gemm_phase<pg8::EpiProj, pg8::StaticOrder, true, true>((LAS unsigned char*)lds, g, S, E);
        }
        grid.sync();
        phase_prep(kargs(), layer, blk, nblk);
        grid.sync();
        phase_attn(kargs(), layer, lds, blk, nblk);
        grid.sync();
        phase_scanA(kargs(), layer, lds, blk, nblk);
        grid.sync();
        phase_scanB(kargs(), layer, blk, nblk);
        grid.sync();
        phase_scanC(kargs(), layer, lds, blk, nblk);
        grid.sync();
        {
            KP p = kargs(); const float* ctl = (const float*)(p->ws + WS_CTL);
            const int M = layer == 0 ? MT : ML;
            pg8::Gemm g{(const bf16_t*)(p->ws + WS_PROJ), (const bf16_t*)(p->ws + WS_WOUTT), M, DM, DMIX, PITCH};
            pg8::StaticOrder S; S.init(M, DM, nblk, blk);
            pg8::EpiResid E{layer == 0 ? p->in[0] : p->out, p->out, p->in[2], (float*)(p->ws + WS_CTXN), ctl + CF_MOD + layer * 3 * 3072};
            pg8::gemm_phase<pg8::EpiResid, pg8::StaticOrder, true, true>((LAS unsigned char*)lds, g, S, E);
        }
        if (layer + 1 < DEPTH) grid.sync();
    }
}

extern "C" void kernel_launch(void* const* d_in, const int* in_sizes, int n_in, void* d_out, int out_size, void* d_ws, size_t ws_size, hipStream_t stream) {
    if (n_in != 22 || ws_size < WS_END || out_size != ML * DM) { fprintf(stderr, "kernel_launch: unexpected shapes (n_in %d, ws %zu, out %d)\n", n_in, ws_size, out_size); return; }
    static int grid_blocks = 0;
    if (!grid_blocks) {
        int dev = 0, cus = 0, per_cu = 0;
        (void)hipGetDevice(&dev);
        (void)hipDeviceGetAttribute(&cus, hipDeviceAttributeMultiprocessorCount, dev);
        (void)hipFuncSetAttribute((const void*)hybrid_fwd, hipFuncAttributeMaxDynamicSharedMemorySize, LDS_BYTES);
        (void)hipOccupancyMaxActiveBlocksPerMultiprocessor(&per_cu, (const void*)hybrid_fwd, 512, LDS_BYTES);
        if (per_cu < 1) { fprintf(stderr, "kernel_launch: occupancy query says %d blocks per CU\n", per_cu); per_cu = 1; }
        grid_blocks = cus;
        (void)hipGetLastError();
    }
    Params p{};
    for (int i = 0; i < 22; ++i) p.in[i] = (const float*)d_in[i];
    p.out = (float*)d_out; p.ws = (unsigned char*)d_ws; p.layer = 0; p.pad = 0;
    void* args[] = {&p};
    hipError_t e = hipLaunchCooperativeKernel((const void*)hybrid_fwd, dim3(grid_blocks), dim3(512), args, LDS_BYTES, stream);
    if (e != hipSuccess) fprintf(stderr, "cooperative launch failed: %s (grid %d)\n", hipGetErrorString(e), grid_blocks);
}
```

```cpp
#include <hip/hip_runtime.h>
#include <cstdio>
#include <cstdint>

constexpr int DM = 1024, NB = 2, SEQ = 8192, CTXL = 256, DEPTH = 2;
constexpr int ML = NB * SEQ, MC = NB * CTXL, MT = ML + MC;
constexpr int NPROJ = 6176, NPAD = 6400, PITCH = 6208, DMIX = 2048;
constexpr int C_AQ = 0, C_Z = 512, C_RG = 1536, C_AK = 2048, C_AV = 2560, C_AG = 3072, C_XBC = 3584, C_XS = 3584, C_BM = 4608, C_CM = 4864,
              C_RQ = 5120, C_RK = 5376, C_RV = 5632, C_DTR = 6144;
constexpr int C_YS = 2048  , C_YR = 3072  ;
constexpr float EPS = 1e-6f;
constexpr float LOG2E = 1.4426950408889634f;

typedef unsigned short bf16_t;
typedef short bf16x8 __attribute__((ext_vector_type(8)));
typedef float f32x4 __attribute__((ext_vector_type(4)));
typedef unsigned u32x4 __attribute__((ext_vector_type(4)));
typedef float f32x16 __attribute__((ext_vector_type(16)));
typedef short s16x4 __attribute__((ext_vector_type(4)));
typedef unsigned u32x2 __attribute__((ext_vector_type(2)));
#define LAS __attribute__((address_space(3)))
#ifndef PROBE
#define PROBE -1
#endif
constexpr int LDS_BYTES = 147456 + 512;
#if PROBE >= 100
#define PMARK(lds_, k) do { if (blockIdx.x == 0 && threadIdx.x == 0) ((volatile LAS unsigned long long*)((lds_) + 147456 + 16))[k] = __builtin_amdgcn_s_memrealtime(); } while (0)
#else
#define PMARK(lds_, k) do {} while (0)
#endif

constexpr size_t MiB = 1u << 20;
constexpr size_t WS_CTL = 0;
constexpr size_t WS_PROJ = 1 * MiB;
constexpr size_t PROJ_BYTES = (size_t)MT * PITCH * 2;
constexpr size_t WS_H = WS_PROJ + ((PROJ_BYTES + 4095) / 4096) * 4096;
constexpr size_t H_BYTES = (size_t)MT * DM * 2;
constexpr size_t WS_WINT = WS_H + H_BYTES;
constexpr size_t WINT_BYTES = (size_t)NPAD * DM * 2;
constexpr size_t WS_WOUTT = WS_WINT + WINT_BYTES;
constexpr size_t WOUTT_BYTES = (size_t)DM * DMIX * 2;
constexpr size_t WS_CTXN = WS_WOUTT + WOUTT_BYTES;
constexpr size_t CTXN_BYTES = (size_t)MC * DM * 4;
constexpr size_t WS_TABG = WS_CTXN;
constexpr size_t TABG_BYTES = (size_t)66 * 2 * 16 * 2 * 256 * 4;
constexpr size_t WS_END = WS_TABG + TABG_BYTES;
static_assert(WS_END <= 256 * MiB, "workspace map exceeds 256 MiB");
constexpr size_t WS_HALO = 524288;
constexpr int CF_MOD = 1024;
constexpr int CF_LAM = 512, CF_MB = 516;
constexpr int CF_ROPE = 40960;

struct Params {
    const float* in[22];
    float* out;
    unsigned char* ws;
    int layer; int pad;
};
typedef const __attribute__((address_space(4))) Params* KP;
__device__ __forceinline__ KP kargs() { KP k = (KP)__builtin_amdgcn_kernarg_segment_ptr(); asm volatile("" : "+s"(k)); return k; }

__device__ __forceinline__ int tid_opaque() { int t = threadIdx.x; asm volatile("" : "+v"(t)); return t; }
__device__ __forceinline__ float bf2f(bf16_t v) { return __uint_as_float((unsigned)v << 16); }
__device__ __forceinline__ bf16_t f2bf(float f) { unsigned u = __float_as_uint(f); return (bf16_t)((u + 0x7fffu + ((u >> 16) & 1u)) >> 16); }
__device__ __forceinline__ unsigned pk2(float lo, float hi) { return (unsigned)f2bf(lo) | ((unsigned)f2bf(hi) << 16); }
__device__ __forceinline__ float siluf(float x) { return x * __builtin_amdgcn_rcpf(1.f + __builtin_amdgcn_exp2f(-x * LOG2E)); }
__device__ __forceinline__ void unpack8(const u32x4 w, float* f) {
    f[0] = __uint_as_float(w.x << 16); f[1] = __uint_as_float(w.x & 0xffff0000u); f[2] = __uint_as_float(w.y << 16); f[3] = __uint_as_float(w.y & 0xffff0000u);
    f[4] = __uint_as_float(w.z << 16); f[5] = __uint_as_float(w.z & 0xffff0000u); f[6] = __uint_as_float(w.w << 16); f[7] = __uint_as_float(w.w & 0xffff0000u);
}
typedef float f32x2_t __attribute__((ext_vector_type(2))); typedef __bf16 bf16x2_t __attribute__((ext_vector_type(2)));
__device__ __forceinline__ unsigned cvtpk(float lo, float hi) { f32x2_t v = {lo, hi}; bf16x2_t b = __builtin_convertvector(v, bf16x2_t); return __builtin_bit_cast(unsigned, b); }
__device__ __forceinline__ u32x4 pack8(const float* f) { u32x4 w; w.x = cvtpk(f[0], f[1]); w.y = cvtpk(f[2], f[3]); w.z = cvtpk(f[4], f[5]); w.w = cvtpk(f[6], f[7]); return w; }
__device__ __forceinline__ float wave_sum(float v) {
#pragma unroll
    for (int o = 1; o < 64; o <<= 1) v += __shfl_xor(v, o);
    return v;
}
__device__ __forceinline__ float lam_init_of(int layer) { return 0.8f - 0.6f * __expf(-0.3f * (float)layer); }

struct RowInfo { int b, t, L, isctx; };
__device__ __forceinline__ RowInfo row_info(int r) {
    RowInfo i;
    if (r < ML) { i.b = r >> 13; i.t = r & (SEQ - 1); i.L = SEQ; i.isctx = 0; }
    else { const int rr = r - ML; i.b = rr >> 8; i.t = rr & (CTXL - 1); i.L = CTXL; i.isctx = 1; }
    return i;
}
__device__ __forceinline__ int seq_row0(int b, int isctx) { return isctx ? ML + b * CTXL : b * SEQ; }

__device__ __forceinline__ void phase_ada(KP p, float* lds, int blk, int nblk) {
    const int tid = tid_opaque();
    float* ctl = (float*)(p->ws + WS_CTL);
    const float* c = p->in[1]; const float* cc = p->in[3];
    for (int i = tid; i < 3 * DM; i += blockDim.x) {
        const int v = i / DM, k = i % DM;
        const float x = (v < 2) ? c[v * DM + k] : cc[k];
        lds[i] = siluf(x);
    }
    __syncthreads();
    float* red = lds + 3 * DM;
    for (int grp = blk; grp < 256; grp += nblk) {
        const int layer = grp / 128, col0 = (grp % 128) * 24;
        const float* w = p->in[4] + (size_t)layer * DM * 3072;
        const int cl = tid & 31, kg = tid >> 5;
        float a0 = 0.f, a1 = 0.f, a2 = 0.f;
        if (cl < 24) {
            float wv[64];
#pragma unroll
            for (int i = 0; i < 64; ++i) wv[i] = w[(size_t)(kg * 64 + i) * 3072 + col0 + cl];
#pragma unroll
            for (int i = 0; i < 64; ++i) {
                const int k = kg * 64 + i;
                a0 += lds[k] * wv[i]; a1 += lds[DM + k] * wv[i]; a2 += lds[2 * DM + k] * wv[i];
            }
        }
        red[(kg * 32 + cl) * 3 + 0] = a0; red[(kg * 32 + cl) * 3 + 1] = a1; red[(kg * 32 + cl) * 3 + 2] = a2;
        __syncthreads();
        if (tid < 72) {
            const int v = tid / 24, cc2 = tid % 24;
            float s = 0.f;
            for (int g = 0; g < 16; ++g) s += red[(g * 32 + cc2) * 3 + v];
            s += p->in[5][layer * 3072 + col0 + cc2];
            ctl[CF_MOD + (layer * 3 + v) * 3072 + col0 + cc2] = s;
        }
        __syncthreads();
    }
    if (blk == (nblk > 1 ? 1 : 0)) {
        for (int i = tid; i < 192 * 16; i += blockDim.x) {
            const int f = i & 15, pid = i >> 4; const float pos = (float)(pid < 128 ? pid : pid - 128);
            const float ang = pos * exp2f(-(float)f * (13.287712379549449f / 16.f));
            ctl[CF_ROPE + i] = cosf(ang); ctl[CF_ROPE + 3072 + i] = sinf(ang);
        }
    }
    if (blk == 0 && tid < 64) {
        for (int layer = 0; layer < DEPTH; ++layer) {
            const float q1 = p->in[10][layer * 64 + tid] * p->in[11][layer * 64 + tid];
            const float q2 = p->in[12][layer * 64 + tid] * p->in[13][layer * 64 + tid];
            const float s1 = wave_sum(q1), s2 = wave_sum(q2);
            float gq = fabsf(p->in[8][layer * 64 + tid]), gk = fabsf(p->in[9][layer * 64 + tid]);
#pragma unroll
            for (int o = 1; o < 64; o <<= 1) { gq = fmaxf(gq, __shfl_xor(gq, o)); gk = fmaxf(gk, __shfl_xor(gk, o)); }
            if (tid == 0) {
                ctl[CF_LAM + layer] = expf(s1) - expf(s2) + lam_init_of(layer);
                ctl[CF_MB + layer] = 8.0f * gq * gk * LOG2E * 1.03f + 0.5f;
            }
        }
    }
}

__device__ __forceinline__ int win_src_col(int n) {
    if (n < 512) return n;
    if (n < 1536) return 3616 + (n - 512);
    if (n < 2048) return 5664 + (n - 1536);
    if (n < 2560) return 512 + (n - 2048);
    if (n < 3072) return 1024 + (n - 2560);
    if (n < 3584) return 1536 + (n - 3072);
    if (n < 5120) return 2048 + (n - 3584);
    if (n < 5376) return 4640 + (n - 5120);
    if (n < 5632) return 4896 + (n - 5376);
    if (n < 6144) return 5152 + (n - 5632);
    if (n < 6176) return 3584 + (n - 6144);
    return -1;
}
__device__ __forceinline__ void transpose_item(const float* W, int K, int N, int srccol, bf16_t* WT, int k0, int n0, float* scr, int lane) {
    if (srccol >= 0) {
        float t[32];
#pragma unroll
        for (int i = 0; i < 32; ++i) { const int kk = 2 * i + (lane >> 5); t[i] = W[(size_t)(k0 + kk) * N + srccol + (lane & 31)]; }
#pragma unroll
        for (int i = 0; i < 32; ++i) { const int kk = 2 * i + (lane >> 5); scr[kk * 33 + (lane & 31)] = t[i]; }
    } else {
#pragma unroll 8
        for (int i = 0; i < 32; ++i) { const int kk = 2 * i + (lane >> 5); scr[kk * 33 + (lane & 31)] = 0.f; }
    }
    __builtin_amdgcn_s_waitcnt(0xC07F); asm volatile("" ::: "memory");
    const int c = lane & 7;
#pragma unroll
    for (int j = 0; j < 4; ++j) {
        const int n = (lane >> 3) + 8 * j; const float* s = scr + (8 * c) * 33 + n;
        u32x4 o; o.x = pk2(s[0 * 33], s[1 * 33]); o.y = pk2(s[2 * 33], s[3 * 33]); o.z = pk2(s[4 * 33], s[5 * 33]); o.w = pk2(s[6 * 33], s[7 * 33]);
        *(u32x4*)(WT + (size_t)(n0 + n) * K + k0 + 8 * c) = o;
    }
    __builtin_amdgcn_s_waitcnt(0xC07F); asm volatile("" ::: "memory");
}
__device__ __forceinline__ void phase_convw(KP p, int layer, float* lds, int blk, int nblk) {
    const int tid = tid_opaque(), lane = tid & 63, wave = tid >> 6, nw = blockDim.x >> 6;

    float* scr = lds + wave * (64 * 33);
    const int gw = blk * nw + wave, NGW = nblk * nw;
    const float* win = p->in[6] + (size_t)layer * DM * NPROJ;
    const float* wout = p->in[7] + (size_t)layer * DMIX * DM;
    bf16_t* wint = (bf16_t*)(p->ws + WS_WINT); bf16_t* woutt = (bf16_t*)(p->ws + WS_WOUTT);
    constexpr int I_IN = (DM / 64) * (NPAD / 32), I_OUT = (DMIX / 64) * (DM / 32);
    for (int it = gw; it < I_IN + I_OUT; it += NGW) {
        if (it < I_IN) { const int nb = it % (NPAD / 32), kb = it / (NPAD / 32); transpose_item(win, DM, NPROJ, win_src_col(nb * 32), wint, kb * 64, nb * 32, scr, lane); }
        else { const int r = it - I_IN; const int nb = r % (DM / 32), kb = r / (DM / 32); transpose_item(wout, DMIX, DM, nb * 32, woutt, kb * 64, nb * 32, scr, lane); }
    }
}

__host__ __device__ __forceinline__ float* ctx_slab(unsigned char* ws, int kq, int r) { return (float*)(ws + WS_PROJ + (size_t)(kq * 512 + r) * PITCH * 2 + 4096); }
__device__ __forceinline__ void phase_norm(KP p, int layer, int blk, int nblk) {
    const int tid = tid_opaque(), lane = tid & 63, wave = tid >> 6, nw = blockDim.x >> 6;
    const float* ctl = (const float*)(p->ws + WS_CTL);
    bf16_t* H = (bf16_t*)(p->ws + WS_H);
    const float* xl = layer == 0 ? p->in[0] : p->out;
    const float* xc = p->in[2];
    constexpr int RU = 9;
    const int NW = nblk * nw;
    for (int r0 = blk * nw + wave; r0 < MT; r0 += RU * NW) {
        f32x4 v[RU][4]; float s[RU];
#pragma unroll
        for (int u = 0; u < RU; ++u) {
            const int r = r0 + u * NW; s[u] = 0.f;
            if (r < MT) {
                const float* xr = r >= ML ? xc + (size_t)(r - ML) * DM : xl + (size_t)r * DM;
#pragma unroll
                for (int j = 0; j < 4; ++j) v[u][j] = *(const f32x4*)(xr + 256 * j + 4 * lane);
                if (layer > 0 && r >= ML) {
#pragma unroll
                    for (int q = 0; q < 8; ++q) { const float* sl = ctx_slab(p->ws, q, r - ML);
#pragma unroll
                        for (int j = 0; j < 4; ++j) v[u][j] += *(const f32x4*)(sl + 256 * j + 4 * lane); }
                }
            } else {
#pragma unroll
                for (int j = 0; j < 4; ++j) v[u][j] = (f32x4){0.f, 0.f, 0.f, 0.f};
            }
        }
#pragma unroll
        for (int u = 0; u < RU; ++u) {
#pragma unroll
            for (int j = 0; j < 4; ++j) s[u] += v[u][j].x * v[u][j].x + v[u][j].y * v[u][j].y + v[u][j].z * v[u][j].z + v[u][j].w * v[u][j].w;
            s[u] = wave_sum(s[u]);
        }
#pragma unroll
        for (int u = 0; u < RU; ++u) {
            const int r = r0 + u * NW;
            if (r < MT) {
                const RowInfo ri = row_info(r);
                const float* mod = ctl + CF_MOD + (layer * 3 + (ri.isctx ? 2 : ri.b)) * 3072;
                const float rs = rsqrtf(s[u] * (1.f / DM) + EPS);
#pragma unroll
                for (int j = 0; j < 4; ++j) {
                    const int c0 = 256 * j + 4 * lane;
                    const f32x4 sh = *(const f32x4*)(mod + c0), sc = *(const f32x4*)(mod + 1024 + c0);
                    u32x2 o; o.x = cvtpk(v[u][j].x * rs * (1.f + sc.x) + sh.x, v[u][j].y * rs * (1.f + sc.y) + sh.y); o.y = cvtpk(v[u][j].z * rs * (1.f + sc.z) + sh.z, v[u][j].w * rs * (1.f + sc.w) + sh.w);
                    *(u32x2*)(H + (size_t)r * DM + c0) = o;
                }
            }
        }
    }
}

namespace pg8 {
#define PG8_LAS __attribute__((address_space(3)))
constexpr int BM = 256, BK = 64, HALF = 128, HTB = HALF * BK * 2, STAGE_BYTES = 8 * HTB, NXCD = 8, WGM = 8;
__host__ __device__ __forceinline__ int lds_byte(int r, int c) { const int st = (r >> 4) * 2 + (c >> 5), rr = r & 15, cc = c & 31, ob = rr * 64 + cc * 2; return st * 1024 + (ob ^ (((ob >> 9) & 1) << 5)); }
__host__ __device__ __forceinline__ void stage_rc(int b, int& R, int& C) { const int st = b / 1024, sb = b % 1024, swz = sb ^ (((sb >> 9) & 1) << 5); R = (st >> 1) * 16 + swz / 64; C = (st & 1) * 32 + (swz % 64) / 2; }
__host__ __device__ __forceinline__ int perm32(int rho) { const int n = rho >> 4, i = rho & 15; return 8 * (i >> 2) + 4 * n + (i & 3); }
struct Unit { int pm, pn; size_t kofs; };
struct Gemm { const bf16_t* A; const bf16_t* Bt; int M, N, K, lda, ldb; };
struct StaticOrder {
    int nM, nN, nwg, G, c;
    __host__ __device__ void init(int M, int N, int G_, int c_) { nM = M / BM; nN = N / BM; nwg = nM * nN; G = G_; c = c_; }
    __host__ __device__ bool next(int i, Unit& u) const {
        const long L = (long)i * G + c; if (L >= nwg) return false;
        int wgid = (int)L; { const int q = nwg / NXCD, r = nwg % NXCD, xcd = wgid % NXCD, off = wgid / NXCD; wgid = (xcd < r ? xcd * (q + 1) : r * (q + 1) + (xcd - r) * q) + off; }
        const int nig = WGM * nN, gid = wgid / nig, fm = gid * WGM, gsz = (nM - fm) < WGM ? (nM - fm) : WGM;
        u.pm = fm + ((wgid % nig) % gsz); u.pn = (wgid % nig) / gsz; u.kofs = 0; return true;
    }
    __device__ __forceinline__ void a_ready(const Unit&) const {}
    __device__ __forceinline__ void done(const Unit&) const {}
};
__device__ __forceinline__ unsigned cvt_pk_bf16(float lo, float hi) { unsigned r; asm volatile("v_cvt_pk_bf16_f32 %0, %1, %2" : "=v"(r) : "v"(lo), "v"(hi)); return r; }
struct EpiProj {
    static constexpr bool PERM = true, AFTER_DRAIN = false;
    bf16_t* O; bf16_t* H2;
    __device__ __forceinline__ void operator()(const f32x4 (&acc)[2][2][4][2], const Unit& u, int wr, int wc, int fr, int fq) const {
        const int row0 = u.pm * BM + wr * 64 + fr, col0 = u.pn * BM + wc * 32 + 8 * fq;
#pragma unroll
        for (int ai = 0; ai < 2; ++ai)
#pragma unroll
            for (int m = 0; m < 4; ++m) { bf16_t* rowp = O + (size_t)(row0 + ai * HALF + m * 16) * PITCH + col0;
#pragma unroll
                for (int bj = 0; bj < 2; ++bj) { const f32x4 v0 = acc[ai][bj][m][0], v1 = acc[ai][bj][m][1];
                    u32x4 w; w.x = cvt_pk_bf16(v0[0], v0[1]); w.y = cvt_pk_bf16(v0[2], v0[3]); w.z = cvt_pk_bf16(v1[0], v1[1]); w.w = cvt_pk_bf16(v1[2], v1[3]);
                    if (col0 + bj * HALF + 8 <= PITCH) *(u32x4*)(rowp + bj * HALF) = w;
                    const int rin = wr * 64 + fr + ai * HALF + m * 16;
                    if (u.pn >= 14 && u.pn < 20 && (rin == 0 || rin == BM - 1)) *(u32x4*)(H2 + (size_t)(u.pm * 2 + (rin ? 1 : 0)) * 1536 + (col0 + bj * HALF - C_XBC)) = w; } }
    }
};
struct EpiResid {
    static constexpr bool PERM = false, AFTER_DRAIN = false;
    const float* xlat; float* olat; const float* xctx; float* octx; const float* mod;
    __device__ __forceinline__ void operator()(const f32x4 (&acc)[2][2][4][2], const Unit& u, int wr, int wc, int fr, int fq) const {
        const bool isctx = u.pm >= 64;
        const float* xb = isctx ? xctx : xlat; float* ob = isctx ? octx : olat;
        const int prow = (isctx ? u.pm - 64 : u.pm) * BM + wr * 64 + fr;
        const float* gv = mod + (isctx ? 2 : (u.pm >> 5)) * 3072 + 2048;
        const int col0 = u.pn * BM + wc * 32 + 4 * fq;
#pragma unroll
        for (int bj = 0; bj < 2; ++bj)
#pragma unroll
            for (int n = 0; n < 2; ++n) { const int col = col0 + bj * HALF + n * 16; const f32x4 g = *(const f32x4*)(gv + col);
#pragma unroll
                for (int ai = 0; ai < 2; ++ai)
#pragma unroll
                    for (int m = 0; m < 4; ++m) { const size_t off = (size_t)(prow + ai * HALF + m * 16) * DM + col;
                        const f32x4 xin = *(const f32x4*)(xb + off); *(f32x4*)(ob + off) = xin + g * acc[ai][bj][m][n]; } }
    }
};
struct CtxSplitOrder {
    int c;
    __device__ bool next(int i, Unit& u) const { if (i > 0 || c >= 64) return false; const int t = c >> 3; u.pm = 64 + (t >> 2); u.pn = t & 3; u.kofs = (size_t)(c & 7) * 256 * 2; return true; }
    __device__ __forceinline__ void a_ready(const Unit&) const {}
    __device__ __forceinline__ void done(const Unit&) const {}
};
struct EpiCtxSlab {
    static constexpr bool PERM = false, AFTER_DRAIN = false;
    unsigned char* ws; const float* mod;
    __device__ __forceinline__ void operator()(const f32x4 (&acc)[2][2][4][2], const Unit& u, int wr, int wc, int fr, int fq) const {
        const int prow = (u.pm - 64) * BM + wr * 64 + fr, kq = (int)(u.kofs >> 9);
        const float* gv = mod + 2 * 3072 + 2048;
        const int col0 = u.pn * BM + wc * 32 + 4 * fq;
#pragma unroll
        for (int bj = 0; bj < 2; ++bj)
#pragma unroll
            for (int n = 0; n < 2; ++n) { const int col = col0 + bj * HALF + n * 16; const f32x4 g = *(const f32x4*)(gv + col);
#pragma unroll
                for (int ai = 0; ai < 2; ++ai)
#pragma unroll
                    for (int m = 0; m < 4; ++m) *(f32x4*)(ctx_slab(ws, kq, prow + ai * HALF + m * 16) + col) = g * acc[ai][bj][m][n]; }
    }
};
template <class Epi, class Sched, bool ALIGN_EPI = false, bool SP2 = false>
__device__ __forceinline__ void gemm_phase(PG8_LAS unsigned char* lds, const Gemm g, const Sched& S, const Epi& E) {
    const int tid = tid_opaque(), wid = __builtin_amdgcn_readfirstlane(tid >> 6), lane = tid & 63, wr = wid >> 2, wc = wid & 3, fr = lane & 15, fq = lane >> 4;
    const int K = g.K, lda = g.lda, ldb = g.ldb, nt = K / BK;
    unsigned voffA[2], voffB[2];
#pragma unroll
    for (int i = 0; i < 2; ++i) { int R, C; stage_rc(tid * 16 + i * 8192, R, C); const int Rb = Epi::PERM ? ((R & ~31) + perm32(R & 31)) : R;
        voffA[i] = (unsigned)(R * lda + C) * 2u; voffB[i] = (unsigned)(Rb * ldb + C) * 2u; }
    const size_t kstep = (size_t)(BK * 2);
    const size_t hstepA = (size_t)HALF * lda * 2, hstepB = (size_t)HALF * ldb * 2;
    const size_t tstepA = 2 * hstepA, tstepB = 2 * hstepB;
    const unsigned ldsw = (unsigned)wid * 1024u;
    const int aoff = lds_byte(wr * 64 + fr, fq * 8), boff = lds_byte(wc * 32 + fr, fq * 8);
#define PG8_SA(b, h) (((b) * 2 + (h)) * HTB)
#define PG8_SB(b, h) ((4 + (b) * 2 + (h)) * HTB)
#define PG8_STAGE(bufoff, gbase, voff) do { _Pragma("unroll") for (int _i = 0; _i < 2; ++_i) \
        __builtin_amdgcn_global_load_lds((const unsigned*)((const char*)(gbase) + (voff)[_i]), (PG8_LAS unsigned*)(lds + (bufoff) + ldsw + _i * 8192), 16, 0, 0); } while (0)
#define PG8_LDA(dst, b, h) do { _Pragma("unroll") for (int m = 0; m < 4; ++m) _Pragma("unroll") for (int k = 0; k < 2; ++k) dst[m][k] = *(const PG8_LAS bf16x8*)(lds + PG8_SA(b, h) + aoff + m * 2048 + k * 1024); } while (0)
#define PG8_LDB(dst, b, h) do { _Pragma("unroll") for (int n = 0; n < 2; ++n) _Pragma("unroll") for (int k = 0; k < 2; ++k) dst[n][k] = *(const PG8_LAS bf16x8*)(lds + PG8_SB(b, h) + boff + n * 2048 + k * 1024); } while (0)
#define PG8_MMA(ai, bj, At, Bt) do { __builtin_amdgcn_s_setprio(1); _Pragma("unroll") for (int m = 0; m < 4; ++m) _Pragma("unroll") for (int n = 0; n < 2; ++n) _Pragma("unroll") for (int k = 0; k < 2; ++k) \
        acc[ai][bj][m][n] = __builtin_amdgcn_mfma_f32_16x16x32_bf16(Bt[n][k], At[m][k], acc[ai][bj][m][n], 0, 0, 0); __builtin_amdgcn_s_setprio(0); } while (0)
#define PG8_WAIT_V(n) asm volatile("s_waitcnt vmcnt(" #n ")" ::: "memory")
#define PG8_WAIT_L(n) asm volatile("s_waitcnt lgkmcnt(" #n ")" ::: "memory")
#define PG8_BAR __builtin_amdgcn_s_barrier()
#define PG8_SCHED __builtin_amdgcn_sched_barrier(0)
    Unit cur, nxt; int ui = 0;
    if (!S.next(0, cur)) return;
    f32x4 acc[2][2][4][2];
#pragma unroll
    for (int a = 0; a < 2; ++a)
#pragma unroll
        for (int b = 0; b < 2; ++b)
#pragma unroll
            for (int m = 0; m < 4; ++m)
#pragma unroll
                for (int n = 0; n < 2; ++n) acc[a][b][m][n] = (f32x4){0.f, 0.f, 0.f, 0.f};
    bf16x8 At[4][2], B0[2][2], B1[2][2];
    const char* cA = (const char*)g.A + (size_t)cur.pm * tstepA + cur.kofs; const char* cB = (const char*)g.Bt + (size_t)cur.pn * tstepB + cur.kofs;
    S.a_ready(cur);
    if constexpr (SP2) {
        PG8_STAGE(PG8_SB(0, 0), cB, voffB); PG8_STAGE(PG8_SB(0, 1), cB + hstepB, voffB); PG8_STAGE(PG8_SA(0, 0), cA, voffA); PG8_STAGE(PG8_SA(0, 1), cA + hstepA, voffA);
        if (wr == 1) PG8_BAR;
        PG8_WAIT_V(2); PG8_BAR;
        PG8_STAGE(PG8_SB(1, 0), cB + kstep, voffB); PG8_STAGE(PG8_SA(1, 0), cA + kstep, voffA); PG8_STAGE(PG8_SB(1, 1), cB + hstepB + kstep, voffB);
        PG8_WAIT_V(6); PG8_BAR;
    } else {
        PG8_STAGE(PG8_SB(0, 0), cB, voffB); PG8_STAGE(PG8_SA(0, 0), cA, voffA); PG8_STAGE(PG8_SB(0, 1), cB + hstepB, voffB); PG8_STAGE(PG8_SA(0, 1), cA + hstepA, voffA);
        if (wr == 1) PG8_BAR;
        PG8_WAIT_V(4); PG8_BAR;
        PG8_STAGE(PG8_SB(1, 0), cB + kstep, voffB); PG8_STAGE(PG8_SA(1, 0), cA + kstep, voffA); PG8_STAGE(PG8_SB(1, 1), cB + hstepB + kstep, voffB);
        PG8_WAIT_V(6); PG8_BAR;
    }
    for (;;) {
        const bool has_next = S.next(ui + 1, nxt);
        const char* nA = has_next ? (const char*)g.A + (size_t)nxt.pm * tstepA + nxt.kofs : cA; const char* nB = has_next ? (const char*)g.Bt + (size_t)nxt.pn * tstepB + nxt.kofs : cB;
        for (int t = 0; t < nt; t += 2) {
            const bool last = (t == nt - 2);
            const char* a1 = cA + (size_t)(t + 1) * kstep;
            const char* a2 = last ? nA : cA + (size_t)(t + 2) * kstep; const char* b2 = last ? nB : cB + (size_t)(t + 2) * kstep;
            const char* a3 = a2 + kstep; const char* b3 = b2 + kstep;
            if (last && has_next) S.a_ready(nxt);
            if constexpr (SP2) {
            PG8_LDB(B0, 0, 0); PG8_LDB(B1, 0, 1); PG8_SCHED; PG8_LDA(At, 0, 0); PG8_STAGE(PG8_SA(1, 1), a1 + hstepA, voffA);
            PG8_WAIT_V(8); PG8_WAIT_L(0); PG8_BAR; PG8_MMA(0, 0, At, B0); PG8_MMA(0, 1, At, B1); PG8_BAR; PG8_SCHED;
            PG8_LDA(At, 0, 1); PG8_STAGE(PG8_SB(0, 0), b2, voffB); PG8_STAGE(PG8_SB(0, 1), b2 + hstepB, voffB); PG8_STAGE(PG8_SA(0, 0), a2, voffA);
            PG8_WAIT_V(8); PG8_WAIT_L(0); PG8_BAR; PG8_MMA(1, 0, At, B0); PG8_MMA(1, 1, At, B1); PG8_BAR; PG8_SCHED;
            PG8_LDB(B0, 1, 0); PG8_LDB(B1, 1, 1); PG8_SCHED; PG8_LDA(At, 1, 0); PG8_STAGE(PG8_SA(0, 1), a2 + hstepA, voffA);
            PG8_WAIT_V(8); PG8_WAIT_L(0); PG8_BAR; PG8_MMA(0, 0, At, B0); PG8_MMA(0, 1, At, B1); PG8_BAR; PG8_SCHED;
            PG8_LDA(At, 1, 1); PG8_STAGE(PG8_SB(1, 0), b3, voffB); PG8_STAGE(PG8_SB(1, 1), b3 + hstepB, voffB); PG8_STAGE(PG8_SA(1, 0), a3, voffA);
            PG8_WAIT_V(8); PG8_WAIT_L(0); PG8_BAR; PG8_MMA(1, 0, At, B0); PG8_MMA(1, 1, At, B1); PG8_BAR; PG8_SCHED;
            } else {
            PG8_LDB(B0, 0, 0); PG8_SCHED; PG8_LDA(At, 0, 0); PG8_STAGE(PG8_SA(1, 1), a1 + hstepA, voffA);
            PG8_WAIT_L(8); PG8_BAR; PG8_WAIT_L(0); PG8_MMA(0, 0, At, B0); PG8_BAR; PG8_SCHED;
            PG8_LDB(B1, 0, 1); PG8_STAGE(PG8_SB(0, 0), b2, voffB);
            PG8_BAR; PG8_WAIT_L(0); PG8_MMA(0, 1, At, B1); PG8_BAR;
            PG8_LDA(At, 0, 1); PG8_STAGE(PG8_SA(0, 0), a2, voffA);
            PG8_BAR; PG8_WAIT_L(0); PG8_MMA(1, 0, At, B0); PG8_BAR; PG8_SCHED;
            PG8_STAGE(PG8_SB(0, 1), b2 + hstepB, voffB);
            PG8_WAIT_V(6); PG8_BAR; PG8_MMA(1, 1, At, B1); PG8_BAR;
            PG8_LDB(B0, 1, 0); PG8_SCHED; PG8_LDA(At, 1, 0); PG8_STAGE(PG8_SA(0, 1), a2 + hstepA, voffA);
            PG8_WAIT_L(8); PG8_BAR; PG8_WAIT_L(0); PG8_MMA(0, 0, At, B0); PG8_BAR; PG8_SCHED;
            PG8_LDB(B1, 1, 1); PG8_STAGE(PG8_SB(1, 0), b3, voffB);
            PG8_BAR; PG8_WAIT_L(0); PG8_MMA(0, 1, At, B1); PG8_BAR;
            PG8_LDA(At, 1, 1); PG8_STAGE(PG8_SA(1, 0), a3, voffA);
            PG8_BAR; PG8_WAIT_L(0); PG8_MMA(1, 0, At, B0); PG8_BAR; PG8_SCHED;
            PG8_STAGE(PG8_SB(1, 1), b3 + hstepB, voffB);
            PG8_WAIT_V(6); PG8_BAR; PG8_MMA(1, 1, At, B1); PG8_BAR;
            }
        }
        if constexpr (ALIGN_EPI) { if (wr == 0) PG8_BAR; }
        if constexpr (!Epi::AFTER_DRAIN) { E(acc, cur, wr, wc, fr, fq); S.done(cur); }
        if (!has_next) break;
#pragma unroll
        for (int a = 0; a < 2; ++a)
#pragma unroll
            for (int b = 0; b < 2; ++b)
#pragma unroll
                for (int m = 0; m < 4; ++m)
#pragma unroll
                    for (int n = 0; n < 2; ++n) acc[a][b][m][n] = (f32x4){0.f, 0.f, 0.f, 0.f};
        cur = nxt; cA = nA; cB = nB; ++ui;
        if constexpr (ALIGN_EPI) { if (wr == 1) PG8_BAR; }
    }
    PG8_WAIT_V(0);
    if constexpr (!ALIGN_EPI) { if (wr == 0) PG8_BAR; }
    PG8_BAR;
    if constexpr (Epi::AFTER_DRAIN) { E.fused(acc, cur, wr, wc, fr, fq, lds, wid, lane); S.done(cur); }
#undef PG8_SA
#undef PG8_SB
#undef PG8_STAGE
#undef PG8_LDA
#undef PG8_LDB
#undef PG8_MMA
#undef PG8_WAIT_V
#undef PG8_WAIT_L
#undef PG8_BAR
#undef PG8_SCHED
}
}

__device__ __forceinline__ int crow(int r, int hi) { return (r & 3) + 8 * (r >> 2) + 4 * hi; }
__device__ __forceinline__ void glds16(const void* gsrc, unsigned lds_dst) { unsigned keep;
    asm volatile("s_mov_b32 %0, m0\n\ts_mov_b32 m0, %2\n\ts_nop 0\n\tglobal_load_lds_dwordx4 %1, off\n\ts_mov_b32 m0, %0" : "=&s"(keep) : "v"(gsrc), "s"(lds_dst) : "memory"); }
typedef short v4i16_t __attribute__((ext_vector_type(4)));
__device__ __forceinline__ s16x4 vtr(const LAS char* p) { return __builtin_bit_cast(s16x4, __builtin_amdgcn_ds_read_tr16_b64_v4i16((LAS v4i16_t*)p)); }
__device__ __forceinline__ int tr_laneoff(int lane) { return ((lane >> 4) & 1) * 32 + (lane & 3) * 8 + (4 * (lane >> 5) + ((lane & 15) >> 2)) * 64; }
__device__ __forceinline__ bf16x8 tr_frag(const LAS char* p) { const s16x4 lo = vtr(p), hh = vtr(p + 512); return (bf16x8){lo[0], lo[1], lo[2], lo[3], hh[0], hh[1], hh[2], hh[3]}; }
#define SBAR() __builtin_amdgcn_sched_barrier(0)
#define WAIT_BAR(N) asm volatile("s_waitcnt vmcnt(" #N ") lgkmcnt(0)\n\ts_barrier" ::: "memory")
constexpr int AT_SLOT = 32768, AT_NSLOT = 4, AT_WSF = AT_SLOT * AT_NSLOT, AT_XS = 132;

__device__ __forceinline__ void attn_unit(KP p, int layer, LAS char* lds, int b, int h, int q0, int isctx) {
    const int tid = tid_opaque(), lane = tid & 63, r32 = lane & 31, hi = lane >> 5;
    const int wave = __builtin_amdgcn_readfirstlane(tid >> 6), qg = wave & 3, map = wave >> 2;
    const float* ctl = (const float*)(p->ws + WS_CTL);
    const float mb = ctl[CF_MB + layer];
    bf16_t* P = (bf16_t*)(p->ws + WS_PROJ);
    const unsigned lds0 = (unsigned)(uintptr_t)lds;
    const int NT = isctx ? CTXL / 64 : (SEQ + CTXL) / 64;
    const int rowq0 = seq_row0(b, isctx) + q0 + qg * 32;
#define AT_KROW0(t) (isctx ? (ML + b * CTXL + (t) * 64) : ((t) < SEQ / 64 ? (b * SEQ + (t) * 64) : (ML + b * CTXL + ((t) - SEQ / 64) * 64)))
    const int krow_ = 8 * wave + (lane >> 3);
    const bf16_t* klane = P + (size_t)krow_ * PITCH + C_AK + h * 128 + (((lane & 7) ^ ((krow_ >> 1) & 7)) * 8);
    const bf16_t* vlane = P + (size_t)(16 * (wave & 3) + (lane >> 2)) * PITCH + C_AV + h * 128 + (lane & 3) * 8 + (wave >> 2) * 32;
#define AT_DMA_K(t) do { const unsigned sl_ = lds0 + (unsigned)(((t) & 3) * 16384); const bf16_t* kb_ = klane + (size_t)AT_KROW0(t) * PITCH; \
        glds16(kb_, (unsigned)__builtin_amdgcn_readfirstlane(sl_ + wave * 1024)); \
        glds16(kb_ + 64, (unsigned)__builtin_amdgcn_readfirstlane(sl_ + 8192 + wave * 1024)); } while (0)
#define AT_DMA_V(t) do { const unsigned sl_ = lds0 + 65536u + (unsigned)(((t) & 3) * 16384); const bf16_t* vb_ = vlane + (size_t)AT_KROW0(t) * PITCH; \
        glds16(vb_, (unsigned)__builtin_amdgcn_readfirstlane(sl_ + (wave >> 2) * 4096 + (wave & 3) * 1024)); \
        glds16(vb_ + 64, (unsigned)__builtin_amdgcn_readfirstlane(sl_ + ((wave >> 2) + 2) * 4096 + (wave & 3) * 1024)); } while (0)
    bf16x8 qr[4];
    {
        const bf16_t* qp = P + (size_t)(rowq0 + r32) * PITCH + C_AQ + h * 128 + map * 64 + hi * 8;
#pragma unroll
        for (int ks = 0; ks < 4; ++ks) qr[ks] = *(const bf16x8*)(qp + ks * 16);
    }
    asm volatile("" : "+v"(qr[0]), "+v"(qr[1]), "+v"(qr[2]), "+v"(qr[3]));
    auto epilogue = [&](float l, f32x16 (&o)[4]) {
        const int tid = tid_opaque(), lane = tid & 63, r32 = lane & 31, hi = lane >> 5;
        const int wave = __builtin_amdgcn_readfirstlane(tid >> 6), qg = wave & 3, map = wave >> 2;
        const float lam = ((const float*)(p->ws + WS_CTL))[CF_LAM + layer];
        const int rowq0 = seq_row0(b, isctx) + q0 + qg * 32;
        bf16_t* P = (bf16_t*)(p->ws + WS_PROJ);
        LAS float* wsf = (LAS float*)(lds + AT_WSF) + wave * 32;

    if (hi == 0) wsf[r32] = l;
    asm volatile("s_waitcnt lgkmcnt(0)" ::: "memory");
    LAS float* X = (LAS float*)lds + qg * (32 * AT_XS);
    const float fm = map ? lam : 1.f;
    if (map == 1) {
#pragma unroll
        for (int r = 0; r < 16; ++r) { const int row = crow(r, hi); const float f = fm / wsf[row];
#pragma unroll
            for (int d0 = 0; d0 < 4; ++d0) X[row * AT_XS + d0 * 32 + r32] = o[d0][r] * f; }
    }
    WAIT_BAR(0);
    if (map == 0) {
#pragma unroll
        for (int r = 0; r < 16; ++r) { const int row = crow(r, hi); const float f = fm / wsf[row];
#pragma unroll
            for (int d0 = 0; d0 < 4; ++d0) { const int xi = row * AT_XS + d0 * 32 + r32; X[xi] = o[d0][r] * f - X[xi]; } }
        asm volatile("s_waitcnt lgkmcnt(0)" ::: "memory");
        const int row = lane >> 1, half = lane & 1;
        float xv[64]; float ss = 0.f;
#pragma unroll
        for (int i = 0; i < 64; i += 4) { const f32x4 v = *(const LAS f32x4*)(X + row * AT_XS + half * 64 + i); xv[i] = v[0]; xv[i + 1] = v[1]; xv[i + 2] = v[2]; xv[i + 3] = v[3];
            ss += v[0] * v[0] + v[1] * v[1] + v[2] * v[2] + v[3] * v[3]; }
        ss += __shfl_xor(ss, 1);
        const float rs = rsqrtf(ss * (1.f / 128.f) + EPS) * (1.f - lam_init_of(layer));
        const float* sub = p->in[14] + layer * 128 + half * 64;
        bf16_t* gp = P + (size_t)(rowq0 + row) * PITCH + C_AG + h * 128 + half * 64;
        bf16_t* op = P + (size_t)(rowq0 + row) * PITCH + C_AQ + h * 128 + half * 64;
#pragma unroll
        for (int i = 0; i < 64; i += 8) {
            float g[8]; unpack8(*(const u32x4*)(gp + i), g);
            float w[8];
#pragma unroll
            for (int j = 0; j < 8; ++j) w[j] = xv[i + j] * rs * sub[i + j] * siluf(g[j]);
            *(u32x4*)(op + i) = pack8(w);
        }
    }
    };
    AT_DMA_K(0); AT_DMA_K(1); AT_DMA_V(0); AT_DMA_K(2); AT_DMA_V(1);
    f32x16 o[4];
#pragma unroll
    for (int d = 0; d < 4; ++d)
#pragma unroll
        for (int r = 0; r < 16; ++r) o[d][r] = 0.f;
    float nmb = -mb; asm volatile("" : "+v"(nmb));
    f32x16 negm;
#pragma unroll
    for (int r = 0; r < 16; ++r) negm[r] = nmb;
    asm volatile("" : "+v"(negm));
    float l = 0.f, lkeep = 1.f;
    const int ksw = (r32 >> 1) & 7;
    const int koff = map * 8192 + r32 * 128;
    int kso[4];
#pragma unroll
    for (int ks = 0; ks < 4; ++ks) kso[ks] = koff + (((2 * ks + hi) ^ ksw) * 16);
    const int voff = 65536 + ((lane >> 4) & 1) * 32 + (lane & 3) * 8 + (4 * hi + ((lane & 15) >> 2)) * 64;
    u32x4 pwx[2], pwy[2];
#define AT_QKH(t, half, S) do { const LAS char* kp_ = lds + ((t) & 3) * 16384 + (half) * 4096; _Pragma("unroll") for (int r = 0; r < 16; ++r) S[r] = nmb; \
        _Pragma("unroll") for (int ks = 0; ks < 4; ++ks) S = __builtin_amdgcn_mfma_f32_32x32x16_bf16(*(const LAS bf16x8*)(kp_ + kso[ks]), qr[ks], S, 0, 0, 0); } while (0)
#define AT_EXH(e, S, PWX) do { \
        _Pragma("unroll") for (int r = 8 * (e); r < 8 * (e) + 8; ++r) S[r] = __builtin_amdgcn_exp2f(S[r]); \
        l += lkeep * (((S[8 * (e)] + S[8 * (e) + 1]) + (S[8 * (e) + 2] + S[8 * (e) + 3])) + ((S[8 * (e) + 4] + S[8 * (e) + 5]) + (S[8 * (e) + 6] + S[8 * (e) + 7]))); \
        _Pragma("unroll") for (int j = 0; j < 4; ++j) PWX[j] = cvtpk(S[8 * (e) + 2 * j], S[8 * (e) + 2 * j + 1]); } while (0)
#define AT_LDK(i, KA, hfk) asm volatile("ds_read_b128 %0, %1 offset:%c2" : "=v"(fk[i]) : "v"(KA[i]), "i"((hfk) * 4096) : "memory")
#define AT_LDV(F, VA, ks, d) do { asm volatile("ds_read_b64_tr_b16 %0, %1 offset:%c2" : "=v"(F[0]) : "v"(VA), "i"((ks) * 1024 + (d) * 4096) : "memory"); \
                                  asm volatile("ds_read_b64_tr_b16 %0, %1 offset:%c2" : "=v"(F[1]) : "v"(VA), "i"((ks) * 1024 + (d) * 4096 + 512) : "memory"); } while (0)
#define AT_LGK(n) asm volatile("s_waitcnt lgkmcnt(%0)" :: "n"(n) : "memory")
#define AT_VF2(F) (bf16x8){F[0][0], F[0][1], F[0][2], F[0][3], F[1][0], F[1][1], F[1][2], F[1][3]}
#define AT_PV(F, d0, PWF) o[d0] = __builtin_amdgcn_mfma_f32_32x32x16_bf16(__builtin_bit_cast(bf16x8, PWF), AT_VF2(F), o[d0], 0, 0, 0)
#define AT_QKM(S, i) S = __builtin_amdgcn_mfma_f32_32x32x16_bf16(fk[i], qr[i], S, 0, 0, 0)
#define AT_QKM0(S) S = __builtin_amdgcn_mfma_f32_32x32x16_bf16(fk[0], qr[0], negm, 0, 0, 0)
#define AT_VBAR(N) asm volatile("s_waitcnt vmcnt(" #N ")\n\ts_barrier" ::: "memory")
#define AT_WAIT(s) do { const int rem_ = NT - (s); if (rem_ > 2) { AT_VBAR(4); } else if (rem_ == 2) { AT_VBAR(2); } else { AT_VBAR(0); } } while (0)
#define AT_E2(S, j) do { asm volatile("v_exp_f32 %0, %1" : "=v"(ex_[2 * (j)]) : "v"(S[2 * (j)])); asm volatile("v_exp_f32 %0, %1" : "=v"(ex_[2 * (j) + 1]) : "v"(S[2 * (j) + 1])); } while (0)
#define AT_CV(PW, j) do { unsigned c_; asm volatile("v_cvt_pk_bf16_f32 %0, %1, %2" : "=v"(c_) : "v"(ex_[2 * (j)]), "v"(ex_[2 * (j) + 1])); PW[(j) >> 2][(j) & 3] = c_; } while (0)
#define AT_AD(d, x, y) asm volatile("v_add_f32 %0, %1, %2" : "=v"(d) : "v"(x), "v"(y))
#define AT_HS(hf, SACC, SEXP, PWC, PWN, LK, KAN, VAN, hfn, PRE) do { \
        AT_LDV(fa[2], va_, 2 * (hf), 2);      AT_LGK(8);  SBAR(); AT_QKM0(SACC);          AT_E2(SEXP, 0); SBAR(); \
        AT_LDK(3, ka_, hf);                   AT_LGK(7);  SBAR(); AT_PV(fa[0], 0, PWC[0]); AT_E2(SEXP, 1); AT_CV(PWN, 0); SBAR(); \
        AT_LDV(fa[3], va_, 2 * (hf), 3);      AT_LGK(8);  SBAR(); AT_QKM(SACC, 1);         AT_E2(SEXP, 2); AT_CV(PWN, 1); SBAR(); \
        AT_LDV(fb[0], va_, 2 * (hf) + 1, 0);  AT_LGK(8);  SBAR(); AT_PV(fa[1], 1, PWC[0]); AT_E2(SEXP, 3); AT_CV(PWN, 2); SBAR(); \
        AT_LDV(fb[1], va_, 2 * (hf) + 1, 1);  AT_LGK(9);  SBAR(); AT_QKM(SACC, 2);         AT_E2(SEXP, 4); AT_CV(PWN, 3); SBAR(); \
        AT_LDV(fb[2], va_, 2 * (hf) + 1, 2);  AT_LGK(9);  SBAR(); AT_PV(fa[2], 2, PWC[0]); AT_E2(SEXP, 5); AT_CV(PWN, 4); SBAR(); \
        AT_LDV(fb[3], va_, 2 * (hf) + 1, 3);  AT_LGK(10); SBAR(); AT_QKM(SACC, 3);         AT_E2(SEXP, 6); AT_CV(PWN, 5); SBAR(); \
        PRE; SBAR(); \
        AT_LDK(0, KAN, hfn);                  AT_LGK(9);  SBAR(); AT_PV(fa[3], 3, PWC[0]); AT_E2(SEXP, 7); AT_CV(PWN, 6); SBAR(); \
        AT_LDV(fa[0], VAN, 2 * (hfn), 0);     AT_LGK(9);  SBAR(); AT_PV(fb[0], 0, PWC[1]); AT_CV(PWN, 7); AT_AD(a_[0], ex_[0], ex_[1]); AT_AD(a_[1], ex_[2], ex_[3]); AT_AD(a_[2], ex_[4], ex_[5]); SBAR(); \
        AT_LDK(1, KAN, hfn);                  AT_LGK(8);  SBAR(); AT_PV(fb[1], 1, PWC[1]); AT_AD(a_[3], ex_[6], ex_[7]); AT_AD(a_[4], ex_[8], ex_[9]); AT_AD(a_[5], ex_[10], ex_[11]); AT_AD(a_[6], ex_[12], ex_[13]); SBAR(); \
        AT_LDV(fa[1], VAN, 2 * (hfn), 1);     AT_LGK(8);  SBAR(); AT_PV(fb[2], 2, PWC[1]); AT_AD(a_[7], ex_[14], ex_[15]); AT_AD(a_[0], a_[0], a_[1]); AT_AD(a_[2], a_[2], a_[3]); AT_AD(a_[4], a_[4], a_[5]); SBAR(); \
        AT_LDK(2, KAN, hfn);                  AT_LGK(7);  SBAR(); AT_PV(fb[3], 3, PWC[1]); AT_AD(a_[6], a_[6], a_[7]); AT_AD(a_[0], a_[0], a_[2]); AT_AD(a_[4], a_[4], a_[6]); AT_AD(a_[0], a_[0], a_[4]); \
                                                                  asm volatile("v_fmac_f32 %0, %1, %2" : "+v"(l) : "v"(LK), "v"(a_[0])); SBAR(); } while (0)
#define AT_BASES(t, VA, KA) do { const int t1_ = (t) + 1 < NT ? (t) + 1 : NT - 1; \
        VA = lds0 + (unsigned)(((t) & 3) * 16384 + voff); _Pragma("unroll") for (int ks = 0; ks < 4; ++ks) KA[ks] = lds0 + (unsigned)((t1_ & 3) * 16384 + kso[ks]); } while (0)
#define AT_SEAM(s, VA, KA) do { if ((s) < NT) { AT_WAIT(s); if ((s) + 3 < NT) AT_DMA_K((s) + 3); if ((s) + 2 < NT) AT_DMA_V((s) + 2); } AT_BASES(s, VA, KA); } while (0)
#define AT_STEP(t) do { float a_[8], ex_[16]; lkeep = (t) + 1 < NT ? 1.f : 0.f; \
        AT_HS(0, sa_, sb_, pwx, pwy, one_, ka_, va_, 1, do {} while (0)); \
        AT_HS(1, sb_, sa_, pwy, pwx, lkeep, kan_, van_, 0, AT_SEAM((t) + 1, van_, kan_)); \
        va_ = van_; _Pragma("unroll") for (int ks = 0; ks < 4; ++ks) ka_[ks] = kan_[ks]; } while (0)
    f32x16 sa_, sb_; float one_ = 1.f; asm volatile("" : "+v"(one_));
    bf16x8 fk[4]; s16x4 fa[4][2], fb[4][2]; unsigned va_, ka_[4], van_, kan_[4];
    {
        asm volatile("s_waitcnt vmcnt(8)\n\ts_barrier" ::: "memory");
        AT_QKH(0, 0, sa_); AT_EXH(0, sa_, pwx[0]); AT_EXH(1, sa_, pwx[1]); AT_QKH(0, 1, sb_);
        SBAR(); AT_SEAM(0, va_, ka_); SBAR();
        AT_LDK(0, ka_, 0); AT_LDV(fa[0], va_, 0, 0); AT_LDK(1, ka_, 0); AT_LDV(fa[1], va_, 0, 1); AT_LDK(2, ka_, 0); SBAR();
    }
    if (map == 1) __builtin_amdgcn_s_setprio(1);
    for (int t = 0; t < NT; ++t) { AT_STEP(t); }
    __builtin_amdgcn_s_setprio(0);
    asm volatile("s_waitcnt lgkmcnt(0)" ::: "memory");
    l += __shfl_xor(l, 32);
    WAIT_BAR(0);
    epilogue(l, o);
    WAIT_BAR(0);
#undef AT_DMA_K
#undef AT_DMA_V
#undef AT_KROW0
#undef AT_QK
#undef AT_EXP
#undef AT_PVX
#undef AT_TRR
#undef AT_VLD
#undef AT_VF
#undef AT_MM
#undef AT_QKH
#undef AT_LGK0
#undef AT_QKM
#undef AT_KLD
#undef AT_EXH
#undef AT_PVB
#undef AT_WAIT
#undef AT_STEP
#undef AT_MM1
#undef AT_KRD
#undef AT_E2
#undef AT_CV
#undef AT_HS
#undef AT_AD
#undef AT_BASES
#undef AT_SEAM
#undef AT_LDK
#undef AT_LDV
#undef AT_LGK
#undef AT_VF2
#undef AT_PV
#undef AT_QKM0
#undef AT_VBAR
}
__device__ __forceinline__ void phase_attn(KP p, int layer, LAS char* lds, int blk, int nblk) {
    const int nunits = 512 + (layer == 0 ? 16 : 0);
    for (int u = blk; u < nunits; u += nblk) {
        if (u < 512) { const int bh = u & 7, qb = u >> 3; attn_unit(p, layer, lds, bh >> 2, bh & 3, qb * 128, 0); }
        else { const int j = u - 512; attn_unit(p, layer, lds, j >> 3, (j >> 1) & 3, (j & 1) * 128, 1); }
    }
}

__device__ __forceinline__ void phase_prep(KP p, int layer, float* ldsf, int blk, int nblk) {
    const int tid = tid_opaque(), lane = tid & 63, wave = tid >> 6, nw = blockDim.x >> 6;
    bf16_t* P = (bf16_t*)(p->ws + WS_PROJ);
    float* ctab = ldsf; float* stab = ldsf + 192 * 16;
    { const float* src = (const float*)(p->ws + WS_CTL) + CF_ROPE;
      for (int i = tid; i < 2 * 192 * 16; i += blockDim.x) ldsf[i] = src[i]; }
    __syncthreads();
    const int sub = lane & 7, a0 = (sub & 3) * 8;
    float gq[8], gk[8];
#pragma unroll
    for (int j = 0; j < 8; ++j) { gq[j] = p->in[8][layer * 64 + sub * 8 + j]; gk[j] = p->in[9][layer * 64 + sub * 8 + j]; }
    constexpr int RU = 6;
    const bool wsplit = nblk >= 200;
    const int per = (MT + (nblk - 148) - 1) / (nblk - 148 > 0 ? nblk - 148 : 1);
    const int rbase = !wsplit ? 0 : (blk < 148 ? 0 : (blk - 148) * per);
    const int nrows = !wsplit ? MT : (blk < 148 ? 0 : (rbase + per <= MT ? per : (MT > rbase ? MT - rbase : 0)));
    const int NW = wsplit ? nw : nblk * nw;
    for (int r0 = wsplit ? wave : blk * nw + wave; r0 < nrows; r0 += RU * NW) {
        u32x4 wq[RU], wk[RU];
#pragma unroll
        for (int u = 0; u < RU; ++u) { const int r = rbase + (r0 + u * NW < nrows ? r0 + u * NW : r0); const bf16_t* row = P + (size_t)r * PITCH;
            wq[u] = *(const u32x4*)(row + C_AQ + lane * 8); wk[u] = *(const u32x4*)(row + C_AK + lane * 8); }
#pragma unroll
        for (int u = 0; u < RU; ++u) {
            if (r0 + u * NW < nrows) {
                const int r = rbase + r0 + u * NW;
                const RowInfo ri = row_info(r);
                float cs[8], sn[8];
                if (!ri.isctx) {
                    const int base = (a0 < 16) ? (ri.t >> 6) * 16 + a0 : (128 + (ri.t & 63)) * 16 + (a0 - 16);
#pragma unroll
                    for (int j = 0; j < 8; ++j) { cs[j] = ctab[base + j]; sn[j] = stab[base + j]; }
                } else {
#pragma unroll
                    for (int j = 0; j < 8; ++j) { cs[j] = 1.f; sn[j] = 0.f; }
                }
                bf16_t* row = P + (size_t)r * PITCH;
                float x[8], y[8];
                unpack8(wq[u], x);
                { float ss = 0.f;
#pragma unroll
                  for (int j = 0; j < 8; ++j) ss += x[j] * x[j];
                  ss += __shfl_xor(ss, 1); ss += __shfl_xor(ss, 2); ss += __shfl_xor(ss, 4);
                  const float rs = rsqrtf(ss * (1.f / 64.f) + EPS);
#pragma unroll
                  for (int j = 0; j < 8; ++j) x[j] *= rs * gq[j];
#pragma unroll
                  for (int j = 0; j < 8; ++j) { const float o = __shfl_xor(x[j], 4); y[j] = ((sub < 4) ? (x[j] * cs[j] - o * sn[j]) : (o * sn[j] + x[j] * cs[j])) * (0.125f * LOG2E); }
                  *(u32x4*)(row + C_AQ + lane * 8) = pack8(y); }
                unpack8(wk[u], x);
                { float ss = 0.f;
#pragma unroll
                  for (int j = 0; j < 8; ++j) ss += x[j] * x[j];
                  ss += __shfl_xor(ss, 1); ss += __shfl_xor(ss, 2); ss += __shfl_xor(ss, 4);
                  const float rs = rsqrtf(ss * (1.f / 64.f) + EPS);
#pragma unroll
                  for (int j = 0; j < 8; ++j) x[j] *= rs * gk[j];
#pragma unroll
                  for (int j = 0; j < 8; ++j) { const float o = __shfl_xor(x[j], 4); y[j] = (sub < 4) ? (x[j] * cs[j] - o * sn[j]) : (o * sn[j] + x[j] * cs[j]); }
                  *(u32x4*)(row + C_AK + lane * 8) = pack8(y); }
            }
        }
    }
    __syncthreads();
}

constexpr int C_U = C_XBC;
constexpr int CF_TOT = 32768;
constexpr size_t WS_ST = WS_H;
static_assert((size_t)66 * 2 * 20 * 8192 * 2 <= H_BYTES + WINT_BYTES, "states overlay");
__device__ __forceinline__ size_t st_off(int blk, int dir, int head) { return (size_t)((blk * 2 + dir) * 20 + head) * 8192; }
struct BlkInfo { int b, isctx, row0, t0, L, seqrow0; };
__device__ __forceinline__ BlkInfo blk_info(int blk) {
    BlkInfo i; i.b = blk / 33; const int k = blk % 33; i.isctx = (k == 0);
    if (i.isctx) { i.seqrow0 = ML + i.b * CTXL; i.t0 = 0; i.L = CTXL; } else { i.seqrow0 = i.b * SEQ; i.t0 = (k - 1) * 256; i.L = SEQ; }
    i.row0 = i.seqrow0 + i.t0; return i;
}
template <int NTOK, int CH = 8, class F>
__device__ __forceinline__ void conv_strip(const bf16_t* P, const BlkInfo& bi, int tb, int ch0, const float* cw, const float* cb, F&& emit) {
    float w0[CH], w1[CH], w2[CH], bb[CH];
#pragma unroll
    for (int j = 0; j < CH; ++j) { w0[j] = cw[ch0 + j]; w1[j] = cw[1536 + ch0 + j]; w2[j] = cw[3072 + ch0 + j]; bb[j] = cb[ch0 + j]; }
    float xm[CH], x0[CH], xp[CH];
    const bf16_t* base = P + (size_t)bi.seqrow0 * PITCH + C_XBC + ch0;
    auto ld = [&](int ts, float* f) {
        const int tc = ts < 0 ? 0 : (ts >= bi.L ? bi.L - 1 : ts); const unsigned keep = (ts == tc) ? 0xffffffffu : 0u;
        if (CH == 8) { u32x4 w = *(const u32x4*)(base + (size_t)tc * PITCH); w.x &= keep; w.y &= keep; w.z &= keep; w.w &= keep; unpack8(w, f); }
        else { u32x2 w = *(const u32x2*)(base + (size_t)tc * PITCH); w.x &= keep; w.y &= keep; f[0] = __uint_as_float(w.x << 16); f[1] = __uint_as_float(w.x & 0xffff0000u); f[2] = __uint_as_float(w.y << 16); f[3] = __uint_as_float(w.y & 0xffff0000u); } };
    const int ts0 = bi.t0 + tb;
    ld(ts0 - 1, xm); ld(ts0, x0);
#pragma unroll
    for (int tt = 0; tt < NTOK; ++tt) {
        ld(ts0 + tt + 1, xp);
        float u[CH];
#pragma unroll
        for (int j = 0; j < CH; ++j) { const float a = bb[j] + w0[j] * xm[j] + w1[j] * x0[j] + w2[j] * xp[j]; u[j] = siluf(a); }
        emit(tb + tt, u);
#pragma unroll
        for (int j = 0; j < CH; ++j) { xm[j] = x0[j]; x0[j] = xp[j]; }
    }
}
template <int KIND>
__device__ __forceinline__ void scan_tables(KP p, int layer, const bf16_t* P, const BlkInfo& bi, int hidx, int dir, int lane, float (&cum)[4], float (&dt)[4], float& tot) {
    float la[4];
    if (KIND == 0) {
        const float bias = p->in[17][(layer * 2 + dir) * 16 + hidx], A = expf(p->in[18][(layer * 2 + dir) * 16 + hidx]);
#pragma unroll
        for (int k = 0; k < 4; ++k) { const float x = bf2f(P[(size_t)(bi.row0 + 4 * lane + k) * PITCH + C_DTR + dir * 16 + hidx]) + bias; dt[k] = x > 20.f ? x : __logf(1.f + __expf(x)); la[k] = -dt[k] * A; }
    } else {
        const float lar = log1pf(-exp2f(-((dir == 0 ? 5.0f : 5.5f) + (float)hidx)));
        float one = 1.f; asm volatile("" : "+v"(one));
#pragma unroll
        for (int k = 0; k < 4; ++k) { dt[k] = one; la[k] = lar; }
    }
    if (dir == 0) {
        float c[4]; c[0] = la[0]; c[1] = c[0] + la[1]; c[2] = c[1] + la[2]; c[3] = c[2] + la[3];
        float incl = c[3];
#pragma unroll
        for (int o = 1; o < 64; o <<= 1) { const float t = __shfl_up(incl, o); if (lane >= o) incl += t; }
        const float excl = incl - c[3];
#pragma unroll
        for (int k = 0; k < 4; ++k) cum[k] = excl + c[k];
        tot = __shfl(incl, 63);
    } else {
        float c[4]; c[3] = la[3]; c[2] = c[3] + la[2]; c[1] = c[2] + la[1]; c[0] = c[1] + la[0];
        float incl = c[0];
#pragma unroll
        for (int o = 1; o < 64; o <<= 1) { const float t = __shfl_down(incl, o); if (lane + o < 64) incl += t; }
        const float excl = incl - c[0];
#pragma unroll
        for (int k = 0; k < 4; ++k) cum[k] = excl + c[k];
        tot = __shfl(incl, 0);
    }
}

__device__ __forceinline__ int blk_rowtile(int blk) { const int b = blk / 33, k = blk % 33; return k == 0 ? 64 + b : 32 * b + (k - 1); }
__device__ __forceinline__ void scanA_ssd(KP p, int layer, LAS char* lds, int blk, int g) {
    const int tid = tid_opaque(), lane = tid & 63, r32 = lane & 31, hi = lane >> 5, wave = __builtin_amdgcn_readfirstlane(tid >> 6);
    const BlkInfo bi = blk_info(blk);
    const bf16_t* P = (const bf16_t*)(p->ws + WS_PROJ);
    bf16_t* Pw = (bf16_t*)(p->ws + WS_PROJ);
    bf16_t* ST = (bf16_t*)(p->ws + WS_ST); float* ctl = (float*)(p->ws + WS_CTL);
    const float* cw = p->in[15] + (size_t)layer * 3 * 1536; const float* cb = p->in[16] + (size_t)layer * 1536;
    LAS float* WA = (LAS float*)(lds + 131072);
    int blk_o = blk; asm volatile("" : "+s"(blk_o));
    const int kk = blk_o % 33 - 1, pmt = blk_rowtile(blk_o);
    const bf16_t* HL = (const bf16_t*)(p->ws + WS_HALO);
    const bf16_t* hprev = (!bi.isctx && kk > 0) ? HL + (size_t)((pmt - 1) * 2 + 1) * 1536 : nullptr;
    const bf16_t* hnext = (!bi.isctx && kk < 31) ? HL + (size_t)((pmt + 1) * 2) * 1536 : nullptr;
    auto ld_row = [&](int j, int ch) -> u32x4 {
        const bool inside = (unsigned)j < 256u; const bf16_t* hs = j < 0 ? hprev : hnext;
        const bf16_t* ptr = inside ? P + (size_t)(bi.row0 + j) * PITCH + C_XBC + ch : (hs ? hs + ch : P + (size_t)bi.row0 * PITCH + C_XBC + ch);
        const unsigned keep = (inside || hs) ? 0xffffffffu : 0u;
        u32x4 w = *(const u32x4*)ptr; w.x &= keep; w.y &= keep; w.z &= keep; w.w &= keep; return w; };
#pragma unroll
    for (int q = 0; q < 2; ++q) {
        const int hd = 2 * wave + q, head = hd >> 1, dir = hd & 1;
        float cum[4], dt[4], tot;
        scan_tables<0>(p, layer, P, bi, g * 8 + head, dir, lane, cum, dt, tot);
        f32x4 w;
#pragma unroll
        for (int k = 0; k < 4; ++k) w[k] = dt[k] * __expf(tot - cum[k]);
        *(LAS f32x4*)(WA + hd * 256 + 4 * lane) = w;
        { float* tg = (float*)(p->ws + WS_TABG) + (size_t)((blk * 2 + dir) * 16 + g * 8 + head) * 512 + 4 * lane;
          *(f32x4*)tg = (f32x4){cum[0], cum[1], cum[2], cum[3]}; *(f32x4*)(tg + 256) = (f32x4){dt[0], dt[1], dt[2], dt[3]}; }
        if (lane == 0) ctl[CF_TOT + (blk * 2 + dir) * 20 + g * 8 + head] = tot;
    }
    const int bc = tid & 31, btb = (tid >> 5) * 16, bcc = bc & 15; const bool isB = bc < 16;
    const int bch = (isB ? 1024 : 1280) + g * 128 + bcc * 8;
    const int xc = tid & 7, xtb = (tid >> 3) * 4;
    u32x4 rb[18], xrow[6];
#pragma unroll
    for (int k = 0; k < 18; ++k) rb[k] = ld_row(btb - 1 + k, bch);
#pragma unroll
    for (int k = 0; k < 6; ++k) xrow[k] = ld_row(xtb - 1 + k, (g * 8) * 64 + xc * 8);
    __syncthreads();
    {
        float w0[8], w1[8], w2[8], bb[8];
#pragma unroll
        for (int j = 0; j < 8; ++j) { w0[j] = cw[bch + j]; w1[j] = cw[1536 + bch + j]; w2[j] = cw[3072 + bch + j]; bb[j] = cb[bch + j]; }
        float xm[8], x0[8], xp[8];
        unpack8(rb[0], xm); unpack8(rb[1], x0);
#pragma unroll
        for (int tt = 0; tt < 16; ++tt) {
            unpack8(rb[tt + 2], xp);
            float u[8];
#pragma unroll
            for (int j = 0; j < 8; ++j) u[j] = siluf(bb[j] + w0[j] * xm[j] + w1[j] * x0[j] + w2[j] * xp[j]);
            const u32x4 w = pack8(u); const int t = btb + tt;
            if (isB) *(LAS u32x4*)(lds + (bcc >> 2) * 16384 + t * 64 + (bcc & 3) * 16) = w;
            *(u32x4*)(Pw + (size_t)(bi.row0 + t) * PITCH + C_U + bch) = w;
#pragma unroll
            for (int j = 0; j < 8; ++j) { xm[j] = x0[j]; x0[j] = xp[j]; }
        }
    }
    const int lo_ = tr_laneoff(lane);
    for (int head = 0; head < 8; ++head) {
        {
            const int ch0 = (g * 8 + head) * 64 + xc * 8;
            float w0[8], w1[8], w2[8], bb[8];
#pragma unroll
            for (int j = 0; j < 8; ++j) { w0[j] = cw[ch0 + j]; w1[j] = cw[1536 + ch0 + j]; w2[j] = cw[3072 + ch0 + j]; bb[j] = cb[ch0 + j]; }
            float xm[8], x0[8], xp[8];
            unpack8(xrow[0], xm); unpack8(xrow[1], x0);
#pragma unroll
            for (int tt = 0; tt < 4; ++tt) {
                unpack8(xrow[tt + 2], xp);
                float u[8], uf[8], ub[8];
                const int t = xtb + tt;
                const float wf = WA[(head * 2) * 256 + t], wb = WA[(head * 2 + 1) * 256 + t];
#pragma unroll
                for (int j = 0; j < 8; ++j) { u[j] = siluf(bb[j] + w0[j] * xm[j] + w1[j] * x0[j] + w2[j] * xp[j]); uf[j] = u[j] * wf; ub[j] = u[j] * wb; }
                *(u32x4*)(Pw + (size_t)(bi.row0 + t) * PITCH + C_U + ch0) = pack8(u);
                const int off = (xc >> 2) * 16384 + t * 64 + (xc & 3) * 16;
                *(LAS u32x4*)(lds + 65536 + off) = pack8(uf); *(LAS u32x4*)(lds + 98304 + off) = pack8(ub);
#pragma unroll
                for (int j = 0; j < 8; ++j) { xm[j] = x0[j]; x0[j] = xp[j]; }
            }
        }
        if (head + 1 < 8) {
#pragma unroll
            for (int k = 0; k < 6; ++k) xrow[k] = ld_row(xtb - 1 + k, (g * 8 + head + 1) * 64 + xc * 8);
        }
        __syncthreads();
        const int pb = wave & 1, nb = wave >> 1;
#pragma unroll
        for (int dir = 0; dir < 2; ++dir) {
            f32x16 acc;
#pragma unroll
            for (int r = 0; r < 16; ++r) acc[r] = 0.f;
            const LAS char* xa = lds + 65536 + dir * 32768 + pb * 16384 + lo_; const LAS char* ba = lds + nb * 16384 + lo_;
#pragma unroll 4
            for (int s = 0; s < 16; ++s) acc = __builtin_amdgcn_mfma_f32_32x32x16_bf16(tr_frag(xa + s * 1024), tr_frag(ba + s * 1024), acc, 0, 0, 0);
            bf16_t* so = ST + st_off(blk, dir, g * 8 + head) + 32 * nb + r32;
#pragma unroll
            for (int r = 0; r < 16; ++r) so[(size_t)(32 * pb + crow(r, hi)) * 128] = f2bf(acc[r]);
        }
        __syncthreads();
    }
}
__device__ __forceinline__ void scanA_ret(KP p, int layer, LAS char* lds, int blk, int head) {
    const int tid = tid_opaque(), lane = tid & 63, r32 = lane & 31, hi = lane >> 5, wave = __builtin_amdgcn_readfirstlane(tid >> 6);
    const BlkInfo bi = blk_info(blk);
    const bf16_t* P = (const bf16_t*)(p->ws + WS_PROJ);
    bf16_t* ST = (bf16_t*)(p->ws + WS_ST); float* ctl = (float*)(p->ws + WS_CTL);
    const float laf = log1pf(-exp2f(-(5.0f + (float)head))), lab = log1pf(-exp2f(-(5.5f + (float)head)));
    if (tid < 2) ctl[CF_TOT + (blk * 2 + tid) * 20 + 16 + head] = 256.f * (tid == 0 ? laf : lab);
    bf16_t* Pw = (bf16_t*)(p->ws + WS_PROJ);
    const float* rope = (const float*)(p->ws + WS_CTL) + CF_ROPE;
#pragma unroll
    for (int i = 0; i < 4; ++i) {
        const int itm = tid + i * 512, isk = itm >> 10, pp = itm & 3, t = (itm >> 2) & 255;
        bf16_t* src = Pw + (size_t)(bi.row0 + t) * PITCH + (isk ? C_RK : C_RQ) + head * 64 + pp * 8;
        float x1[8], x2[8], cs[8], sn[8], y1[8], y2[8];
        unpack8(*(const u32x4*)src, x1); unpack8(*(const u32x4*)(src + 32), x2);
        if (!bi.isctx) {
            const int ts = bi.t0 + t;
            const float* cp = rope + (pp < 2 ? (ts >> 6) * 16 + 8 * pp : (128 + (ts & 63)) * 16 + 8 * (pp - 2));
            const f32x4 c0 = *(const f32x4*)cp, c1 = *(const f32x4*)(cp + 4), s0 = *(const f32x4*)(cp + 3072), s1 = *(const f32x4*)(cp + 3076);
#pragma unroll
            for (int j = 0; j < 4; ++j) { cs[j] = c0[j]; cs[4 + j] = c1[j]; sn[j] = s0[j]; sn[4 + j] = s1[j]; }
        } else {
#pragma unroll
            for (int j = 0; j < 8; ++j) { cs[j] = 1.f; sn[j] = 0.f; }
        }
        const float sc = isk ? 0.125f : 1.f;
#pragma unroll
        for (int j = 0; j < 8; ++j) { y1[j] = (x1[j] * cs[j] - x2[j] * sn[j]) * sc; y2[j] = (x1[j] * sn[j] + x2[j] * cs[j]) * sc; }
        const u32x4 w1 = pack8(y1), w2 = pack8(y2);
        *(u32x4*)src = w1; *(u32x4*)(src + 32) = w2;
        if (isk) {
            float f1[8], f2[8]; unpack8(w1, f1); unpack8(w2, f2);
            const float wf = __expf((float)(255 - t) * laf), wb = __expf((float)t * lab);
            float a1[8], a2[8], b1[8], b2[8];
#pragma unroll
            for (int j = 0; j < 8; ++j) { a1[j] = f1[j] * wf; a2[j] = f2[j] * wf; b1[j] = f1[j] * wb; b2[j] = f2[j] * wb; }
            const int off1 = t * 64 + pp * 16;
            *(LAS u32x4*)(lds + off1) = pack8(a1); *(LAS u32x4*)(lds + 16384 + off1) = pack8(a2);
            *(LAS u32x4*)(lds + 32768 + off1) = pack8(b1); *(LAS u32x4*)(lds + 32768 + 16384 + off1) = pack8(b2);
        }
    }
#pragma unroll
    for (int i = 0; i < 8; ++i) {
        const int it = tid + i * 512, c = it & 15, t = it >> 4;
        *(LAS u32x4*)(lds + 65536 + (c >> 2) * 16384 + t * 64 + (c & 3) * 16) = *(const u32x4*)(P + (size_t)(bi.row0 + t) * PITCH + C_RV + head * 128 + c * 8);
    }
    __syncthreads();
    const int lo_ = tr_laneoff(lane), pb = wave & 3, nb = wave >> 2;
#pragma unroll
    for (int dir = 0; dir < 2; ++dir) {
        f32x16 acc;
#pragma unroll
        for (int r = 0; r < 16; ++r) acc[r] = 0.f;
        const LAS char* va = lds + 65536 + pb * 16384 + lo_; const LAS char* ka = lds + dir * 32768 + nb * 16384 + lo_;
#pragma unroll 4
        for (int s = 0; s < 16; ++s) acc = __builtin_amdgcn_mfma_f32_32x32x16_bf16(tr_frag(va + s * 1024), tr_frag(ka + s * 1024), acc, 0, 0, 0);
        bf16_t* so = ST + st_off(blk, dir, 16 + head) + 32 * nb + r32;
#pragma unroll
        for (int r = 0; r < 16; ++r) so[(size_t)(32 * pb + crow(r, hi)) * 64] = f2bf(acc[r]);
    }
    __syncthreads();
}
__device__ __forceinline__ void phase_scanA(KP p, int layer, LAS char* lds, int blk, int nblk) {
    if (nblk >= 200) {
        if (blk < 132) scanA_ssd(p, layer, lds, blk >> 1, blk & 1);
        else for (int v = blk - 132; v < 264; v += nblk - 132) scanA_ret(p, layer, lds, v >> 2, v & 3);
    } else
    for (int u = blk; u < 132 + 264; u += nblk) {
        if (u < 132) scanA_ssd(p, layer, lds, u >> 1, u & 1);
        else { const int v = u - 132; scanA_ret(p, layer, lds, v >> 2, v & 3); }
    }
}

__device__ __forceinline__ void phase_scanB(KP p, int layer, int blk, int nblk) {
    const int tid = tid_opaque();
    bf16_t* ST = (bf16_t*)(p->ws + WS_ST); const float* ctl = (const float*)(p->ws + WS_CTL);
    for (int it = blk * 512 + tid; it < 2 * 2 * 20 * 1024; it += nblk * 512) {
        const int e8 = it & 1023, head = (it >> 10) % 20, bd = (it >> 10) / 20, dir = bd & 1, b = bd >> 1;
        float run[8]; float zero = 0.f; asm volatile("" : "+v"(zero));
#pragma unroll
        for (int j = 0; j < 8; ++j) run[j] = zero;
        for (int s0 = 0; s0 < 33; s0 += 11) {
            u32x4 raw[11]; float tot[11];
#pragma unroll
            for (int i = 0; i < 11; ++i) {
                const int s = s0 + i, k = (s == 0) ? 0 : (dir == 0 ? s : 33 - s);
                const int bk = b * 33 + k;
                raw[i] = *(const u32x4*)(ST + st_off(bk, dir, head) + e8 * 8);
                tot[i] = ctl[CF_TOT + (bk * 2 + dir) * 20 + head];
            }
#pragma unroll
            for (int i = 0; i < 11; ++i) {
                const int s = s0 + i, k = (s == 0) ? 0 : (dir == 0 ? s : 33 - s);
                const int bk = b * 33 + k;
                float st[8]; unpack8(raw[i], st);
                const float dec = __expf(tot[i]);
                *(u32x4*)(ST + st_off(bk, dir, head) + e8 * 8) = pack8(run);
#pragma unroll
                for (int j = 0; j < 8; ++j) run[j] = run[j] * dec + st[j];
            }
        }
    }
}

template <int KIND>
__device__ __forceinline__ void scanC_unit(KP p, int layer, LAS char* lds, int blk, int gh) {
    constexpr int N = KIND == 0 ? 128 : 64, NKS = N / 16, NSTEP = KIND == 0 ? 8 : 1, NHP = KIND == 0 ? 1 : 2;
    constexpr int QOFF = (N / 8) * 4096, XOFF = KIND == 0 ? 0 : 65536, TABOFF = 131072, RSOFF = 131072 + 12288;
    const int tid = tid_opaque(), lane = tid & 63, r32 = lane & 31, hi = lane >> 5, it = __builtin_amdgcn_readfirstlane(tid >> 6);
    const BlkInfo bi = blk_info(blk);
    bf16_t* P = (bf16_t*)(p->ws + WS_PROJ);
    const bf16_t* ST = (const bf16_t*)(p->ws + WS_ST);
    const float* cw = p->in[15] + (size_t)layer * 3 * 1536; const float* cb = p->in[16] + (size_t)layer * 1536;
    const unsigned lds0 = (unsigned)(uintptr_t)lds;
    auto dma_x = [&](int head, int buf) {
        const int tid = tid_opaque(), lane = tid & 63;
#pragma unroll
        for (int i = 0; i < 4; ++i) {
            const int piece = it * 4 + i, pblk = piece >> 4, rg = piece & 15;
            glds16(P + (size_t)(bi.row0 + 16 * rg + (lane >> 2)) * PITCH + C_U + (gh * 8 + head) * 64 + pblk * 32 + (lane & 3) * 8,
                   (unsigned)__builtin_amdgcn_readfirstlane(lds0 + XOFF + buf * 32768 + pblk * 16384 + rg * 1024));
        }
    };
    if (KIND == 0) {
#pragma unroll
        for (int i = 0; i < 16; ++i) {
            const int inst = it * 16 + i, tile = inst >> 6, r4 = inst & 63;
            const int row = 4 * r4 + (lane >> 4);
            glds16(P + (size_t)(bi.row0 + row) * PITCH + C_U + 1024 + tile * 256 + gh * 128 + (((lane & 15) ^ (row & 15)) * 8),
                   (unsigned)__builtin_amdgcn_readfirstlane(lds0 + tile * QOFF + r4 * 1024));
        }
        asm volatile("s_waitcnt vmcnt(0)" ::: "memory");
    } else {
#pragma unroll
        for (int i = 0; i < 8; ++i) {
            const int itm = tid + i * 512, c = itm & 15, t = itm >> 4;
            const int col = (c < 8) ? C_RK + gh * 64 + c * 8 : C_RQ + gh * 64 + (c - 8) * 8;
            *(LAS u32x4*)(lds + (c < 8 ? 0 : QOFF) + (c & 7) * 4096 + t * 16) = *(const u32x4*)(P + (size_t)(bi.row0 + t) * PITCH + col);
        }
#pragma unroll
        for (int i = 0; i < 8; ++i) {
            const int itm = tid + i * 512, c = itm & 15, t = itm >> 4;
            *(LAS u32x4*)(lds + XOFF + (c >> 2) * 16384 + t * 64 + (c & 3) * 16) = *(const u32x4*)(P + (size_t)(bi.row0 + t) * PITCH + C_RV + gh * 128 + c * 8);
        }
    }
    __syncthreads();
    u32x4 Gs[8][2];
    const int swz = r32 & 15;
#define SC_FRAG(base, tok, ks) (KIND == 0 ? *(const LAS bf16x8*)(lds + (base) + (tok) * 256 + (((2 * (ks) + hi) ^ swz) * 16)) : *(const LAS bf16x8*)(lds + (base) + (2 * (ks) + hi) * 4096 + (tok) * 16))
    {
        bf16x8 Cf[NKS];
#pragma unroll
        for (int ks = 0; ks < NKS; ++ks) Cf[ks] = SC_FRAG(QOFF, 32 * it + r32, ks);
#pragma unroll
        for (int jt = 0; jt < 8; ++jt) {
            f32x16 a;
#pragma unroll
            for (int r = 0; r < 16; ++r) a[r] = 0.f;
#pragma unroll
            for (int ks = 0; ks < NKS; ++ks) a = __builtin_amdgcn_mfma_f32_32x32x16_bf16(SC_FRAG(0, 32 * jt + r32, ks), Cf[ks], a, 0, 0, 0);
#pragma unroll
            for (int s = 0; s < 2; ++s)
#pragma unroll
                for (int e = 0; e < 4; ++e) Gs[jt][s][e] = cvtpk(a[8 * s + 2 * e], a[8 * s + 2 * e + 1]);
        }
    }
    auto stage_step = [&](int step) {
        const int tid = tid_opaque(), lane = tid & 63;
        if (it < 2) {
            const int slot = 0, dir = it & 1;
            float cum[4], dt[4], tot;
            if (KIND == 0) {
                const float* tg = (const float*)(p->ws + WS_TABG) + (size_t)((blk * 2 + dir) * 16 + gh * 8 + step) * 512 + 4 * lane;
                const f32x4 c4_ = *(const f32x4*)tg, d4_ = *(const f32x4*)(tg + 256);
#pragma unroll
                for (int k = 0; k < 4; ++k) { cum[k] = c4_[k]; dt[k] = d4_[k]; }
            } else scan_tables<KIND>(p, layer, P, bi, gh, dir, lane, cum, dt, tot);
            const float cref = dir == 0 ? __shfl(cum[3], lane | 7) : __shfl(cum[0], lane & ~7);
            f32x4 c4, w4, d4;
#pragma unroll
            for (int k = 0; k < 4; ++k) { c4[k] = cum[k]; d4[k] = dt[k]; w4[k] = dt[k] * __expf(cref - cum[k]); }
            LAS float* T = (LAS float*)(lds + TABOFF) + (slot * 2 + dir) * 768;
            *(LAS f32x4*)(T + 4 * lane) = c4; *(LAS f32x4*)(T + 256 + 4 * lane) = w4; *(LAS f32x4*)(T + 512 + 4 * lane) = d4;
        }
        if (KIND == 0) {
            dma_x(step, 0);
            if (!bi.isctx) {
#pragma unroll
                for (int i = 0; i < 4; ++i) {
                    const int inst = it * 4 + i, dir = inst >> 4, r4 = inst & 15, row = 4 * r4 + (lane >> 4);
                    glds16(ST + st_off(blk, dir, gh * 8 + step) + (size_t)row * 128 + (((lane & 15) ^ (row & 15)) * 8),
                           (unsigned)__builtin_amdgcn_readfirstlane(lds0 + 32768u + dir * 16384u + r4 * 1024u));
                }
            }
            asm volatile("s_waitcnt vmcnt(0)" ::: "memory");
        }
    };
    const int lo_ = tr_laneoff(lane), i_tok = 32 * it + r32;
    bf16_t* orow = P + (size_t)(bi.row0 + i_tok) * PITCH;
    float ssq = 0.f;
    for (int step = 0; step < NSTEP; ++step) {
        __syncthreads();
        stage_step(step);
        __syncthreads();
#pragma unroll 1
        for (int hp = 0; hp < NHP; ++hp) {
            const int head = KIND == 0 ? step : hp;
            const int hidx = KIND == 0 ? gh * 8 + head : gh;
            const LAS char* X = lds + XOFF + hp * 32768 + lo_;
            bf16_t* gbase = KIND == 0 ? orow + C_Z + hidx * 64 + 4 * hi : orow + C_RG + gh * 128 + 64 * head + 4 * hi;
            u32x2 gz[2][4];
#pragma unroll
            for (int rg = 0; rg < 4; ++rg) gz[0][rg] = *(const u32x2*)(gbase + 8 * rg);
            f32x16 acc[2];
#pragma unroll
            for (int pb = 0; pb < 2; ++pb)
#pragma unroll
                for (int r = 0; r < 16; ++r) acc[pb][r] = 0.f;
#pragma unroll 1
            for (int dir = 0; dir < 2; ++dir) {
                const LAS float* T = (const LAS float*)(lds + TABOFF) + dir * 768;
                const float ci = T[i_tok];
#pragma unroll
                for (int jt = 0; jt < 8; ++jt) {
                    const bool off = dir == 0 ? (jt < it) : (jt > it);
                    if (off) {
                        const float wi = __expf(ci - T[dir == 0 ? 32 * jt + 31 : 32 * jt]);
#pragma unroll
                        for (int s = 0; s < 2; ++s) {
                            const int j0 = 32 * jt + 16 * s + 4 * hi;
                            const f32x4 wa = *(const LAS f32x4*)(T + 256 + j0), wb = *(const LAS f32x4*)(T + 256 + j0 + 8);
                            float gv[8]; { u32x4 g_ = Gs[jt][s]; asm volatile("" : "+v"(g_)); unpack8(g_, gv); }
#pragma unroll
                            for (int e = 0; e < 4; ++e) { gv[e] *= wa[e] * wi; gv[4 + e] *= wb[e] * wi; }
                            const bf16x8 mB = __builtin_bit_cast(bf16x8, pack8(gv));
#pragma unroll
                            for (int pb = 0; pb < 2; ++pb) acc[pb] = __builtin_amdgcn_mfma_f32_32x32x16_bf16(tr_frag(X + pb * 16384 + (32 * jt + 16 * s) * 64), mB, acc[pb], 0, 0, 0);
                        }
                    } else if (jt == it) {
#pragma unroll
                        for (int s = 0; s < 2; ++s) {
                            const int j0 = 32 * jt + 16 * s + 4 * hi;
                            const f32x4 ca = *(const LAS f32x4*)(T + j0), cb4 = *(const LAS f32x4*)(T + j0 + 8), da = *(const LAS f32x4*)(T + 512 + j0), db = *(const LAS f32x4*)(T + 512 + j0 + 8);
                            float gv[8]; { u32x4 g_ = Gs[jt][s]; asm volatile("" : "+v"(g_)); unpack8(g_, gv); }
#pragma unroll
                            for (int e = 0; e < 4; ++e) {
                                const int ja = 16 * s + 4 * hi + e, jb = ja + 8;
                                const bool ka = dir == 0 ? (ja <= r32) : (ja >= r32), kb = dir == 0 ? (jb <= r32) : (jb >= r32);
                                gv[e] = ka ? gv[e] * da[e] * __expf(ci - ca[e]) : 0.f; gv[4 + e] = kb ? gv[4 + e] * db[e] * __expf(ci - cb4[e]) : 0.f;
                            }
                            const bf16x8 mB = __builtin_bit_cast(bf16x8, pack8(gv));
#pragma unroll
                            for (int pb = 0; pb < 2; ++pb) acc[pb] = __builtin_amdgcn_mfma_f32_32x32x16_bf16(tr_frag(X + pb * 16384 + (32 * jt + 16 * s) * 64), mB, acc[pb], 0, 0, 0);
                        }
                    }
                }
                if (!bi.isctx) {
                    const float ef = __expf(ci);
                    const bf16_t* Sp = ST + st_off(blk, dir, KIND == 0 ? hidx : 16 + gh) + (size_t)((KIND == 0 ? 0 : 64 * head) + r32) * N + 8 * hi;
                    const LAS char* Sl = lds + 32768 + dir * 16384 + r32 * 256;
                    if constexpr (KIND == 0) {
                        const unsigned cbase = lds0 + (unsigned)(QOFF + (32 * it + r32) * 256), sbase = lds0 + 32768u + (unsigned)(dir * 16384 + r32 * 256);
                        unsigned xo[NKS];
#pragma unroll
                        for (int ks = 0; ks < NKS; ++ks) xo[ks] = (unsigned)(((2 * ks + hi) ^ swz) * 16);
                        bf16x8 cf[NKS];
#pragma unroll
                        for (int ks = 0; ks < NKS; ++ks) asm volatile("ds_read_b128 %0, %1" : "=v"(cf[ks]) : "v"(cbase + xo[ks]) : "memory");
#pragma unroll
                        for (int pb = 0; pb < 2; ++pb) {
                            bf16x8 sf[NKS];
#pragma unroll
                            for (int ks = 0; ks < NKS; ++ks) asm volatile("ds_read_b128 %0, %1 offset:%c2" : "=v"(sf[ks]) : "v"(sbase + xo[ks]), "i"(pb * 8192) : "memory");
                            __builtin_amdgcn_sched_barrier(0); asm volatile("s_waitcnt lgkmcnt(0)" ::: "memory"); __builtin_amdgcn_sched_barrier(0);
                            f32x16 a2;
#pragma unroll
                            for (int r = 0; r < 16; ++r) a2[r] = 0.f;
#pragma unroll
                            for (int ks = 0; ks < NKS; ++ks) a2 = __builtin_amdgcn_mfma_f32_32x32x16_bf16(sf[ks], cf[ks], a2, 0, 0, 0);
#pragma unroll
                            for (int r = 0; r < 16; ++r) acc[pb][r] += ef * a2[r];
                        }
                    } else {
#pragma unroll
                    for (int pb = 0; pb < 2; ++pb) {
                        __builtin_amdgcn_sched_barrier(0);
                        f32x16 a2;
#pragma unroll
                        for (int r = 0; r < 16; ++r) a2[r] = 0.f;
#pragma unroll
                        for (int ks = 0; ks < NKS; ++ks) a2 = __builtin_amdgcn_mfma_f32_32x32x16_bf16(KIND == 0 ? *(const LAS bf16x8*)(Sl + pb * 8192 + (((2 * ks + hi) ^ swz) * 16)) : *(const bf16x8*)(Sp + (size_t)(32 * pb) * N + 16 * ks), SC_FRAG(QOFF, 32 * it + r32, ks), a2, 0, 0, 0);
#pragma unroll
                        for (int r = 0; r < 16; ++r) acc[pb][r] += ef * a2[r];
                    }
                    }
                }
            }
            const float Dh = KIND == 0 ? p->in[19][layer * 16 + hidx] : 0.f;
#pragma unroll
            for (int rg = 0; rg < 4; ++rg) gz[1][rg] = *(const u32x2*)(gbase + 32 + 8 * rg);
#pragma unroll
            for (int pb = 0; pb < 2; ++pb)
#pragma unroll
                for (int rg = 0; rg < 4; ++rg) {
                    const int p0 = 32 * pb + 8 * rg + 4 * hi;
                    const float a0 = acc[pb][4 * rg], a1 = acc[pb][4 * rg + 1], a2 = acc[pb][4 * rg + 2], a3 = acc[pb][4 * rg + 3];
                    const u32x2 zw = gz[pb][rg];
                    const float z0 = __uint_as_float(zw.x << 16), z1 = __uint_as_float(zw.x & 0xffff0000u), z2 = __uint_as_float(zw.y << 16), z3 = __uint_as_float(zw.y & 0xffff0000u);
                    u32x2 o;
                    if (KIND == 0) {
                        const u32x2 xw = *(const LAS u32x2*)(X - lo_ + pb * 16384 + i_tok * 64 + (8 * rg + 4 * hi) * 2);
                        const float x0 = __uint_as_float(xw.x << 16), x1 = __uint_as_float(xw.x & 0xffff0000u), x2 = __uint_as_float(xw.y << 16), x3 = __uint_as_float(xw.y & 0xffff0000u);
                        const float v0 = (a0 + Dh * x0) * siluf(z0), v1 = (a1 + Dh * x1) * siluf(z1), v2 = (a2 + Dh * x2) * siluf(z2), v3 = (a3 + Dh * x3) * siluf(z3);
                        ssq += v0 * v0 + v1 * v1 + v2 * v2 + v3 * v3;
                        o.x = cvtpk(v0, v1); o.y = cvtpk(v2, v3);
                    } else {
                        ssq += a0 * a0 + a1 * a1 + a2 * a2 + a3 * a3;
                        const f32x4 nw = *(const f32x4*)(p->in[21] + layer * 128 + 64 * head + p0);
                        o.x = cvtpk(a0 * nw[0] * siluf(z0), a1 * nw[1] * siluf(z1)); o.y = cvtpk(a2 * nw[2] * siluf(z2), a3 * nw[3] * siluf(z3));
                    }
                    *(u32x2*)(gbase + 32 * pb + 8 * rg) = o;
                }
        }
    }
    ssq += __shfl_xor(ssq, 32);
    LAS float* rsb = (LAS float*)(lds + RSOFF) + 32 * it;
    if (hi == 0) rsb[r32] = rsqrtf(ssq * (KIND == 0 ? 1.f / 512.f : 1.f / 128.f) + EPS);
    asm volatile("s_waitcnt vmcnt(0) lgkmcnt(0)" ::: "memory");
    __builtin_amdgcn_fence(__ATOMIC_ACQUIRE, "agent");
    asm volatile("s_waitcnt vmcnt(0)" ::: "memory");
    {
        bf16_t* rbase = P + (size_t)(bi.row0 + 32 * it) * PITCH + (KIND == 0 ? C_Z + gh * 512 + lane * 8 : C_RG + gh * 128 + lane * 2);
        if (KIND == 0) {
            float nw[8];
#pragma unroll
            for (int j = 0; j < 8; ++j) nw[j] = p->in[20][layer * 1024 + gh * 512 + lane * 8 + j];
#pragma unroll 1
            for (int t8 = 0; t8 < 32; t8 += 32) {
                u32x4 w[32];
#pragma unroll
                for (int k = 0; k < 32; ++k) w[k] = *(const u32x4*)(rbase + (size_t)(t8 + k) * PITCH);
#pragma unroll
                for (int k = 0; k < 32; ++k) { float f[8]; unpack8(w[k], f); const float rs = rsb[t8 + k];
#pragma unroll
                    for (int j = 0; j < 8; ++j) f[j] *= rs * nw[j];
                    *(u32x4*)(rbase + (size_t)(t8 + k) * PITCH) = pack8(f); }
            }
        } else {
#pragma unroll 2
            for (int t8 = 0; t8 < 32; t8 += 8) {
                unsigned w[8];
#pragma unroll
                for (int k = 0; k < 8; ++k) w[k] = *(const unsigned*)(rbase + (size_t)(t8 + k) * PITCH);
#pragma unroll
                for (int k = 0; k < 8; ++k) { const float rs = rsb[t8 + k]; *(unsigned*)(rbase + (size_t)(t8 + k) * PITCH) = cvtpk(__uint_as_float(w[k] << 16) * rs, __uint_as_float(w[k] & 0xffff0000u) * rs); }
            }
        }
    }
    __syncthreads();
#undef SC_FRAG
}
__device__ __forceinline__ void phase_scanC(KP p, int layer, LAS char* lds, int blk, int nblk) {
    if (nblk >= 200) {
        if (blk < 132) { const int bk = blk >> 1; if (layer + 1 < DEPTH || (bk % 33) != 0) scanC_unit<0>(p, layer, lds, bk, blk & 1); }
        else for (int v = blk - 132; v < 264; v += nblk - 132) { const int bk = v >> 2; if (layer + 1 < DEPTH || (bk % 33) != 0) scanC_unit<1>(p, layer, lds, bk, v & 3); }
    } else
    for (int u = blk; u < 132 + 264; u += nblk) {
        if (u < 132) { const int bk = u >> 1; if (layer + 1 < DEPTH || (bk % 33) != 0) scanC_unit<0>(p, layer, lds, bk, u & 1); }
        else { const int v = u - 132, bk = v >> 2; if (layer + 1 < DEPTH || (bk % 33) != 0) scanC_unit<1>(p, layer, lds, bk, v & 3); }
    }
}


#define XB_TMO      128
#define XB_XCNT(j)  (256  + 64 * (j))
#define XB_XSUB(j)  (1280 + 64 * (j))
#define XB_XGEN(j)  (2304 + 64 * (j))
#define XB_TOP      3328
#define XB_TOPGEN   3392
#define XCD_BAR_WORDS 3456
#define XB_SPIN_CAP (1u << 20)
constexpr size_t WS_BAR = 262144;
constexpr int LDS_MISC = 147456;
__device__ __forceinline__ unsigned xb_ld(unsigned* p)              { return __hip_atomic_load(p, __ATOMIC_RELAXED, __HIP_MEMORY_SCOPE_AGENT); }
__device__ __forceinline__ unsigned xb_add(unsigned* p, unsigned v) { return __hip_atomic_fetch_add(p, v, __ATOMIC_RELAXED, __HIP_MEMORY_SCOPE_AGENT); }
__device__ __forceinline__ unsigned xb_xcc_id() { return (unsigned)__builtin_amdgcn_s_getreg((3 << 11) | 20) & 0xFu; }
#define XB_SPIN(cond, bar) do { unsigned _sp = 0; while (cond) { __builtin_amdgcn_s_sleep(1); \
    if ((++_sp & 255u) == 0u) { if (xb_ld(&(bar)[XB_TMO])) break; if (_sp > XB_SPIN_CAP) { atomicAdd(&(bar)[XB_TMO], 1u); break; } } } } while (0)
struct XcdBarrier { unsigned* bar; unsigned x; volatile LAS unsigned* st; };
__device__ __forceinline__ XcdBarrier xcd_barrier_post(unsigned* bar, volatile LAS unsigned* st) {
    XcdBarrier b; b.bar = bar; b.x = xb_xcc_id(); b.st = st;
    if (threadIdx.x == 0) (void)xb_add(&bar[XB_XCNT(b.x)], 1u);
    return b;
}
__device__ __forceinline__ void xcd_barrier_complete(unsigned* bar, unsigned x, unsigned& nloc, unsigned& nx) {
    const unsigned G = gridDim.x * gridDim.y * gridDim.z;
    unsigned sum, cnt, mine, sp = 0u;
    for (;;) {
        sum = 0u; cnt = 0u; mine = 0u;
#pragma unroll
        for (unsigned j = 0; j < 16; ++j) { const unsigned c = xb_ld(&bar[XB_XCNT(j)]); sum += c; cnt += (c > 0u) ? 1u : 0u; mine = (j == x) ? c : mine; }
        if (sum == G) break;
        __builtin_amdgcn_s_sleep(1);
        if ((++sp & 255u) == 0u) { if (xb_ld(&bar[XB_TMO])) break; if (sp > XB_SPIN_CAP) { atomicAdd(&bar[XB_TMO], 1u); break; } }
    }
    nloc = mine > 0u ? mine : 1u; nx = cnt > 0u ? cnt : 1u;
}
__device__ __forceinline__ void xcd_barrier(const XcdBarrier& b) {
    asm volatile("s_waitcnt vmcnt(0)" ::: "memory");
    __syncthreads();
    if (tid_opaque() == 0) {
        unsigned* bar = b.bar;
        __builtin_amdgcn_s_waitcnt(0);
        unsigned nloc = b.st[0], nx = b.st[1];
        if (nloc == 0u) { xcd_barrier_complete(bar, b.x, nloc, nx); b.st[0] = nloc; b.st[1] = nx; }
        const unsigned old = xb_add(&bar[XB_XSUB(b.x)], 1u);
        const unsigned gen = old / nloc;
        if (old + 1u == (gen + 1u) * nloc) {
            __builtin_amdgcn_fence(__ATOMIC_RELEASE, "agent");
            asm volatile("s_waitcnt vmcnt(0)" ::: "memory");
            const unsigned og = xb_add(&bar[XB_TOP], 1u);
            const unsigned tg = og / nx;
            if (og + 1u == (tg + 1u) * nx) xb_add(&bar[XB_TOPGEN], 1u);
            else XB_SPIN(xb_ld(&bar[XB_TOPGEN]) == tg, bar);
            __builtin_amdgcn_fence(__ATOMIC_ACQUIRE, "agent");
            xb_add(&bar[XB_XGEN(b.x)], 1u);
            asm volatile("s_waitcnt vmcnt(0)" ::: "memory");
        } else {
            XB_SPIN(xb_ld(&bar[XB_XGEN(b.x)]) == gen, bar);
            __builtin_amdgcn_fence(__ATOMIC_ACQUIRE, "agent");
            asm volatile("s_waitcnt vmcnt(0)" ::: "memory");
        }
    }
    __syncthreads();
}

__global__ __launch_bounds__(512, 2) void hybrid_fwd(Params p_) {
    extern __shared__ __attribute__((aligned(16))) unsigned char ldsb[];
    LAS char* lds = (LAS char*)ldsb;
    float* ldsf = (float*)ldsb;
    const int blk = blockIdx.x, nblk = gridDim.x;
    {
        volatile LAS unsigned* misc = (volatile LAS unsigned*)(lds + LDS_MISC);
        if (threadIdx.x < 2) misc[threadIdx.x] = 0u;
        __syncthreads();
        (void)xcd_barrier_post((unsigned*)(kargs()->ws + WS_BAR), misc);
    }
#define XBAR_NOW() XcdBarrier{(unsigned*)(kargs()->ws + WS_BAR), xb_xcc_id(), (volatile LAS unsigned*)(lds + LDS_MISC)}
#if PROBE >= 0
    unsigned long long pr_a = __builtin_amdgcn_s_memrealtime(), pr_b = pr_a; int pr_seam = 0;
#if PROBE >= 200
#define SEAM() do { xcd_barrier(XBAR_NOW()); ++pr_seam; if (pr_seam == PROBE - 200) pr_a = __builtin_amdgcn_s_memtime(); if (pr_seam == PROBE - 199) pr_b = pr_a + (__builtin_amdgcn_s_memtime() - pr_a) / 16; } while (0)
#else
#define SEAM() do { xcd_barrier(XBAR_NOW()); ++pr_seam; if (pr_seam == PROBE) pr_a = __builtin_amdgcn_s_memrealtime(); if (pr_seam == PROBE + 1) pr_b = __builtin_amdgcn_s_memrealtime(); } while (0)
#endif
#else
#define SEAM() xcd_barrier(XBAR_NOW())
#endif

    phase_ada(kargs(), ldsf, blk, nblk);
    __syncthreads();
    phase_convw(kargs(), 0, ldsf, blk, nblk);
    SEAM();
    for (int layer = 0; layer < DEPTH; ++layer) {
        if (layer > 0) phase_convw(kargs(), layer, ldsf, blk, nblk);
        phase_norm(kargs(), layer, blk, nblk);
        SEAM();
        {
            KP p = kargs();
            pg8::Gemm g{(const bf16_t*)(p->ws + WS_H), (const bf16_t*)(p->ws + WS_WINT), MT, NPAD, DM, DM, DM};
            pg8::StaticOrder S; S.init(MT, NPAD, nblk, blk);
            pg8::EpiProj E{(bf16_t*)(p->ws + WS_PROJ), (bf16_t*)(p->ws + WS_HALO)};
            pg8::gemm_phase<pg8::EpiProj, pg8::StaticOrder, true, true>((LAS unsigned char*)lds, g, S, E);
        }
        SEAM();
        phase_scanA(kargs(), layer, lds, blk, nblk);
        phase_prep(kargs(), layer, ldsf, blk, nblk);
        SEAM();
        phase_scanB(kargs(), layer, blk, nblk);
        phase_attn(kargs(), layer, lds, blk, nblk);
        SEAM();
        phase_scanC(kargs(), layer, lds, blk, nblk);
        SEAM();
        {
            KP p = kargs(); const float* ctl = (const float*)(p->ws + WS_CTL);
            pg8::Gemm g{(const bf16_t*)(p->ws + WS_PROJ), (const bf16_t*)(p->ws + WS_WOUTT), ML, DM, DMIX, PITCH, DMIX};
            pg8::StaticOrder S; S.init(ML, DM, nblk, blk);
            pg8::EpiResid E{layer == 0 ? p->in[0] : p->out, p->out, p->in[2], (float*)(p->ws + WS_CTXN), ctl + CF_MOD + layer * 3 * 3072};
            pg8::gemm_phase<pg8::EpiResid, pg8::StaticOrder, true, true>((LAS unsigned char*)lds, g, S, E);
            if (layer == 0 && nblk >= 64) {
                pg8::Gemm g2{(const bf16_t*)(p->ws + WS_PROJ), (const bf16_t*)(p->ws + WS_WOUTT), MT, DM, 256, PITCH, DMIX};
                pg8::CtxSplitOrder S2{blk};
                pg8::EpiCtxSlab E2{p->ws, ctl + CF_MOD};
                pg8::gemm_phase<pg8::EpiCtxSlab, pg8::CtxSplitOrder, false, true>((LAS unsigned char*)lds, g2, S2, E2);
            }
        }
        if (layer + 1 < DEPTH) SEAM();
    }
#if PROBE >= 200
#elif PROBE >= 100
    { volatile LAS unsigned long long* mk = (volatile LAS unsigned long long*)(lds + 147456 + 16); pr_a = mk[PROBE - 100]; pr_b = mk[PROBE - 99]; }
#elif PROBE >= 0
    if (PROBE + 1 > pr_seam) pr_b = __builtin_amdgcn_s_memrealtime();
#endif
#if PROBE >= 0
    if (blk == 0) { const unsigned long long t0 = __builtin_amdgcn_s_memrealtime(), w = 8ull * (pr_b - pr_a); while (__builtin_amdgcn_s_memrealtime() - t0 < w) __builtin_amdgcn_s_sleep(8); }
#endif
}

extern "C" void kernel_launch(void* const* d_in, const int* in_sizes, int n_in, void* d_out, int out_size, void* d_ws, size_t ws_size, hipStream_t stream) {
    if (n_in != 22 || ws_size < WS_END || out_size != ML * DM) { fprintf(stderr, "kernel_launch: unexpected shapes (n_in %d, ws %zu, out %d)\n", n_in, ws_size, out_size); return; }
    static int grid_blocks = 0;
    if (!grid_blocks) {
        int dev = 0, cus = 0, per_cu = 0;
        (void)hipGetDevice(&dev);
        (void)hipDeviceGetAttribute(&cus, hipDeviceAttributeMultiprocessorCount, dev);
        (void)hipFuncSetAttribute((const void*)hybrid_fwd, hipFuncAttributeMaxDynamicSharedMemorySize, LDS_BYTES);
        (void)hipOccupancyMaxActiveBlocksPerMultiprocessor(&per_cu, (const void*)hybrid_fwd, 512, LDS_BYTES);
        if (per_cu < 1) { fprintf(stderr, "kernel_launch: occupancy query says %d blocks per CU\n", per_cu); per_cu = 1; }
        grid_blocks = cus;
        (void)hipGetLastError();
    }
    Params p{};
    for (int i = 0; i < 22; ++i) p.in[i] = (const float*)d_in[i];
    p.out = (float*)d_out; p.ws = (unsigned char*)d_ws; p.layer = 0; p.pad = 0;
    (void)hipMemsetAsync((unsigned char*)d_ws + WS_BAR, 0, XCD_BAR_WORDS * 4, stream);
    void* args[] = {&p};
    hipError_t e = hipLaunchCooperativeKernel((const void*)hybrid_fwd, dim3(grid_blocks), dim3(512), args, LDS_BYTES, stream);
    if (e != hipSuccess) fprintf(stderr, "cooperative launch failed: %s (grid %d)\n", hipGetErrorString(e), grid_blocks);
}
```

```cpp
#include <hip/hip_runtime.h>
#include <cstdio>
#include <cstdint>

constexpr int DM = 1024, NB = 2, SEQ = 8192, CTXL = 256, DEPTH = 2;
constexpr int ML = NB * SEQ, MC = NB * CTXL, MT = ML + MC;
constexpr int NPROJ = 6176, NPAD = 6400, PITCH = 6208, DMIX = 2048;
constexpr int C_AQ = 0, C_Z = 512, C_RG = 1536, C_AK = 2048, C_AV = 2560, C_AG = 3072, C_XBC = 3584, C_XS = 3584, C_BM = 4608, C_CM = 4864,
              C_RQ = 5120, C_RK = 5376, C_RV = 5632, C_DTR = 6144;
constexpr int C_YS = 2048  , C_YR = 3072  ;
constexpr float EPS = 1e-6f;
constexpr float LOG2E = 1.4426950408889634f;

typedef unsigned short bf16_t;
typedef short bf16x8 __attribute__((ext_vector_type(8)));
typedef float f32x4 __attribute__((ext_vector_type(4)));
typedef unsigned u32x4 __attribute__((ext_vector_type(4)));
typedef float f32x16 __attribute__((ext_vector_type(16)));
typedef short s16x4 __attribute__((ext_vector_type(4)));
typedef unsigned u32x2 __attribute__((ext_vector_type(2)));
#define LAS __attribute__((address_space(3)))
#ifndef PROBE
#define PROBE -1
#endif
constexpr int LDS_BYTES = 147456 + 512;
#if PROBE >= 100
#define PMARK(lds_, k) do { if (blockIdx.x == 0 && threadIdx.x == 0) ((volatile LAS unsigned long long*)((lds_) + 147456 + 16))[k] = __builtin_amdgcn_s_memrealtime(); } while (0)
#else
#define PMARK(lds_, k) do {} while (0)
#endif

constexpr size_t MiB = 1u << 20;
constexpr size_t WS_CTL = 0;
constexpr size_t WS_PROJ = 1 * MiB;
constexpr size_t PROJ_BYTES = (size_t)MT * PITCH * 2;
constexpr size_t WS_H = WS_PROJ + ((PROJ_BYTES + 4095) / 4096) * 4096;
constexpr size_t H_BYTES = (size_t)MT * DM * 2;
constexpr size_t WS_WINT = WS_H + H_BYTES;
constexpr size_t WINT_BYTES = (size_t)NPAD * DM * 2;
constexpr size_t WS_WOUTT = WS_WINT + WINT_BYTES;
constexpr size_t WOUTT_BYTES = (size_t)DM * DMIX * 2;
constexpr size_t WS_CTXN = WS_WOUTT + WOUTT_BYTES;
constexpr size_t CTXN_BYTES = (size_t)MC * DM * 4;
constexpr size_t WS_TABG = WS_CTXN;
constexpr size_t TABG_BYTES = (size_t)66 * 2 * 16 * 2 * 256 * 4;
constexpr size_t WS_END = WS_TABG + TABG_BYTES;
static_assert(WS_END <= 256 * MiB, "workspace map exceeds 256 MiB");
constexpr size_t WS_HALO = 524288;
constexpr int CF_MOD = 1024;
constexpr int CF_LAM = 512, CF_MB = 516;
constexpr int CF_ROPE = 40960;

struct Params {
    const float* in[22];
    float* out;
    unsigned char* ws;
    int layer; int pad;
};
typedef const __attribute__((address_space(4))) Params* KP;
__device__ __forceinline__ KP kargs() { KP k = (KP)__builtin_amdgcn_kernarg_segment_ptr(); asm volatile("" : "+s"(k)); return k; }

__device__ __forceinline__ int tid_opaque() { int t = threadIdx.x; asm volatile("" : "+v"(t)); return t; }
__device__ __forceinline__ float bf2f(bf16_t v) { return __uint_as_float((unsigned)v << 16); }
__device__ __forceinline__ bf16_t f2bf(float f) { unsigned u = __float_as_uint(f); return (bf16_t)((u + 0x7fffu + ((u >> 16) & 1u)) >> 16); }
__device__ __forceinline__ unsigned pk2(float lo, float hi) { return (unsigned)f2bf(lo) | ((unsigned)f2bf(hi) << 16); }
__device__ __forceinline__ float siluf(float x) { return x * __builtin_amdgcn_rcpf(1.f + __builtin_amdgcn_exp2f(-x * LOG2E)); }
__device__ __forceinline__ void unpack8(const u32x4 w, float* f) {
    f[0] = __uint_as_float(w.x << 16); f[1] = __uint_as_float(w.x & 0xffff0000u); f[2] = __uint_as_float(w.y << 16); f[3] = __uint_as_float(w.y & 0xffff0000u);
    f[4] = __uint_as_float(w.z << 16); f[5] = __uint_as_float(w.z & 0xffff0000u); f[6] = __uint_as_float(w.w << 16); f[7] = __uint_as_float(w.w & 0xffff0000u);
}
typedef float f32x2_t __attribute__((ext_vector_type(2))); typedef __bf16 bf16x2_t __attribute__((ext_vector_type(2)));
__device__ __forceinline__ unsigned cvtpk(float lo, float hi) { f32x2_t v = {lo, hi}; bf16x2_t b = __builtin_convertvector(v, bf16x2_t); return __builtin_bit_cast(unsigned, b); }
__device__ __forceinline__ u32x4 pack8(const float* f) { u32x4 w; w.x = cvtpk(f[0], f[1]); w.y = cvtpk(f[2], f[3]); w.z = cvtpk(f[4], f[5]); w.w = cvtpk(f[6], f[7]); return w; }
template <bool WT> __device__ __forceinline__ void st16(void* p, u32x4 v) {
    if constexpr (WT) asm volatile("global_store_dwordx4 %0, %1, off sc1\n\ts_nop 1" :: "v"(p), "v"(v) : "memory");
    else *(u32x4*)p = v;
}
__device__ __forceinline__ float wave_sum(float v) {
#pragma unroll
    for (int o = 1; o < 64; o <<= 1) v += __shfl_xor(v, o);
    return v;
}
__device__ __forceinline__ float lam_init_of(int layer) { return 0.8f - 0.6f * __expf(-0.3f * (float)layer); }

struct RowInfo { int b, t, L, isctx; };
__device__ __forceinline__ RowInfo row_info(int r) {
    RowInfo i;
    if (r < ML) { i.b = r >> 13; i.t = r & (SEQ - 1); i.L = SEQ; i.isctx = 0; }
    else { const int rr = r - ML; i.b = rr >> 8; i.t = rr & (CTXL - 1); i.L = CTXL; i.isctx = 1; }
    return i;
}
__device__ __forceinline__ int seq_row0(int b, int isctx) { return isctx ? ML + b * CTXL : b * SEQ; }

__device__ __forceinline__ void phase_ada(KP p, float* lds, int blk, int nblk) {
    const int tid = tid_opaque();
    float* ctl = (float*)(p->ws + WS_CTL);
    const float* c = p->in[1]; const float* cc = p->in[3];
    for (int i = tid; i < 3 * DM; i += blockDim.x) {
        const int v = i / DM, k = i % DM;
        const float x = (v < 2) ? c[v * DM + k] : cc[k];
        lds[i] = siluf(x);
    }
    __syncthreads();
    float* red = lds + 3 * DM;
    for (int grp = blk; grp < 256; grp += nblk) {
        const int layer = grp / 128, col0 = (grp % 128) * 24;
        const float* w = p->in[4] + (size_t)layer * DM * 3072;
        const int cl = tid & 31, kg = tid >> 5;
        float a0 = 0.f, a1 = 0.f, a2 = 0.f;
        if (cl < 24) {
            float wv[64];
#pragma unroll
            for (int i = 0; i < 64; ++i) wv[i] = w[(size_t)(kg * 64 + i) * 3072 + col0 + cl];
#pragma unroll
            for (int i = 0; i < 64; ++i) {
                const int k = kg * 64 + i;
                a0 += lds[k] * wv[i]; a1 += lds[DM + k] * wv[i]; a2 += lds[2 * DM + k] * wv[i];
            }
        }
        red[(kg * 32 + cl) * 3 + 0] = a0; red[(kg * 32 + cl) * 3 + 1] = a1; red[(kg * 32 + cl) * 3 + 2] = a2;
        __syncthreads();
        if (tid < 72) {
            const int v = tid / 24, cc2 = tid % 24;
            float s = 0.f;
            for (int g = 0; g < 16; ++g) s += red[(g * 32 + cc2) * 3 + v];
            s += p->in[5][layer * 3072 + col0 + cc2];
            ctl[CF_MOD + (layer * 3 + v) * 3072 + col0 + cc2] = s;
        }
        __syncthreads();
    }
    if (blk == (nblk > 1 ? 1 : 0)) {
        for (int i = tid; i < 192 * 16; i += blockDim.x) {
            const int f = i & 15, pid = i >> 4; const float pos = (float)(pid < 128 ? pid : pid - 128);
            const float ang = pos * exp2f(-(float)f * (13.287712379549449f / 16.f));
            ctl[CF_ROPE + i] = cosf(ang); ctl[CF_ROPE + 3072 + i] = sinf(ang);
        }
    }
    if (blk == 0 && tid < 64) {
        for (int layer = 0; layer < DEPTH; ++layer) {
            const float q1 = p->in[10][layer * 64 + tid] * p->in[11][layer * 64 + tid];
            const float q2 = p->in[12][layer * 64 + tid] * p->in[13][layer * 64 + tid];
            const float s1 = wave_sum(q1), s2 = wave_sum(q2);
            float gq = fabsf(p->in[8][layer * 64 + tid]), gk = fabsf(p->in[9][layer * 64 + tid]);
#pragma unroll
            for (int o = 1; o < 64; o <<= 1) { gq = fmaxf(gq, __shfl_xor(gq, o)); gk = fmaxf(gk, __shfl_xor(gk, o)); }
            if (tid == 0) {
                ctl[CF_LAM + layer] = expf(s1) - expf(s2) + lam_init_of(layer);
                ctl[CF_MB + layer] = 8.0f * gq * gk * LOG2E * 1.03f + 0.5f;
            }
        }
    }
}

__device__ __forceinline__ int win_src_col(int n) {
    if (n < 512) return n;
    if (n < 1536) return 3616 + (n - 512);
    if (n < 2048) return 5664 + (n - 1536);
    if (n < 2560) return 512 + (n - 2048);
    if (n < 3072) return 1024 + (n - 2560);
    if (n < 3584) return 1536 + (n - 3072);
    if (n < 5120) return 2048 + (n - 3584);
    if (n < 5376) return 4640 + (n - 5120);
    if (n < 5632) return 4896 + (n - 5376);
    if (n < 6144) return 5152 + (n - 5632);
    if (n < 6176) return 3584 + (n - 6144);
    return -1;
}
__device__ __forceinline__ void transpose_item(const float* W, int K, int N, int srccol, bf16_t* WT, int k0, int n0, float* scr, int lane) {
    if (srccol >= 0) {
        float t[32];
#pragma unroll
        for (int i = 0; i < 32; ++i) { const int kk = 2 * i + (lane >> 5); t[i] = W[(size_t)(k0 + kk) * N + srccol + (lane & 31)]; }
#pragma unroll
        for (int i = 0; i < 32; ++i) { const int kk = 2 * i + (lane >> 5); scr[kk * 33 + (lane & 31)] = t[i]; }
    } else {
#pragma unroll 8
        for (int i = 0; i < 32; ++i) { const int kk = 2 * i + (lane >> 5); scr[kk * 33 + (lane & 31)] = 0.f; }
    }
    __builtin_amdgcn_s_waitcnt(0xC07F); asm volatile("" ::: "memory");
    const int c = lane & 7;
#pragma unroll
    for (int j = 0; j < 4; ++j) {
        const int n = (lane >> 3) + 8 * j; const float* s = scr + (8 * c) * 33 + n;
        u32x4 o; o.x = pk2(s[0 * 33], s[1 * 33]); o.y = pk2(s[2 * 33], s[3 * 33]); o.z = pk2(s[4 * 33], s[5 * 33]); o.w = pk2(s[6 * 33], s[7 * 33]);
        st16<true>(WT + (size_t)(n0 + n) * K + k0 + 8 * c, o);
    }
    __builtin_amdgcn_s_waitcnt(0xC07F); asm volatile("" ::: "memory");
}
__device__ __forceinline__ void phase_convw(KP p, int layer, float* lds, int blk, int nblk) {
    const int tid = tid_opaque(), lane = tid & 63, wave = tid >> 6, nw = blockDim.x >> 6;

    float* scr = lds + wave * (64 * 33);
    const int gw = blk * nw + wave, NGW = nblk * nw;
    const float* win = p->in[6] + (size_t)layer * DM * NPROJ;
    const float* wout = p->in[7] + (size_t)layer * DMIX * DM;
    bf16_t* wint = (bf16_t*)(p->ws + WS_WINT); bf16_t* woutt = (bf16_t*)(p->ws + WS_WOUTT);
    constexpr int I_IN = (DM / 64) * (NPAD / 32), I_OUT = (DMIX / 64) * (DM / 32);
    for (int it = gw; it < I_IN + I_OUT; it += NGW) {
        if (it < I_IN) { const int nb = it % (NPAD / 32), kb = it / (NPAD / 32); transpose_item(win, DM, NPROJ, win_src_col(nb * 32), wint, kb * 64, nb * 32, scr, lane); }
        else { const int r = it - I_IN; const int nb = r % (DM / 32), kb = r / (DM / 32); transpose_item(wout, DMIX, DM, nb * 32, woutt, kb * 64, nb * 32, scr, lane); }
    }
}

__host__ __device__ __forceinline__ float* ctx_slab(unsigned char* ws, int kq, int r) { return (float*)(ws + WS_PROJ + (size_t)(kq * 512 + r) * PITCH * 2 + 4096); }
__device__ __forceinline__ void phase_norm(KP p, int layer, int blk, int nblk, float* ldsf) {
    const int tid = tid_opaque(), lane = tid & 63, wave = tid >> 6, nw = blockDim.x >> 6;
    const float* ctl = (const float*)(p->ws + WS_CTL);
    bf16_t* H = (bf16_t*)(p->ws + WS_H);
    const float* xl = layer == 0 ? p->in[0] : p->out;
    const float* xc = p->in[2];
    constexpr int RU = 9;
    const int NW = nblk * nw;
    LAS float* mlds = (LAS float*)ldsf + 24576;
    const bool onepass = RU * NW >= MT;
    float t[12];
#pragma unroll
    for (int k = 0; k < 12; ++k) { const int i = tid + k * 512; t[k] = ctl[CF_MOD + (layer * 3 + i / 2048) * 3072 + (i % 2048)]; }
    if (!onepass) {
#pragma unroll
        for (int k = 0; k < 12; ++k) mlds[tid + k * 512] = t[k];
        __syncthreads();
    }
    for (int r0 = blk * nw + wave; r0 < MT; r0 += RU * NW) {
        f32x4 v[RU][4];
#pragma unroll
        for (int u = 0; u < RU; ++u) {
            const int r = r0 + u * NW;
            if (r < MT) {
                const float* xr = r >= ML ? xc + (size_t)(r - ML) * DM : xl + (size_t)r * DM;
#pragma unroll
                for (int j = 0; j < 4; ++j) v[u][j] = *(const f32x4*)(xr + 512 * (j >> 1) + 8 * lane + 4 * (j & 1));
                if (layer > 0 && r >= ML) {
#pragma unroll
                    for (int q = 0; q < 8; ++q) { const float* sl = ctx_slab(p->ws, q, r - ML);
#pragma unroll
                        for (int j = 0; j < 4; ++j) v[u][j] += *(const f32x4*)(sl + 512 * (j >> 1) + 8 * lane + 4 * (j & 1)); }
                }
            } else {
#pragma unroll
                for (int j = 0; j < 4; ++j) v[u][j] = (f32x4){0.f, 0.f, 0.f, 0.f};
            }
        }
        if (onepass) {
#pragma unroll
            for (int k = 0; k < 12; ++k) mlds[tid + k * 512] = t[k];
            __syncthreads();
        }
#pragma unroll
        for (int u = 0; u < RU; ++u) {
            float su = 0.f;
#pragma unroll
            for (int j = 0; j < 4; ++j) su += v[u][j].x * v[u][j].x + v[u][j].y * v[u][j].y + v[u][j].z * v[u][j].z + v[u][j].w * v[u][j].w;
            su = wave_sum(su);
            const int r = r0 + u * NW;
            if (r < MT) {
                const RowInfo ri = row_info(r);
                const LAS float* mod = mlds + (ri.isctx ? 2 : ri.b) * 2048;
                const float rs = rsqrtf(su * (1.f / DM) + EPS);
#pragma unroll
                for (int jj = 0; jj < 2; ++jj) {
                    u32x4 o;
#pragma unroll
                    for (int h2 = 0; h2 < 2; ++h2) {
                        const int j = 2 * jj + h2, c0 = 512 * jj + 8 * lane + 4 * h2;
                        const f32x4 sh = *(const LAS f32x4*)(mod + c0), sc = *(const LAS f32x4*)(mod + 1024 + c0);
                        o[2 * h2] = cvtpk(v[u][j].x * rs * (1.f + sc.x) + sh.x, v[u][j].y * rs * (1.f + sc.y) + sh.y); o[2 * h2 + 1] = cvtpk(v[u][j].z * rs * (1.f + sc.z) + sh.z, v[u][j].w * rs * (1.f + sc.w) + sh.w);
                    }
                    st16<true>(H + (size_t)r * DM + 512 * jj + 8 * lane, o);
                }
            }
        }
    }
}

namespace pg8 {
#define PG8_LAS __attribute__((address_space(3)))
constexpr int BM = 256, BK = 64, HALF = 128, HTB = HALF * BK * 2, STAGE_BYTES = 8 * HTB, NXCD = 8, WGM = 8;
__host__ __device__ __forceinline__ int lds_byte(int r, int c) { const int st = (r >> 4) * 2 + (c >> 5), rr = r & 15, cc = c & 31, ob = rr * 64 + cc * 2; return st * 1024 + (ob ^ (((ob >> 9) & 1) << 5)); }
__host__ __device__ __forceinline__ void stage_rc(int b, int& R, int& C) { const int st = b / 1024, sb = b % 1024, swz = sb ^ (((sb >> 9) & 1) << 5); R = (st >> 1) * 16 + swz / 64; C = (st & 1) * 32 + (swz % 64) / 2; }
__host__ __device__ __forceinline__ int perm32(int rho) { const int n = rho >> 4, i = rho & 15; return 8 * (i >> 2) + 4 * n + (i & 3); }
struct Unit { int pm, pn; size_t kofs; };
struct Gemm { const bf16_t* A; const bf16_t* Bt; int M, N, K, lda, ldb; };
struct StaticOrder {
    int nM, nN, nwg, G, c;
    __host__ __device__ void init(int M, int N, int G_, int c_) { nM = M / BM; nN = N / BM; nwg = nM * nN; G = G_; c = c_; }
    __host__ __device__ bool next(int i, Unit& u) const {
        const long L = (long)i * G + c; if (L >= nwg) return false;
        int wgid = (int)L; { const int q = nwg / NXCD, r = nwg % NXCD, xcd = wgid % NXCD, off = wgid / NXCD; wgid = (xcd < r ? xcd * (q + 1) : r * (q + 1) + (xcd - r) * q) + off; }
        const int nig = WGM * nN, gid = wgid / nig, fm = gid * WGM, gsz = (nM - fm) < WGM ? (nM - fm) : WGM;
        u.pm = fm + ((wgid % nig) % gsz); u.pn = (wgid % nig) / gsz; u.kofs = 0; return true;
    }
    __device__ __forceinline__ void a_ready(const Unit&) const {}
    __device__ __forceinline__ void done(const Unit&) const {}
};
__device__ __forceinline__ unsigned cvt_pk_bf16(float lo, float hi) { unsigned r; asm volatile("v_cvt_pk_bf16_f32 %0, %1, %2" : "=v"(r) : "v"(lo), "v"(hi)); return r; }
struct EpiProj {
    static constexpr bool PERM = true, AFTER_DRAIN = false;
    bf16_t* O; bf16_t* H2;
    template <bool WT> __device__ __forceinline__ void run(const f32x4 (&acc)[2][2][4][2], const Unit& u, int wr, int wc, int fr, int fq) const {
        const int row0 = u.pm * BM + wr * 64 + fr, col0 = u.pn * BM + wc * 32 + 8 * fq;
#pragma unroll
        for (int ai = 0; ai < 2; ++ai)
#pragma unroll
            for (int m = 0; m < 4; ++m) { bf16_t* rowp = O + (size_t)(row0 + ai * HALF + m * 16) * PITCH + col0;
#pragma unroll
                for (int bj = 0; bj < 2; ++bj) { const f32x4 v0 = acc[ai][bj][m][0], v1 = acc[ai][bj][m][1];
                    u32x4 w; w.x = cvt_pk_bf16(v0[0], v0[1]); w.y = cvt_pk_bf16(v0[2], v0[3]); w.z = cvt_pk_bf16(v1[0], v1[1]); w.w = cvt_pk_bf16(v1[2], v1[3]);
                    if (col0 + bj * HALF + 8 <= PITCH) st16<WT>(rowp + bj * HALF, w);
                    const int rin = wr * 64 + fr + ai * HALF + m * 16;
                    if (u.pn >= 14 && u.pn < 20 && (rin == 0 || rin == BM - 1)) *(u32x4*)(H2 + (size_t)(u.pm * 2 + (rin ? 1 : 0)) * 1536 + (col0 + bj * HALF - C_XBC)) = w; } }
    }
};
struct EpiResid {
    static constexpr bool PERM = false, AFTER_DRAIN = false;
    const float* xlat; float* olat; const float* xctx; float* octx; const float* mod;
    template <bool WT> __device__ __forceinline__ void run(const f32x4 (&acc)[2][2][4][2], const Unit& u, int wr, int wc, int fr, int fq) const {
        const bool isctx = u.pm >= 64;
        const float* xb = isctx ? xctx : xlat; float* ob = isctx ? octx : olat;
        const int prow = (isctx ? u.pm - 64 : u.pm) * BM + wr * 64 + fr;
        const float* gv = mod + (isctx ? 2 : (u.pm >> 5)) * 3072 + 2048;
        const int col0 = u.pn * BM + wc * 32 + 4 * fq;
#pragma unroll
        for (int bj = 0; bj < 2; ++bj)
#pragma unroll
            for (int n = 0; n < 2; ++n) { const int col = col0 + bj * HALF + n * 16; const f32x4 g = *(const f32x4*)(gv + col);
#pragma unroll
                for (int ai = 0; ai < 2; ++ai)
#pragma unroll
                    for (int m = 0; m < 4; ++m) { const size_t off = (size_t)(prow + ai * HALF + m * 16) * DM + col;
                        const f32x4 xin = *(const f32x4*)(xb + off); st16<WT>(ob + off, __builtin_bit_cast(u32x4, xin + g * acc[ai][bj][m][n])); } }
    }
};
struct CtxSplitOrder {
    int c;
    __device__ bool next(int i, Unit& u) const { if (i > 0 || c >= 64) return false; const int t = c >> 3; u.pm = 64 + (t >> 2); u.pn = t & 3; u.kofs = (size_t)(c & 7) * 256 * 2; return true; }
    __device__ __forceinline__ void a_ready(const Unit&) const {}
    __device__ __forceinline__ void done(const Unit&) const {}
};
struct EpiCtxSlab {
    static constexpr bool PERM = false, AFTER_DRAIN = false;
    unsigned char* ws; const float* mod;
    template <bool WT> __device__ __forceinline__ void run(const f32x4 (&acc)[2][2][4][2], const Unit& u, int wr, int wc, int fr, int fq) const {
        const int prow = (u.pm - 64) * BM + wr * 64 + fr, kq = (int)(u.kofs >> 9);
        const float* gv = mod + 2 * 3072 + 2048;
        const int col0 = u.pn * BM + wc * 32 + 4 * fq;
#pragma unroll
        for (int bj = 0; bj < 2; ++bj)
#pragma unroll
            for (int n = 0; n < 2; ++n) { const int col = col0 + bj * HALF + n * 16; const f32x4 g = *(const f32x4*)(gv + col);
#pragma unroll
                for (int ai = 0; ai < 2; ++ai)
#pragma unroll
                    for (int m = 0; m < 4; ++m) st16<WT>(ctx_slab(ws, kq, prow + ai * HALF + m * 16) + col, __builtin_bit_cast(u32x4, g * acc[ai][bj][m][n])); }
    }
};
template <class Epi, class Sched, bool ALIGN_EPI = false, bool SP2 = false>
__device__ __forceinline__ void gemm_phase(PG8_LAS unsigned char* lds, const Gemm g, const Sched& S, const Epi& E) {
    const int tid = tid_opaque(), wid = __builtin_amdgcn_readfirstlane(tid >> 6), lane = tid & 63, wr = wid >> 2, wc = wid & 3, fr = lane & 15, fq = lane >> 4;
    const int K = g.K, lda = g.lda, ldb = g.ldb, nt = K / BK;
    unsigned voffA[2], voffB[2];
#pragma unroll
    for (int i = 0; i < 2; ++i) { int R, C; stage_rc(tid * 16 + i * 8192, R, C); const int Rb = Epi::PERM ? ((R & ~31) + perm32(R & 31)) : R;
        voffA[i] = (unsigned)(R * lda + C) * 2u; voffB[i] = (unsigned)(Rb * ldb + C) * 2u; }
    const size_t kstep = (size_t)(BK * 2);
    const size_t hstepA = (size_t)HALF * lda * 2, hstepB = (size_t)HALF * ldb * 2;
    const size_t tstepA = 2 * hstepA, tstepB = 2 * hstepB;
    const unsigned ldsw = (unsigned)wid * 1024u;
    const int aoff = lds_byte(wr * 64 + fr, fq * 8), boff = lds_byte(wc * 32 + fr, fq * 8);
#define PG8_SA(b, h) (((b) * 2 + (h)) * HTB)
#define PG8_SB(b, h) ((4 + (b) * 2 + (h)) * HTB)
#define PG8_STAGE(bufoff, gbase, voff) do { _Pragma("unroll") for (int _i = 0; _i < 2; ++_i) \
        __builtin_amdgcn_global_load_lds((const unsigned*)((const char*)(gbase) + (voff)[_i]), (PG8_LAS unsigned*)(lds + (bufoff) + ldsw + _i * 8192), 16, 0, 0); } while (0)
#define PG8_LDA(dst, b, h) do { _Pragma("unroll") for (int m = 0; m < 4; ++m) _Pragma("unroll") for (int k = 0; k < 2; ++k) dst[m][k] = *(const PG8_LAS bf16x8*)(lds + PG8_SA(b, h) + aoff + m * 2048 + k * 1024); } while (0)
#define PG8_LDB(dst, b, h) do { _Pragma("unroll") for (int n = 0; n < 2; ++n) _Pragma("unroll") for (int k = 0; k < 2; ++k) dst[n][k] = *(const PG8_LAS bf16x8*)(lds + PG8_SB(b, h) + boff + n * 2048 + k * 1024); } while (0)
#define PG8_MMA(ai, bj, At, Bt) do { __builtin_amdgcn_s_setprio(1); _Pragma("unroll") for (int m = 0; m < 4; ++m) _Pragma("unroll") for (int n = 0; n < 2; ++n) _Pragma("unroll") for (int k = 0; k < 2; ++k) \
        acc[ai][bj][m][n] = __builtin_amdgcn_mfma_f32_16x16x32_bf16(Bt[n][k], At[m][k], acc[ai][bj][m][n], 0, 0, 0); __builtin_amdgcn_s_setprio(0); } while (0)
#define PG8_WAIT_V(n) asm volatile("s_waitcnt vmcnt(" #n ")" ::: "memory")
#define PG8_WAIT_L(n) asm volatile("s_waitcnt lgkmcnt(" #n ")" ::: "memory")
#define PG8_BAR __builtin_amdgcn_s_barrier()
#define PG8_SCHED __builtin_amdgcn_sched_barrier(0)
    Unit cur, nxt; int ui = 0;
    if (!S.next(0, cur)) return;
    f32x4 acc[2][2][4][2];
#pragma unroll
    for (int a = 0; a < 2; ++a)
#pragma unroll
        for (int b = 0; b < 2; ++b)
#pragma unroll
            for (int m = 0; m < 4; ++m)
#pragma unroll
                for (int n = 0; n < 2; ++n) acc[a][b][m][n] = (f32x4){0.f, 0.f, 0.f, 0.f};
    bf16x8 At[4][2], B0[2][2], B1[2][2];
    const char* cA = (const char*)g.A + (size_t)cur.pm * tstepA + cur.kofs; const char* cB = (const char*)g.Bt + (size_t)cur.pn * tstepB + cur.kofs;
    S.a_ready(cur);
    if constexpr (SP2) {
        PG8_STAGE(PG8_SB(0, 0), cB, voffB); PG8_STAGE(PG8_SB(0, 1), cB + hstepB, voffB); PG8_STAGE(PG8_SA(0, 0), cA, voffA); PG8_STAGE(PG8_SA(0, 1), cA + hstepA, voffA);
        if (wr == 1) PG8_BAR;
        PG8_WAIT_V(2); PG8_BAR;
        PG8_STAGE(PG8_SB(1, 0), cB + kstep, voffB); PG8_STAGE(PG8_SA(1, 0), cA + kstep, voffA); PG8_STAGE(PG8_SB(1, 1), cB + hstepB + kstep, voffB);
        PG8_WAIT_V(6); PG8_BAR;
    } else {
        PG8_STAGE(PG8_SB(0, 0), cB, voffB); PG8_STAGE(PG8_SA(0, 0), cA, voffA); PG8_STAGE(PG8_SB(0, 1), cB + hstepB, voffB); PG8_STAGE(PG8_SA(0, 1), cA + hstepA, voffA);
        if (wr == 1) PG8_BAR;
        PG8_WAIT_V(4); PG8_BAR;
        PG8_STAGE(PG8_SB(1, 0), cB + kstep, voffB); PG8_STAGE(PG8_SA(1, 0), cA + kstep, voffA); PG8_STAGE(PG8_SB(1, 1), cB + hstepB + kstep, voffB);
        PG8_WAIT_V(6); PG8_BAR;
    }
    for (;;) {
        const bool has_next = S.next(ui + 1, nxt);
        const char* nA = has_next ? (const char*)g.A + (size_t)nxt.pm * tstepA + nxt.kofs : cA; const char* nB = has_next ? (const char*)g.Bt + (size_t)nxt.pn * tstepB + nxt.kofs : cB;
        for (int t = 0; t < nt; t += 2) {
            const bool last = (t == nt - 2);
            const char* a1 = cA + (size_t)(t + 1) * kstep;
            const char* a2 = last ? nA : cA + (size_t)(t + 2) * kstep; const char* b2 = last ? nB : cB + (size_t)(t + 2) * kstep;
            const char* a3 = a2 + kstep; const char* b3 = b2 + kstep;
            if (last && has_next) S.a_ready(nxt);
            if constexpr (SP2) {
            PG8_LDB(B0, 0, 0); PG8_LDB(B1, 0, 1); PG8_SCHED; PG8_LDA(At, 0, 0); PG8_STAGE(PG8_SA(1, 1), a1 + hstepA, voffA);
            PG8_WAIT_V(8); PG8_WAIT_L(0); PG8_BAR; PG8_MMA(0, 0, At, B0); PG8_MMA(0, 1, At, B1); PG8_BAR; PG8_SCHED;
            PG8_LDA(At, 0, 1); PG8_STAGE(PG8_SB(0, 0), b2, voffB); PG8_STAGE(PG8_SB(0, 1), b2 + hstepB, voffB); PG8_STAGE(PG8_SA(0, 0), a2, voffA);
            PG8_WAIT_V(8); PG8_WAIT_L(0); PG8_BAR; PG8_MMA(1, 0, At, B0); PG8_MMA(1, 1, At, B1); PG8_BAR; PG8_SCHED;
            PG8_LDB(B0, 1, 0); PG8_LDB(B1, 1, 1); PG8_SCHED; PG8_LDA(At, 1, 0); PG8_STAGE(PG8_SA(0, 1), a2 + hstepA, voffA);
            PG8_WAIT_V(8); PG8_WAIT_L(0); PG8_BAR; PG8_MMA(0, 0, At, B0); PG8_MMA(0, 1, At, B1); PG8_BAR; PG8_SCHED;
            PG8_LDA(At, 1, 1); PG8_STAGE(PG8_SB(1, 0), b3, voffB); PG8_STAGE(PG8_SB(1, 1), b3 + hstepB, voffB); PG8_STAGE(PG8_SA(1, 0), a3, voffA);
            PG8_WAIT_V(8); PG8_WAIT_L(0); PG8_BAR; PG8_MMA(1, 0, At, B0); PG8_MMA(1, 1, At, B1); PG8_BAR; PG8_SCHED;
            } else {
            PG8_LDB(B0, 0, 0); PG8_SCHED; PG8_LDA(At, 0, 0); PG8_STAGE(PG8_SA(1, 1), a1 + hstepA, voffA);
            PG8_WAIT_L(8); PG8_BAR; PG8_WAIT_L(0); PG8_MMA(0, 0, At, B0); PG8_BAR; PG8_SCHED;
            PG8_LDB(B1, 0, 1); PG8_STAGE(PG8_SB(0, 0), b2, voffB);
            PG8_BAR; PG8_WAIT_L(0); PG8_MMA(0, 1, At, B1); PG8_BAR;
            PG8_LDA(At, 0, 1); PG8_STAGE(PG8_SA(0, 0), a2, voffA);
            PG8_BAR; PG8_WAIT_L(0); PG8_MMA(1, 0, At, B0); PG8_BAR; PG8_SCHED;
            PG8_STAGE(PG8_SB(0, 1), b2 + hstepB, voffB);
            PG8_WAIT_V(6); PG8_BAR; PG8_MMA(1, 1, At, B1); PG8_BAR;
            PG8_LDB(B0, 1, 0); PG8_SCHED; PG8_LDA(At, 1, 0); PG8_STAGE(PG8_SA(0, 1), a2 + hstepA, voffA);
            PG8_WAIT_L(8); PG8_BAR; PG8_WAIT_L(0); PG8_MMA(0, 0, At, B0); PG8_BAR; PG8_SCHED;
            PG8_LDB(B1, 1, 1); PG8_STAGE(PG8_SB(1, 0), b3, voffB);
            PG8_BAR; PG8_WAIT_L(0); PG8_MMA(0, 1, At, B1); PG8_BAR;
            PG8_LDA(At, 1, 1); PG8_STAGE(PG8_SA(1, 0), a3, voffA);
            PG8_BAR; PG8_WAIT_L(0); PG8_MMA(1, 0, At, B0); PG8_BAR; PG8_SCHED;
            PG8_STAGE(PG8_SB(1, 1), b3 + hstepB, voffB);
            PG8_WAIT_V(6); PG8_BAR; PG8_MMA(1, 1, At, B1); PG8_BAR;
            }
        }
        if constexpr (ALIGN_EPI) { if (wr == 0) PG8_BAR; }
        if constexpr (!Epi::AFTER_DRAIN) { if (has_next) E.template run<false>(acc, cur, wr, wc, fr, fq); else E.template run<true>(acc, cur, wr, wc, fr, fq); S.done(cur); }
        if (!has_next) break;
#pragma unroll
        for (int a = 0; a < 2; ++a)
#pragma unroll
            for (int b = 0; b < 2; ++b)
#pragma unroll
                for (int m = 0; m < 4; ++m)
#pragma unroll
                    for (int n = 0; n < 2; ++n) acc[a][b][m][n] = (f32x4){0.f, 0.f, 0.f, 0.f};
        cur = nxt; cA = nA; cB = nB; ++ui;
        if constexpr (ALIGN_EPI) { if (wr == 1) PG8_BAR; }
    }
    PG8_WAIT_V(0);
    if constexpr (!ALIGN_EPI) { if (wr == 0) PG8_BAR; }
    PG8_BAR;
    if constexpr (Epi::AFTER_DRAIN) { E.fused(acc, cur, wr, wc, fr, fq, lds, wid, lane); S.done(cur); }
#undef PG8_SA
#undef PG8_SB
#undef PG8_STAGE
#undef PG8_LDA
#undef PG8_LDB
#undef PG8_MMA
#undef PG8_WAIT_V
#undef PG8_WAIT_L
#undef PG8_BAR
#undef PG8_SCHED
}
}

__device__ __forceinline__ int crow(int r, int hi) { return (r & 3) + 8 * (r >> 2) + 4 * hi; }
__device__ __forceinline__ void glds16(const void* gsrc, unsigned lds_dst) { unsigned keep;
    asm volatile("s_mov_b32 %0, m0\n\ts_mov_b32 m0, %2\n\ts_nop 0\n\tglobal_load_lds_dwordx4 %1, off\n\ts_mov_b32 m0, %0" : "=&s"(keep) : "v"(gsrc), "s"(lds_dst) : "memory"); }
typedef short v4i16_t __attribute__((ext_vector_type(4)));
__device__ __forceinline__ s16x4 vtr(const LAS char* p) { return __builtin_bit_cast(s16x4, __builtin_amdgcn_ds_read_tr16_b64_v4i16((LAS v4i16_t*)p)); }
__device__ __forceinline__ int tr_laneoff(int lane) { return ((lane >> 4) & 1) * 32 + (lane & 3) * 8 + (4 * (lane >> 5) + ((lane & 15) >> 2)) * 64; }
__device__ __forceinline__ bf16x8 tr_frag(const LAS char* p) { const s16x4 lo = vtr(p), hh = vtr(p + 512); return (bf16x8){lo[0], lo[1], lo[2], lo[3], hh[0], hh[1], hh[2], hh[3]}; }
#define SBAR() __builtin_amdgcn_sched_barrier(0)
#define WAIT_BAR(N) asm volatile("s_waitcnt vmcnt(" #N ") lgkmcnt(0)\n\ts_barrier" ::: "memory")
constexpr int AT_SLOT = 32768, AT_NSLOT = 4, AT_WSF = AT_SLOT * AT_NSLOT, AT_XS = 132;

__device__ __forceinline__ void attn_unit(KP p, int layer, LAS char* lds, int b, int h, int q0, int isctx) {
    const int tid = tid_opaque(), lane = tid & 63, r32 = lane & 31, hi = lane >> 5;
    const int wave = __builtin_amdgcn_readfirstlane(tid >> 6), qg = wave & 3, map = wave >> 2;
    const float* ctl = (const float*)(p->ws + WS_CTL);
    const float mb = ctl[CF_MB + layer];
    bf16_t* P = (bf16_t*)(p->ws + WS_PROJ);
    const unsigned lds0 = (unsigned)(uintptr_t)lds;
    const int NT = isctx ? CTXL / 64 : (SEQ + CTXL) / 64;
    const int rowq0 = seq_row0(b, isctx) + q0 + qg * 32;
#define AT_KROW0(t) (isctx ? (ML + b * CTXL + (t) * 64) : ((t) < SEQ / 64 ? (b * SEQ + (t) * 64) : (ML + b * CTXL + ((t) - SEQ / 64) * 64)))
    const int krow_ = 8 * wave + (lane >> 3);
    const bf16_t* klane = P + (size_t)krow_ * PITCH + C_AK + h * 128 + (((lane & 7) ^ ((krow_ >> 1) & 7)) * 8);
    const bf16_t* vlane = P + (size_t)(16 * (wave & 3) + (lane >> 2)) * PITCH + C_AV + h * 128 + (lane & 3) * 8 + (wave >> 2) * 32;
#define AT_DMA_K(t) do { const unsigned sl_ = lds0 + (unsigned)(((t) & 3) * 16384); const bf16_t* kb_ = klane + (size_t)AT_KROW0(t) * PITCH; \
        glds16(kb_, (unsigned)__builtin_amdgcn_readfirstlane(sl_ + wave * 1024)); \
        glds16(kb_ + 64, (unsigned)__builtin_amdgcn_readfirstlane(sl_ + 8192 + wave * 1024)); } while (0)
#define AT_DMA_V(t) do { const unsigned sl_ = lds0 + 65536u + (unsigned)(((t) & 3) * 16384); const bf16_t* vb_ = vlane + (size_t)AT_KROW0(t) * PITCH; \
        glds16(vb_, (unsigned)__builtin_amdgcn_readfirstlane(sl_ + (wave >> 2) * 4096 + (wave & 3) * 1024)); \
        glds16(vb_ + 64, (unsigned)__builtin_amdgcn_readfirstlane(sl_ + ((wave >> 2) + 2) * 4096 + (wave & 3) * 1024)); } while (0)
    AT_DMA_K(0); AT_DMA_K(1); AT_DMA_V(0); AT_DMA_K(2); AT_DMA_V(1);
    bf16x8 qr[4];
    {
        const bf16_t* qp = P + (size_t)(rowq0 + r32) * PITCH + C_AQ + h * 128 + map * 64 + hi * 8;
#pragma unroll
        for (int ks = 0; ks < 4; ++ks) qr[ks] = *(const bf16x8*)(qp + ks * 16);
    }
    asm volatile("" : "+v"(qr[0]), "+v"(qr[1]), "+v"(qr[2]), "+v"(qr[3]));
    auto epilogue = [&](float l, f32x16 (&o)[4]) {
        const int tid = tid_opaque(), lane = tid & 63, r32 = lane & 31, hi = lane >> 5;
        const int wave = __builtin_amdgcn_readfirstlane(tid >> 6), qg = wave & 3, map = wave >> 2;
        const float lam = ((const float*)(p->ws + WS_CTL))[CF_LAM + layer];
        const int rowq0 = seq_row0(b, isctx) + q0 + qg * 32;
        bf16_t* P = (bf16_t*)(p->ws + WS_PROJ);
        LAS float* wsf = (LAS float*)(lds + AT_WSF) + wave * 32;

    if (hi == 0) wsf[r32] = l;
    asm volatile("s_waitcnt lgkmcnt(0)" ::: "memory");
    LAS float* X = (LAS float*)lds + qg * (32 * AT_XS);
    const float fm = map ? lam : 1.f;
    if (map == 1) {
#pragma unroll
        for (int r = 0; r < 16; ++r) { const int row = crow(r, hi); const float f = fm * __builtin_amdgcn_rcpf(wsf[row]);
#pragma unroll
            for (int d0 = 0; d0 < 4; ++d0) X[row * AT_XS + d0 * 32 + r32] = o[d0][r] * f; }
    }
    WAIT_BAR(0);
    if (map == 0) {
        u32x4 gw_[8]; f32x4 sb_[16];
        { const int row_ = lane >> 1, half_ = lane & 1;
          const bf16_t* gp_ = P + (size_t)(rowq0 + row_) * PITCH + C_AG + h * 128 + half_ * 64;
          const float* sub_ = p->in[14] + layer * 128 + half_ * 64;
#pragma unroll
          for (int k = 0; k < 8; ++k) gw_[k] = *(const u32x4*)(gp_ + 8 * k);
#pragma unroll
          for (int k = 0; k < 16; ++k) sb_[k] = *(const f32x4*)(sub_ + 4 * k); }
#pragma unroll
        for (int r = 0; r < 16; ++r) { const int row = crow(r, hi); const float f = fm * __builtin_amdgcn_rcpf(wsf[row]);
#pragma unroll
            for (int d0 = 0; d0 < 4; ++d0) { const int xi = row * AT_XS + d0 * 32 + r32; X[xi] = o[d0][r] * f - X[xi]; } }
        asm volatile("s_waitcnt lgkmcnt(0)" ::: "memory");
        const int row = lane >> 1, half = lane & 1;
        float xv[64]; float ss = 0.f;
#pragma unroll
        for (int i = 0; i < 64; i += 4) { const f32x4 v = *(const LAS f32x4*)(X + row * AT_XS + half * 64 + i); xv[i] = v[0]; xv[i + 1] = v[1]; xv[i + 2] = v[2]; xv[i + 3] = v[3];
            ss += v[0] * v[0] + v[1] * v[1] + v[2] * v[2] + v[3] * v[3]; }
        ss += __shfl_xor(ss, 1);
        const float rs = rsqrtf(ss * (1.f / 128.f) + EPS) * (1.f - lam_init_of(layer));
        const float* sub = p->in[14] + layer * 128 + half * 64;
        bf16_t* gp = P + (size_t)(rowq0 + row) * PITCH + C_AG + h * 128 + half * 64;
        bf16_t* op = P + (size_t)(rowq0 + row) * PITCH + C_AQ + h * 128 + half * 64;
#pragma unroll
        for (int i = 0; i < 64; i += 8) {
            float g[8]; unpack8(gw_[i >> 3], g);
            float w[8];
#pragma unroll
            for (int j = 0; j < 8; ++j) w[j] = xv[i + j] * rs * sb_[(i + j) >> 2][(i + j) & 3] * siluf(g[j]);
            *(u32x4*)(op + i) = pack8(w);
        }
    }
    };
    f32x16 o[4];
#pragma unroll
    for (int d = 0; d < 4; ++d)
#pragma unroll
        for (int r = 0; r < 16; ++r) o[d][r] = 0.f;
    float nmb = -mb; asm volatile("" : "+v"(nmb));
    f32x16 negm;
#pragma unroll
    for (int r = 0; r < 16; ++r) negm[r] = nmb;
    asm volatile("" : "+v"(negm));
    float l = 0.f, lkeep = 1.f;
    const int ksw = (r32 >> 1) & 7;
    const int koff = map * 8192 + r32 * 128;
    int kso[4];
#pragma unroll
    for (int ks = 0; ks < 4; ++ks) kso[ks] = koff + (((2 * ks + hi) ^ ksw) * 16);
    const int voff = 65536 + ((lane >> 4) & 1) * 32 + (lane & 3) * 8 + (4 * hi + ((lane & 15) >> 2)) * 64;
    u32x4 pwx[2], pwy[2];
#define AT_QKH(t, half, S) do { const LAS char* kp_ = lds + ((t) & 3) * 16384 + (half) * 4096; _Pragma("unroll") for (int r = 0; r < 16; ++r) S[r] = nmb; \
        _Pragma("unroll") for (int ks = 0; ks < 4; ++ks) S = __builtin_amdgcn_mfma_f32_32x32x16_bf16(*(const LAS bf16x8*)(kp_ + kso[ks]), qr[ks], S, 0, 0, 0); } while (0)
#define AT_EXH(e, S, PWX) do { \
        _Pragma("unroll") for (int r = 8 * (e); r < 8 * (e) + 8; ++r) S[r] = __builtin_amdgcn_exp2f(S[r]); \
        l += lkeep * (((S[8 * (e)] + S[8 * (e) + 1]) + (S[8 * (e) + 2] + S[8 * (e) + 3])) + ((S[8 * (e) + 4] + S[8 * (e) + 5]) + (S[8 * (e) + 6] + S[8 * (e) + 7]))); \
        _Pragma("unroll") for (int j = 0; j < 4; ++j) PWX[j] = cvtpk(S[8 * (e) + 2 * j], S[8 * (e) + 2 * j + 1]); } while (0)
#define AT_LDK(i, KA, hfk) asm volatile("ds_read_b128 %0, %1 offset:%c2" : "=v"(fk[i]) : "v"(KA[i]), "i"((hfk) * 4096) : "memory")
#define AT_LDV(F, VA, ks, d) do { asm volatile("ds_read_b64_tr_b16 %0, %1 offset:%c2" : "=v"(F[0]) : "v"(VA), "i"((ks) * 1024 + (d) * 4096) : "memory"); \
                                  asm volatile("ds_read_b64_tr_b16 %0, %1 offset:%c2" : "=v"(F[1]) : "v"(VA), "i"((ks) * 1024 + (d) * 4096 + 512) : "memory"); } while (0)
#define AT_LGK(n) asm volatile("s_waitcnt lgkmcnt(%0)" :: "n"(n) : "memory")
#define AT_VF2(F) (bf16x8){F[0][0], F[0][1], F[0][2], F[0][3], F[1][0], F[1][1], F[1][2], F[1][3]}
#define AT_PV(F, d0, PWF) o[d0] = __builtin_amdgcn_mfma_f32_32x32x16_bf16(__builtin_bit_cast(bf16x8, PWF), AT_VF2(F), o[d0], 0, 0, 0)
#define AT_QKM(S, i) S = __builtin_amdgcn_mfma_f32_32x32x16_bf16(fk[i], qr[i], S, 0, 0, 0)
#define AT_QKM0(S) S = __builtin_amdgcn_mfma_f32_32x32x16_bf16(fk[0], qr[0], negm, 0, 0, 0)
#define AT_VBAR(N) asm volatile("s_waitcnt vmcnt(" #N ")\n\ts_barrier" ::: "memory")
#define AT_WAIT(s) do { const int rem_ = NT - (s); if (rem_ > 2) { AT_VBAR(4); } else if (rem_ == 2) { AT_VBAR(2); } else { AT_VBAR(0); } } while (0)
#define AT_E2(S, j) do { asm volatile("v_exp_f32 %0, %1" : "=v"(ex_[2 * (j)]) : "v"(S[2 * (j)])); asm volatile("v_exp_f32 %0, %1" : "=v"(ex_[2 * (j) + 1]) : "v"(S[2 * (j) + 1])); } while (0)
#define AT_CV(PW, j) do { unsigned c_; asm volatile("v_cvt_pk_bf16_f32 %0, %1, %2" : "=v"(c_) : "v"(ex_[2 * (j)]), "v"(ex_[2 * (j) + 1])); PW[(j) >> 2][(j) & 3] = c_; } while (0)
#define AT_AD(d, x, y) asm volatile("v_add_f32 %0, %1, %2" : "=v"(d) : "v"(x), "v"(y))
#define AT_HS(hf, SACC, SEXP, PWC, PWN, LK, KAN, VAN, hfn, PRE) do { \
        AT_LDV(fa[2], va_, 2 * (hf), 2);      AT_LGK(8);  SBAR(); AT_QKM0(SACC);          AT_E2(SEXP, 0); SBAR(); \
        AT_LDK(3, ka_, hf);                   AT_LGK(7);  SBAR(); AT_PV(fa[0], 0, PWC[0]); AT_E2(SEXP, 1); AT_CV(PWN, 0); SBAR(); \
        AT_LDV(fa[3], va_, 2 * (hf), 3);      AT_LGK(8);  SBAR(); AT_QKM(SACC, 1);         AT_E2(SEXP, 2); AT_CV(PWN, 1); SBAR(); \
        AT_LDV(fb[0], va_, 2 * (hf) + 1, 0);  AT_LGK(8);  SBAR(); AT_PV(fa[1], 1, PWC[0]); AT_E2(SEXP, 3); AT_CV(PWN, 2); SBAR(); \
        AT_LDV(fb[1], va_, 2 * (hf) + 1, 1);  AT_LGK(9);  SBAR(); AT_QKM(SACC, 2);         AT_E2(SEXP, 4); AT_CV(PWN, 3); SBAR(); \
        AT_LDV(fb[2], va_, 2 * (hf) + 1, 2);  AT_LGK(9);  SBAR(); AT_PV(fa[2], 2, PWC[0]); AT_E2(SEXP, 5); AT_CV(PWN, 4); SBAR(); \
        AT_LDV(fb[3], va_, 2 * (hf) + 1, 3);  AT_LGK(10); SBAR(); AT_QKM(SACC, 3);         AT_E2(SEXP, 6); AT_CV(PWN, 5); SBAR(); \
        PRE; SBAR(); \
        AT_LDK(0, KAN, hfn);                  AT_LGK(9);  SBAR(); AT_PV(fa[3], 3, PWC[0]); AT_E2(SEXP, 7); AT_CV(PWN, 6); SBAR(); \
        AT_LDV(fa[0], VAN, 2 * (hfn), 0);     AT_LGK(9);  SBAR(); AT_PV(fb[0], 0, PWC[1]); AT_CV(PWN, 7); AT_AD(a_[0], ex_[0], ex_[1]); AT_AD(a_[1], ex_[2], ex_[3]); AT_AD(a_[2], ex_[4], ex_[5]); SBAR(); \
        AT_LDK(1, KAN, hfn);                  AT_LGK(8);  SBAR(); AT_PV(fb[1], 1, PWC[1]); AT_AD(a_[3], ex_[6], ex_[7]); AT_AD(a_[4], ex_[8], ex_[9]); AT_AD(a_[5], ex_[10], ex_[11]); AT_AD(a_[6], ex_[12], ex_[13]); SBAR(); \
        AT_LDV(fa[1], VAN, 2 * (hfn), 1);     AT_LGK(8);  SBAR(); AT_PV(fb[2], 2, PWC[1]); AT_AD(a_[7], ex_[14], ex_[15]); AT_AD(a_[0], a_[0], a_[1]); AT_AD(a_[2], a_[2], a_[3]); AT_AD(a_[4], a_[4], a_[5]); SBAR(); \
        AT_LDK(2, KAN, hfn);                  AT_LGK(7);  SBAR(); AT_PV(fb[3], 3, PWC[1]); AT_AD(a_[6], a_[6], a_[7]); AT_AD(a_[0], a_[0], a_[2]); AT_AD(a_[4], a_[4], a_[6]); AT_AD(a_[0], a_[0], a_[4]); \
                                                                  asm volatile("v_fmac_f32 %0, %1, %2" : "+v"(l) : "v"(LK), "v"(a_[0])); SBAR(); } while (0)
#define AT_BASES(t, VA, KA) do { const int t1_ = (t) + 1 < NT ? (t) + 1 : NT - 1; \
        VA = lds0 + (unsigned)(((t) & 3) * 16384 + voff); _Pragma("unroll") for (int ks = 0; ks < 4; ++ks) KA[ks] = lds0 + (unsigned)((t1_ & 3) * 16384 + kso[ks]); } while (0)
#define AT_SEAM(s, VA, KA) do { if ((s) < NT) { AT_WAIT(s); if ((s) + 3 < NT) AT_DMA_K((s) + 3); if ((s) + 2 < NT) AT_DMA_V((s) + 2); } AT_BASES(s, VA, KA); } while (0)
#define AT_STEP(t) do { float a_[8], ex_[16]; lkeep = (t) + 1 < NT ? 1.f : 0.f; \
        AT_HS(0, sa_, sb_, pwx, pwy, one_, ka_, va_, 1, do {} while (0)); \
        AT_HS(1, sb_, sa_, pwy, pwx, lkeep, kan_, van_, 0, AT_SEAM((t) + 1, van_, kan_)); \
        va_ = van_; _Pragma("unroll") for (int ks = 0; ks < 4; ++ks) ka_[ks] = kan_[ks]; } while (0)
    f32x16 sa_, sb_; float one_ = 1.f; asm volatile("" : "+v"(one_));
    bf16x8 fk[4]; s16x4 fa[4][2], fb[4][2]; unsigned va_, ka_[4], van_, kan_[4];
    {
        asm volatile("s_waitcnt vmcnt(8)\n\ts_barrier" ::: "memory");
        AT_QKH(0, 0, sa_); AT_EXH(0, sa_, pwx[0]); AT_EXH(1, sa_, pwx[1]); AT_QKH(0, 1, sb_);
        SBAR(); AT_SEAM(0, va_, ka_); SBAR();
        AT_LDK(0, ka_, 0); AT_LDV(fa[0], va_, 0, 0); AT_LDK(1, ka_, 0); AT_LDV(fa[1], va_, 0, 1); AT_LDK(2, ka_, 0); SBAR();
    }
    for (int t = 0; t < NT; ++t) { AT_STEP(t); }
    asm volatile("s_waitcnt lgkmcnt(0)" ::: "memory");
    l += __shfl_xor(l, 32);
    WAIT_BAR(0);
    epilogue(l, o);
    WAIT_BAR(0);
#undef AT_DMA_K
#undef AT_DMA_V
#undef AT_KROW0
#undef AT_QK
#undef AT_EXP
#undef AT_PVX
#undef AT_TRR
#undef AT_VLD
#undef AT_VF
#undef AT_MM
#undef AT_QKH
#undef AT_LGK0
#undef AT_QKM
#undef AT_KLD
#undef AT_EXH
#undef AT_PVB
#undef AT_WAIT
#undef AT_STEP
#undef AT_MM1
#undef AT_KRD
#undef AT_E2
#undef AT_CV
#undef AT_HS
#undef AT_AD
#undef AT_BASES
#undef AT_SEAM
#undef AT_LDK
#undef AT_LDV
#undef AT_LGK
#undef AT_VF2
#undef AT_PV
#undef AT_QKM0
#undef AT_VBAR
}
__device__ __forceinline__ void phase_attn(KP p, int layer, LAS char* lds, int blk, int nblk) {
    const int nunits = 512 + ((layer == 0 && nblk < 200) ? 16 : 0);
    for (int u = blk; u < nunits; u += nblk) {
        if (u < 512) { const int bh = u & 7, qb = u >> 3; attn_unit(p, layer, lds, bh >> 2, bh & 3, qb * 128, 0); }
        else { const int j = u - 512; attn_unit(p, layer, lds, j >> 3, (j >> 1) & 3, (j & 1) * 128, 1); }
    }
}

__device__ __forceinline__ void phase_prep(KP p, int layer, float* ldsf, int blk, int nblk) {
    const int tid = tid_opaque(), lane = tid & 63, wave = tid >> 6, nw = blockDim.x >> 6;
    bf16_t* P = (bf16_t*)(p->ws + WS_PROJ);
    float* ctab = ldsf; float* stab = ldsf + 192 * 16;
    { const float* src = (const float*)(p->ws + WS_CTL) + CF_ROPE;
      for (int i = tid; i < 2 * 192 * 16; i += blockDim.x) ldsf[i] = src[i]; }
    __syncthreads();
    const int sub = lane & 7, a0 = (sub & 3) * 8;
    float gq[8], gk[8];
#pragma unroll
    for (int j = 0; j < 8; ++j) { gq[j] = p->in[8][layer * 64 + sub * 8 + j]; gk[j] = p->in[9][layer * 64 + sub * 8 + j]; }
    constexpr int RU = 6;
    const bool wsplit = nblk >= 200;
    const int per = (MT + (nblk - 148) - 1) / (nblk - 148 > 0 ? nblk - 148 : 1);
    const int rbase = !wsplit ? 0 : (blk < 148 ? 0 : (blk - 148) * per);
    const int nrows = !wsplit ? MT : (blk < 148 ? 0 : (rbase + per <= MT ? per : (MT > rbase ? MT - rbase : 0)));
    const int NW = wsplit ? nw : nblk * nw;
    for (int r0 = wsplit ? wave : blk * nw + wave; r0 < nrows; r0 += RU * NW) {
        u32x4 wq[RU], wk[RU];
#pragma unroll
        for (int u = 0; u < RU; ++u) { const int r = rbase + (r0 + u * NW < nrows ? r0 + u * NW : r0); const bf16_t* row = P + (size_t)r * PITCH;
            wq[u] = *(const u32x4*)(row + C_AQ + lane * 8); wk[u] = *(const u32x4*)(row + C_AK + lane * 8); }
#pragma unroll
        for (int u = 0; u < RU; ++u) {
            if (r0 + u * NW < nrows) {
                const int r = rbase + r0 + u * NW;
                const RowInfo ri = row_info(r);
                float cs[8], sn[8];
                if (!ri.isctx) {
                    const int base = (a0 < 16) ? (ri.t >> 6) * 16 + a0 : (128 + (ri.t & 63)) * 16 + (a0 - 16);
#pragma unroll
                    for (int j = 0; j < 8; ++j) { cs[j] = ctab[base + j]; sn[j] = stab[base + j]; }
                } else {
#pragma unroll
                    for (int j = 0; j < 8; ++j) { cs[j] = 1.f; sn[j] = 0.f; }
                }
                bf16_t* row = P + (size_t)r * PITCH;
                float x[8], y[8];
                unpack8(wq[u], x);
                { float ss = 0.f;
#pragma unroll
                  for (int j = 0; j < 8; ++j) ss += x[j] * x[j];
                  ss += __shfl_xor(ss, 1); ss += __shfl_xor(ss, 2); ss += __shfl_xor(ss, 4);
                  const float rs = rsqrtf(ss * (1.f / 64.f) + EPS);
#pragma unroll
                  for (int j = 0; j < 8; ++j) x[j] *= rs * gq[j];
#pragma unroll
                  for (int j = 0; j < 8; ++j) { const float o = __shfl_xor(x[j], 4); y[j] = ((sub < 4) ? (x[j] * cs[j] - o * sn[j]) : (o * sn[j] + x[j] * cs[j])) * (0.125f * LOG2E); }
                  *(u32x4*)(row + C_AQ + lane * 8) = pack8(y); }
                unpack8(wk[u], x);
                { float ss = 0.f;
#pragma unroll
                  for (int j = 0; j < 8; ++j) ss += x[j] * x[j];
                  ss += __shfl_xor(ss, 1); ss += __shfl_xor(ss, 2); ss += __shfl_xor(ss, 4);
                  const float rs = rsqrtf(ss * (1.f / 64.f) + EPS);
#pragma unroll
                  for (int j = 0; j < 8; ++j) x[j] *= rs * gk[j];
#pragma unroll
                  for (int j = 0; j < 8; ++j) { const float o = __shfl_xor(x[j], 4); y[j] = (sub < 4) ? (x[j] * cs[j] - o * sn[j]) : (o * sn[j] + x[j] * cs[j]); }
                  *(u32x4*)(row + C_AK + lane * 8) = pack8(y); }
            }
        }
    }
    __syncthreads();
}

constexpr int C_U = C_XBC;
constexpr int CF_TOT = 32768;
constexpr size_t WS_ST = WS_H;
static_assert((size_t)66 * 2 * 20 * 8192 * 2 <= H_BYTES + WINT_BYTES, "states overlay");
__device__ __forceinline__ size_t st_off(int blk, int dir, int head) { return (size_t)((blk * 2 + dir) * 20 + head) * 8192; }
struct BlkInfo { int b, isctx, row0, t0, L, seqrow0; };
__device__ __forceinline__ BlkInfo blk_info(int blk) {
    BlkInfo i; i.b = blk / 33; const int k = blk % 33; i.isctx = (k == 0);
    if (i.isctx) { i.seqrow0 = ML + i.b * CTXL; i.t0 = 0; i.L = CTXL; } else { i.seqrow0 = i.b * SEQ; i.t0 = (k - 1) * 256; i.L = SEQ; }
    i.row0 = i.seqrow0 + i.t0; return i;
}
template <int NTOK, int CH = 8, class F>
__device__ __forceinline__ void conv_strip(const bf16_t* P, const BlkInfo& bi, int tb, int ch0, const float* cw, const float* cb, F&& emit) {
    float w0[CH], w1[CH], w2[CH], bb[CH];
#pragma unroll
    for (int j = 0; j < CH; ++j) { w0[j] = cw[ch0 + j]; w1[j] = cw[1536 + ch0 + j]; w2[j] = cw[3072 + ch0 + j]; bb[j] = cb[ch0 + j]; }
    float xm[CH], x0[CH], xp[CH];
    const bf16_t* base = P + (size_t)bi.seqrow0 * PITCH + C_XBC + ch0;
    auto ld = [&](int ts, float* f) {
        const int tc = ts < 0 ? 0 : (ts >= bi.L ? bi.L - 1 : ts); const unsigned keep = (ts == tc) ? 0xffffffffu : 0u;
        if (CH == 8) { u32x4 w = *(const u32x4*)(base + (size_t)tc * PITCH); w.x &= keep; w.y &= keep; w.z &= keep; w.w &= keep; unpack8(w, f); }
        else { u32x2 w = *(const u32x2*)(base + (size_t)tc * PITCH); w.x &= keep; w.y &= keep; f[0] = __uint_as_float(w.x << 16); f[1] = __uint_as_float(w.x & 0xffff0000u); f[2] = __uint_as_float(w.y << 16); f[3] = __uint_as_float(w.y & 0xffff0000u); } };
    const int ts0 = bi.t0 + tb;
    ld(ts0 - 1, xm); ld(ts0, x0);
#pragma unroll
    for (int tt = 0; tt < NTOK; ++tt) {
        ld(ts0 + tt + 1, xp);
        float u[CH];
#pragma unroll
        for (int j = 0; j < CH; ++j) { const float a = bb[j] + w0[j] * xm[j] + w1[j] * x0[j] + w2[j] * xp[j]; u[j] = siluf(a); }
        emit(tb + tt, u);
#pragma unroll
        for (int j = 0; j < CH; ++j) { xm[j] = x0[j]; x0[j] = xp[j]; }
    }
}
template <int KIND>
__device__ __forceinline__ void scan_tables(KP p, int layer, const bf16_t* P, const BlkInfo& bi, int hidx, int dir, int lane, float (&cum)[4], float (&dt)[4], float& tot) {
    float la[4];
    if (KIND == 0) {
        const float bias = p->in[17][(layer * 2 + dir) * 16 + hidx], A = expf(p->in[18][(layer * 2 + dir) * 16 + hidx]);
#pragma unroll
        for (int k = 0; k < 4; ++k) { const float x = bf2f(P[(size_t)(bi.row0 + 4 * lane + k) * PITCH + C_DTR + dir * 16 + hidx]) + bias; dt[k] = x > 20.f ? x : __logf(1.f + __expf(x)); la[k] = -dt[k] * A; }
    } else {
        const float lar = log1pf(-exp2f(-((dir == 0 ? 5.0f : 5.5f) + (float)hidx)));
        float one = 1.f; asm volatile("" : "+v"(one));
#pragma unroll
        for (int k = 0; k < 4; ++k) { dt[k] = one; la[k] = lar; }
    }
    if (dir == 0) {
        float c[4]; c[0] = la[0]; c[1] = c[0] + la[1]; c[2] = c[1] + la[2]; c[3] = c[2] + la[3];
        float incl = c[3];
#pragma unroll
        for (int o = 1; o < 64; o <<= 1) { const float t = __shfl_up(incl, o); if (lane >= o) incl += t; }
        const float excl = incl - c[3];
#pragma unroll
        for (int k = 0; k < 4; ++k) cum[k] = excl + c[k];
        tot = __shfl(incl, 63);
    } else {
        float c[4]; c[3] = la[3]; c[2] = c[3] + la[2]; c[1] = c[2] + la[1]; c[0] = c[1] + la[0];
        float incl = c[0];
#pragma unroll
        for (int o = 1; o < 64; o <<= 1) { const float t = __shfl_down(incl, o); if (lane + o < 64) incl += t; }
        const float excl = incl - c[0];
#pragma unroll
        for (int k = 0; k < 4; ++k) cum[k] = excl + c[k];
        tot = __shfl(incl, 0);
    }
}

__device__ __forceinline__ void ssd_tables_from(const float (&xraw)[4], float bias, float Alog, int dir, int lane, float (&cum)[4], float (&dt)[4], float& tot) {
    const float A = expf(Alog);
    float la[4];
#pragma unroll
    for (int k = 0; k < 4; ++k) { const float x = xraw[k] + bias; dt[k] = x > 20.f ? x : __logf(1.f + __expf(x)); la[k] = -dt[k] * A; }
    if (dir == 0) {
        float c[4]; c[0] = la[0]; c[1] = c[0] + la[1]; c[2] = c[1] + la[2]; c[3] = c[2] + la[3];
        float incl = c[3];
#pragma unroll
        for (int o = 1; o < 64; o <<= 1) { const float t = __shfl_up(incl, o); if (lane >= o) incl += t; }
        const float excl = incl - c[3];
#pragma unroll
        for (int k = 0; k < 4; ++k) cum[k] = excl + c[k];
        tot = __shfl(incl, 63);
    } else {
        float c[4]; c[3] = la[3]; c[2] = c[3] + la[2]; c[1] = c[2] + la[1]; c[0] = c[1] + la[0];
        float incl = c[0];
#pragma unroll
        for (int o = 1; o < 64; o <<= 1) { const float t = __shfl_down(incl, o); if (lane + o < 64) incl += t; }
        const float excl = incl - c[0];
#pragma unroll
        for (int k = 0; k < 4; ++k) cum[k] = excl + c[k];
        tot = __shfl(incl, 0);
    }
}

__device__ __forceinline__ int blk_rowtile(int blk) { const int b = blk / 33, k = blk % 33; return k == 0 ? 64 + b : 32 * b + (k - 1); }
__device__ __forceinline__ void scanA_ssd(KP p, int layer, LAS char* lds, int blk, int g) {
    const int tid = tid_opaque(), lane = tid & 63, r32 = lane & 31, hi = lane >> 5, wave = __builtin_amdgcn_readfirstlane(tid >> 6);
    const BlkInfo bi = blk_info(blk);
    const bf16_t* P = (const bf16_t*)(p->ws + WS_PROJ);
    bf16_t* Pw = (bf16_t*)(p->ws + WS_PROJ);
    bf16_t* ST = (bf16_t*)(p->ws + WS_ST); float* ctl = (float*)(p->ws + WS_CTL);
    const float* cw = p->in[15] + (size_t)layer * 3 * 1536; const float* cb = p->in[16] + (size_t)layer * 1536;
    LAS float* WA = (LAS float*)(lds + 131072);
    int blk_o = blk; asm volatile("" : "+s"(blk_o));
    const int kk = blk_o % 33 - 1, pmt = blk_rowtile(blk_o);
    const bf16_t* HL = (const bf16_t*)(p->ws + WS_HALO);
    const bf16_t* hprev = (!bi.isctx && kk > 0) ? HL + (size_t)((pmt - 1) * 2 + 1) * 1536 : nullptr;
    const bf16_t* hnext = (!bi.isctx && kk < 31) ? HL + (size_t)((pmt + 1) * 2) * 1536 : nullptr;
    auto ld_row = [&](int j, int ch) -> u32x4 {
        const bool inside = (unsigned)j < 256u; const bf16_t* hs = j < 0 ? hprev : hnext;
        const bf16_t* ptr = inside ? P + (size_t)(bi.row0 + j) * PITCH + C_XBC + ch : (hs ? hs + ch : P + (size_t)bi.row0 * PITCH + C_XBC + ch);
        const unsigned keep = (inside || hs) ? 0xffffffffu : 0u;
        u32x4 w = *(const u32x4*)ptr; w.x &= keep; w.y &= keep; w.z &= keep; w.w &= keep; return w; };
    float tq_x[2][4], tq_b[2], tq_a[2];
#pragma unroll
    for (int q = 0; q < 2; ++q) {
        const int hd = 2 * wave + q, head = hd >> 1, dir = hd & 1, hidx = g * 8 + head;
        tq_b[q] = p->in[17][(layer * 2 + dir) * 16 + hidx]; tq_a[q] = p->in[18][(layer * 2 + dir) * 16 + hidx];
#pragma unroll
        for (int k = 0; k < 4; ++k) tq_x[q][k] = bf2f(P[(size_t)(bi.row0 + 4 * lane + k) * PITCH + C_DTR + dir * 16 + hidx]);
    }
    const int bc = tid & 31, btb = (tid >> 5) * 16, bcc = bc & 15; const bool isB = bc < 16;
    const int bch = (isB ? 1024 : 1280) + g * 128 + bcc * 8;
    const int xc = tid & 7, xtb = (tid >> 3) * 4;
    u32x4 rb[18], xrow[6];
#pragma unroll
    for (int k = 0; k < 18; ++k) rb[k] = ld_row(btb - 1 + k, bch);
#pragma unroll
    for (int k = 0; k < 6; ++k) xrow[k] = ld_row(xtb - 1 + k, (g * 8) * 64 + xc * 8);
    float hw0[8], hw1[8], hw2[8], hbb[8];
    float sw0[8], sw1[8], sw2[8], sbb[8];
#pragma unroll
    for (int j = 0; j < 8; ++j) { sw0[j] = cw[bch + j]; sw1[j] = cw[1536 + bch + j]; sw2[j] = cw[3072 + bch + j]; sbb[j] = cb[bch + j]; }
    { const int ch0 = (g * 8) * 64 + xc * 8;
#pragma unroll
      for (int j = 0; j < 8; ++j) { hw0[j] = cw[ch0 + j]; hw1[j] = cw[1536 + ch0 + j]; hw2[j] = cw[3072 + ch0 + j]; hbb[j] = cb[ch0 + j]; } }
#pragma unroll
    for (int q = 0; q < 2; ++q) {
        const int hd = 2 * wave + q, head = hd >> 1, dir = hd & 1;
        float cum[4], dt[4], tot;
        ssd_tables_from(tq_x[q], tq_b[q], tq_a[q], dir, lane, cum, dt, tot);
        f32x4 w;
#pragma unroll
        for (int k = 0; k < 4; ++k) w[k] = dt[k] * __expf(tot - cum[k]);
        *(LAS f32x4*)(WA + hd * 256 + 4 * lane) = w;
        { float* tg = (float*)(p->ws + WS_TABG) + (size_t)((blk * 2 + dir) * 16 + g * 8 + head) * 512 + 4 * lane;
          *(f32x4*)tg = (f32x4){cum[0], cum[1], cum[2], cum[3]}; *(f32x4*)(tg + 256) = (f32x4){dt[0], dt[1], dt[2], dt[3]}; }
        if (lane == 0) ctl[CF_TOT + (blk * 2 + dir) * 20 + g * 8 + head] = tot;
    }
    __syncthreads();
    {
        float w0[8], w1[8], w2[8], bb[8];
#pragma unroll
        for (int j = 0; j < 8; ++j) { w0[j] = sw0[j]; w1[j] = sw1[j]; w2[j] = sw2[j]; bb[j] = sbb[j]; }
        float xm[8], x0[8], xp[8];
        unpack8(rb[0], xm); unpack8(rb[1], x0);
#pragma unroll
        for (int tt = 0; tt < 16; ++tt) {
            unpack8(rb[tt + 2], xp);
            float u[8];
#pragma unroll
            for (int j = 0; j < 8; ++j) u[j] = siluf(bb[j] + w0[j] * xm[j] + w1[j] * x0[j] + w2[j] * xp[j]);
            const u32x4 w = pack8(u); const int t = btb + tt;
            if (isB) *(LAS u32x4*)(lds + (bcc >> 2) * 16384 + t * 64 + (bcc & 3) * 16) = w;
            *(u32x4*)(Pw + (size_t)(bi.row0 + t) * PITCH + C_U + bch) = w;
#pragma unroll
            for (int j = 0; j < 8; ++j) { xm[j] = x0[j]; x0[j] = xp[j]; }
        }
    }
    const int lo_ = tr_laneoff(lane);
    for (int head = 0; head < 8; ++head) {
        {
            const int ch0 = (g * 8 + head) * 64 + xc * 8;
            float w0[8], w1[8], w2[8], bb[8];
#pragma unroll
            for (int j = 0; j < 8; ++j) { w0[j] = hw0[j]; w1[j] = hw1[j]; w2[j] = hw2[j]; bb[j] = hbb[j]; }
            float xm[8], x0[8], xp[8];
            unpack8(xrow[0], xm); unpack8(xrow[1], x0);
#pragma unroll
            for (int tt = 0; tt < 4; ++tt) {
                unpack8(xrow[tt + 2], xp);
                float u[8], uf[8], ub[8];
                const int t = xtb + tt;
                const float wf = WA[(head * 2) * 256 + t], wb = WA[(head * 2 + 1) * 256 + t];
#pragma unroll
                for (int j = 0; j < 8; ++j) { u[j] = siluf(bb[j] + w0[j] * xm[j] + w1[j] * x0[j] + w2[j] * xp[j]); uf[j] = u[j] * wf; ub[j] = u[j] * wb; }
                *(u32x4*)(Pw + (size_t)(bi.row0 + t) * PITCH + C_U + ch0) = pack8(u);
                const int off = (xc >> 2) * 16384 + t * 64 + (xc & 3) * 16;
                *(LAS u32x4*)(lds + 65536 + off) = pack8(uf); *(LAS u32x4*)(lds + 98304 + off) = pack8(ub);
#pragma unroll
                for (int j = 0; j < 8; ++j) { xm[j] = x0[j]; x0[j] = xp[j]; }
            }
        }
        if (head + 1 < 8) {
#pragma unroll
            for (int k = 0; k < 6; ++k) xrow[k] = ld_row(xtb - 1 + k, (g * 8 + head + 1) * 64 + xc * 8);
            const int chn = (g * 8 + head + 1) * 64 + xc * 8;
#pragma unroll
            for (int j = 0; j < 8; ++j) { hw0[j] = cw[chn + j]; hw1[j] = cw[1536 + chn + j]; hw2[j] = cw[3072 + chn + j]; hbb[j] = cb[chn + j]; }
        }
        __syncthreads();
        const int pb = wave & 1, nb = wave >> 1;
#pragma unroll
        for (int dir = 0; dir < 2; ++dir) {
            f32x16 acc;
#pragma unroll
            for (int r = 0; r < 16; ++r) acc[r] = 0.f;
            const unsigned xa_ = (unsigned)(uintptr_t)lds + (unsigned)(65536 + dir * 32768 + pb * 16384 + lo_), ba_ = (unsigned)(uintptr_t)lds + (unsigned)(nb * 16384 + lo_);
            s16x4 f[2][4];
#define SA_RD(F, s_) do { asm volatile("ds_read_b64_tr_b16 %0, %1 offset:%c2" : "=v"(F[0]) : "v"(xa_), "i"((s_) * 1024) : "memory"); asm volatile("ds_read_b64_tr_b16 %0, %1 offset:%c2" : "=v"(F[1]) : "v"(xa_), "i"((s_) * 1024 + 512) : "memory"); \
                asm volatile("ds_read_b64_tr_b16 %0, %1 offset:%c2" : "=v"(F[2]) : "v"(ba_), "i"((s_) * 1024) : "memory"); asm volatile("ds_read_b64_tr_b16 %0, %1 offset:%c2" : "=v"(F[3]) : "v"(ba_), "i"((s_) * 1024 + 512) : "memory"); } while (0)
#define SA_VF(A, B) (bf16x8){A[0], A[1], A[2], A[3], B[0], B[1], B[2], B[3]}
            SA_RD(f[0], 0);
#pragma unroll
            for (int s = 0; s < 16; ++s) {
                if (s + 1 < 16) { SA_RD(f[(s + 1) & 1], s + 1); __builtin_amdgcn_sched_barrier(0); asm volatile("s_waitcnt lgkmcnt(4)" ::: "memory"); }
                else { __builtin_amdgcn_sched_barrier(0); asm volatile("s_waitcnt lgkmcnt(0)" ::: "memory"); }
                __builtin_amdgcn_sched_barrier(0);
                acc = __builtin_amdgcn_mfma_f32_32x32x16_bf16(SA_VF(f[s & 1][0], f[s & 1][1]), SA_VF(f[s & 1][2], f[s & 1][3]), acc, 0, 0, 0);
                __builtin_amdgcn_sched_barrier(0);
            }
#undef SA_RD
#undef SA_VF
            bf16_t* so = ST + st_off(blk, dir, g * 8 + head) + 32 * nb + r32;
#pragma unroll
            for (int r = 0; r < 16; ++r) so[(size_t)(32 * pb + crow(r, hi)) * 128] = f2bf(acc[r]);
        }
        __syncthreads();
    }
}
__device__ __forceinline__ void scanA_ret(KP p, int layer, LAS char* lds, int blk, int head) {
    const int tid = tid_opaque(), lane = tid & 63, r32 = lane & 31, hi = lane >> 5, wave = __builtin_amdgcn_readfirstlane(tid >> 6);
    const BlkInfo bi = blk_info(blk);
    const bf16_t* P = (const bf16_t*)(p->ws + WS_PROJ);
    bf16_t* ST = (bf16_t*)(p->ws + WS_ST); float* ctl = (float*)(p->ws + WS_CTL);
    const float laf = log1pf(-exp2f(-(5.0f + (float)head))), lab = log1pf(-exp2f(-(5.5f + (float)head)));
    if (tid < 2) ctl[CF_TOT + (blk * 2 + tid) * 20 + 16 + head] = 256.f * (tid == 0 ? laf : lab);
    bf16_t* Pw = (bf16_t*)(p->ws + WS_PROJ);
    const float* rope = (const float*)(p->ws + WS_CTL) + CF_ROPE;
#pragma unroll
    for (int i = 0; i < 4; ++i) {
        const int itm = tid + i * 512, isk = itm >> 10, pp = itm & 3, t = (itm >> 2) & 255;
        bf16_t* src = Pw + (size_t)(bi.row0 + t) * PITCH + (isk ? C_RK : C_RQ) + head * 64 + pp * 8;
        float x1[8], x2[8], cs[8], sn[8], y1[8], y2[8];
        unpack8(*(const u32x4*)src, x1); unpack8(*(const u32x4*)(src + 32), x2);
        if (!bi.isctx) {
            const int ts = bi.t0 + t;
            const float* cp = rope + (pp < 2 ? (ts >> 6) * 16 + 8 * pp : (128 + (ts & 63)) * 16 + 8 * (pp - 2));
            const f32x4 c0 = *(const f32x4*)cp, c1 = *(const f32x4*)(cp + 4), s0 = *(const f32x4*)(cp + 3072), s1 = *(const f32x4*)(cp + 3076);
#pragma unroll
            for (int j = 0; j < 4; ++j) { cs[j] = c0[j]; cs[4 + j] = c1[j]; sn[j] = s0[j]; sn[4 + j] = s1[j]; }
        } else {
#pragma unroll
            for (int j = 0; j < 8; ++j) { cs[j] = 1.f; sn[j] = 0.f; }
        }
        const float sc = isk ? 0.125f : 1.f;
#pragma unroll
        for (int j = 0; j < 8; ++j) { y1[j] = (x1[j] * cs[j] - x2[j] * sn[j]) * sc; y2[j] = (x1[j] * sn[j] + x2[j] * cs[j]) * sc; }
        const u32x4 w1 = pack8(y1), w2 = pack8(y2);
        *(u32x4*)src = w1; *(u32x4*)(src + 32) = w2;
        if (isk) {
            float f1[8], f2[8]; unpack8(w1, f1); unpack8(w2, f2);
            const float wf = __expf((float)(255 - t) * laf), wb = __expf((float)t * lab);
            float a1[8], a2[8], b1[8], b2[8];
#pragma unroll
            for (int j = 0; j < 8; ++j) { a1[j] = f1[j] * wf; a2[j] = f2[j] * wf; b1[j] = f1[j] * wb; b2[j] = f2[j] * wb; }
            const int off1 = t * 64 + pp * 16;
            *(LAS u32x4*)(lds + off1) = pack8(a1); *(LAS u32x4*)(lds + 16384 + off1) = pack8(a2);
            *(LAS u32x4*)(lds + 32768 + off1) = pack8(b1); *(LAS u32x4*)(lds + 32768 + 16384 + off1) = pack8(b2);
        }
    }
#pragma unroll
    for (int i = 0; i < 8; ++i) {
        const int it = tid + i * 512, c = it & 15, t = it >> 4;
        *(LAS u32x4*)(lds + 65536 + (c >> 2) * 16384 + t * 64 + (c & 3) * 16) = *(const u32x4*)(P + (size_t)(bi.row0 + t) * PITCH + C_RV + head * 128 + c * 8);
    }
    __syncthreads();
    const int lo_ = tr_laneoff(lane), pb = wave & 3, nb = wave >> 2;
#pragma unroll
    for (int dir = 0; dir < 2; ++dir) {
        f32x16 acc;
#pragma unroll
        for (int r = 0; r < 16; ++r) acc[r] = 0.f;
        const LAS char* va = lds + 65536 + pb * 16384 + lo_; const LAS char* ka = lds + dir * 32768 + nb * 16384 + lo_;
#pragma unroll 4
        for (int s = 0; s < 16; ++s) acc = __builtin_amdgcn_mfma_f32_32x32x16_bf16(tr_frag(va + s * 1024), tr_frag(ka + s * 1024), acc, 0, 0, 0);
        bf16_t* so = ST + st_off(blk, dir, 16 + head) + 32 * nb + r32;
#pragma unroll
        for (int r = 0; r < 16; ++r) so[(size_t)(32 * pb + crow(r, hi)) * 64] = f2bf(acc[r]);
    }
    __syncthreads();
}
__device__ __forceinline__ void phase_scanA(KP p, int layer, LAS char* lds, int blk, int nblk) {
    if (nblk >= 200) {
        if (blk < 132) scanA_ssd(p, layer, lds, blk >> 1, blk & 1);
        else for (int v = blk - 132; v < 264; v += nblk - 132) scanA_ret(p, layer, lds, v >> 2, v & 3);
    } else
    for (int u = blk; u < 132 + 264; u += nblk) {
        if (u < 132) scanA_ssd(p, layer, lds, u >> 1, u & 1);
        else { const int v = u - 132; scanA_ret(p, layer, lds, v >> 2, v & 3); }
    }
}

__device__ __forceinline__ void phase_scanB(KP p, int layer, int blk, int nblk) {
    const int tid = tid_opaque();
    bf16_t* ST = (bf16_t*)(p->ws + WS_ST); const float* ctl = (const float*)(p->ws + WS_CTL);
    for (int it = blk * 512 + tid; it < 2 * 2 * 20 * 1024; it += nblk * 512) {
        const int e8 = it & 1023, head = (it >> 10) % 20, bd = (it >> 10) / 20, dir = bd & 1, b = bd >> 1;
        float run[8]; float zero = 0.f; asm volatile("" : "+v"(zero));
#pragma unroll
        for (int j = 0; j < 8; ++j) run[j] = zero;
#pragma unroll
        for (int s0 = 0; s0 < 33; s0 += 11) {
            u32x4 raw[11]; float tot[11];
#pragma unroll
            for (int i = 0; i < 11; ++i) {
                const int s = s0 + i, k = (s == 0) ? 0 : (dir == 0 ? s : 33 - s);
                const int bk = b * 33 + k;
                if (s < 32) { raw[i] = *(const u32x4*)(ST + st_off(bk, dir, head) + e8 * 8); tot[i] = ctl[CF_TOT + (bk * 2 + dir) * 20 + head]; }
                else { raw[i] = (u32x4){0u, 0u, 0u, 0u}; tot[i] = 0.f; }
            }
#pragma unroll
            for (int i = 0; i < 11; ++i) {
                const int s = s0 + i, k = (s == 0) ? 0 : (dir == 0 ? s : 33 - s);
                const int bk = b * 33 + k;
                float st[8]; unpack8(raw[i], st);
                const float dec = __expf(tot[i]);
                if (s > 0) *(u32x4*)(ST + st_off(bk, dir, head) + e8 * 8) = pack8(run);
#pragma unroll
                for (int j = 0; j < 8; ++j) run[j] = run[j] * dec + st[j];
            }
        }
    }
}

template <int KIND>
__device__ __forceinline__ void scanC_unit(KP p, int layer, LAS char* lds, int blk, int gh) {
    constexpr int N = KIND == 0 ? 128 : 64, NKS = N / 16, NSTEP = KIND == 0 ? 8 : 1, NHP = KIND == 0 ? 1 : 2;
    constexpr int QOFF = (N / 8) * 4096, XOFF = KIND == 0 ? 0 : 65536, TABOFF = 131072, RSOFF = 131072 + 12288;
    const int tid = tid_opaque(), lane = tid & 63, r32 = lane & 31, hi = lane >> 5, it = __builtin_amdgcn_readfirstlane(tid >> 6);
    const BlkInfo bi = blk_info(blk);
    bf16_t* P = (bf16_t*)(p->ws + WS_PROJ);
    const bf16_t* ST = (const bf16_t*)(p->ws + WS_ST);
    const float* cw = p->in[15] + (size_t)layer * 3 * 1536; const float* cb = p->in[16] + (size_t)layer * 1536;
    const unsigned lds0 = (unsigned)(uintptr_t)lds;
    auto dma_x = [&](int head, int buf) {
        const int tid = tid_opaque(), lane = tid & 63;
#pragma unroll
        for (int i = 0; i < 4; ++i) {
            const int piece = it * 4 + i, pblk = piece >> 4, rg = piece & 15;
            glds16(P + (size_t)(bi.row0 + 16 * rg + (lane >> 2)) * PITCH + C_U + (gh * 8 + head) * 64 + pblk * 32 + (lane & 3) * 8,
                   (unsigned)__builtin_amdgcn_readfirstlane(lds0 + XOFF + buf * 32768 + pblk * 16384 + rg * 1024));
        }
    };
    if (KIND == 0) {
#pragma unroll
        for (int i = 0; i < 16; ++i) {
            const int inst = it * 16 + i, tile = inst >> 6, r4 = inst & 63;
            const int row = 4 * r4 + (lane >> 4);
            glds16(P + (size_t)(bi.row0 + row) * PITCH + C_U + 1024 + tile * 256 + gh * 128 + (((lane & 15) ^ (row & 15)) * 8),
                   (unsigned)__builtin_amdgcn_readfirstlane(lds0 + tile * QOFF + r4 * 1024));
        }
        asm volatile("s_waitcnt vmcnt(0)" ::: "memory");
    } else {
#pragma unroll
        for (int i = 0; i < 8; ++i) {
            const int itm = tid + i * 512, c = itm & 15, t = itm >> 4;
            const int col = (c < 8) ? C_RK + gh * 64 + c * 8 : C_RQ + gh * 64 + (c - 8) * 8;
            *(LAS u32x4*)(lds + (c < 8 ? 0 : QOFF) + (c & 7) * 4096 + t * 16) = *(const u32x4*)(P + (size_t)(bi.row0 + t) * PITCH + col);
        }
#pragma unroll
        for (int i = 0; i < 8; ++i) {
            const int itm = tid + i * 512, c = itm & 15, t = itm >> 4;
            *(LAS u32x4*)(lds + XOFF + (c >> 2) * 16384 + t * 64 + (c & 3) * 16) = *(const u32x4*)(P + (size_t)(bi.row0 + t) * PITCH + C_RV + gh * 128 + c * 8);
        }
    }
    __syncthreads();
    u32x4 Gs[8][2];
    const int swz = r32 & 15;
#define SC_FRAG(base, tok, ks) (KIND == 0 ? *(const LAS bf16x8*)(lds + (base) + (tok) * 256 + (((2 * (ks) + hi) ^ swz) * 16)) : *(const LAS bf16x8*)(lds + (base) + (2 * (ks) + hi) * 4096 + (tok) * 16))
    {
        bf16x8 Cf[NKS];
#pragma unroll
        for (int ks = 0; ks < NKS; ++ks) Cf[ks] = SC_FRAG(QOFF, 32 * it + r32, ks);
#pragma unroll
        for (int jt = 0; jt < 8; ++jt) {
            f32x16 a;
#pragma unroll
            for (int r = 0; r < 16; ++r) a[r] = 0.f;
#pragma unroll
            for (int ks = 0; ks < NKS; ++ks) a = __builtin_amdgcn_mfma_f32_32x32x16_bf16(SC_FRAG(0, 32 * jt + r32, ks), Cf[ks], a, 0, 0, 0);
#pragma unroll
            for (int s = 0; s < 2; ++s)
#pragma unroll
                for (int e = 0; e < 4; ++e) Gs[jt][s][e] = cvtpk(a[8 * s + 2 * e], a[8 * s + 2 * e + 1]);
        }
    }
    auto stage_step = [&](int step) {
        const int tid = tid_opaque(), lane = tid & 63;
        if (it < 2) {
            const int slot = 0, dir = it & 1;
            float cum[4], dt[4], tot;
            if (KIND == 0) {
                const float* tg = (const float*)(p->ws + WS_TABG) + (size_t)((blk * 2 + dir) * 16 + gh * 8 + step) * 512 + 4 * lane;
                const f32x4 c4_ = *(const f32x4*)tg, d4_ = *(const f32x4*)(tg + 256);
#pragma unroll
                for (int k = 0; k < 4; ++k) { cum[k] = c4_[k]; dt[k] = d4_[k]; }
            } else scan_tables<KIND>(p, layer, P, bi, gh, dir, lane, cum, dt, tot);
            const float cref = dir == 0 ? __shfl(cum[3], lane | 7) : __shfl(cum[0], lane & ~7);
            f32x4 c4, w4, d4;
#pragma unroll
            for (int k = 0; k < 4; ++k) { c4[k] = cum[k] * LOG2E; d4[k] = dt[k]; w4[k] = dt[k] * __expf(cref - cum[k]); }
            LAS float* T = (LAS float*)(lds + TABOFF) + (slot * 2 + dir) * 768;
            *(LAS f32x4*)(T + 4 * lane) = c4; *(LAS f32x4*)(T + 256 + 4 * lane) = w4; *(LAS f32x4*)(T + 512 + 4 * lane) = d4;
        }
        if (KIND == 0) {
            dma_x(step, 0);
            if (!bi.isctx) {
#pragma unroll
                for (int i = 0; i < 4; ++i) {
                    const int inst = it * 4 + i, dir = inst >> 4, r4 = inst & 15, row = 4 * r4 + (lane >> 4);
                    glds16(ST + st_off(blk, dir, gh * 8 + step) + (size_t)row * 128 + (((lane & 15) ^ (row & 15)) * 8),
                           (unsigned)__builtin_amdgcn_readfirstlane(lds0 + 32768u + dir * 16384u + r4 * 1024u));
                }
            }
            asm volatile("s_waitcnt vmcnt(0)" ::: "memory");
        }
    };
    const int lo_ = tr_laneoff(lane), i_tok = 32 * it + r32;
    bf16_t* orow = P + (size_t)(bi.row0 + i_tok) * PITCH;
    float ssq = 0.f;
    for (int step = 0; step < NSTEP; ++step) {
        __syncthreads();
        stage_step(step);
        __syncthreads();
#pragma unroll 1
        for (int hp = 0; hp < NHP; ++hp) {
            const int head = KIND == 0 ? step : hp;
            const int hidx = KIND == 0 ? gh * 8 + head : gh;
            const LAS char* X = lds + XOFF + hp * 32768 + lo_;
            bf16_t* gbase = KIND == 0 ? orow + C_Z + hidx * 64 + 4 * hi : orow + C_RG + gh * 128 + 64 * head + 4 * hi;
            u32x2 gz[2][4];
#pragma unroll
            for (int rg = 0; rg < 4; ++rg) { gz[0][rg] = *(const u32x2*)(gbase + 8 * rg); gz[1][rg] = *(const u32x2*)(gbase + 32 + 8 * rg); }
            f32x16 acc[2];
#pragma unroll
            for (int pb = 0; pb < 2; ++pb)
#pragma unroll
                for (int r = 0; r < 16; ++r) acc[pb][r] = 0.f;
#pragma unroll 1
            for (int dir = 0; dir < 2; ++dir) {
                const LAS float* T = (const LAS float*)(lds + TABOFF) + dir * 768;
                const float ci = T[i_tok];
#pragma unroll
                for (int jt = 0; jt < 8; ++jt) {
                    const bool off = dir == 0 ? (jt < it) : (jt > it);
                    if (off) {
                        const float wi = __builtin_amdgcn_exp2f(ci - T[dir == 0 ? 32 * jt + 31 : 32 * jt]);
#pragma unroll
                        for (int s = 0; s < 2; ++s) {
                            const int j0 = 32 * jt + 16 * s + 4 * hi;
                            const f32x4 wa = *(const LAS f32x4*)(T + 256 + j0), wb = *(const LAS f32x4*)(T + 256 + j0 + 8);
                            float gv[8]; { u32x4 g_ = Gs[jt][s]; asm volatile("" : "+v"(g_)); unpack8(g_, gv); }
#pragma unroll
                            for (int e = 0; e < 4; ++e) { gv[e] *= wa[e] * wi; gv[4 + e] *= wb[e] * wi; }
                            const bf16x8 mB = __builtin_bit_cast(bf16x8, pack8(gv));
#pragma unroll
                            for (int pb = 0; pb < 2; ++pb) acc[pb] = __builtin_amdgcn_mfma_f32_32x32x16_bf16(tr_frag(X + pb * 16384 + (32 * jt + 16 * s) * 64), mB, acc[pb], 0, 0, 0);
                        }
                    } else if (jt == it) {
                        const int sd_ = dir == 0 ? 1 : -1, dr_ = sd_ * r32;
#pragma unroll
                        for (int s = 0; s < 2; ++s) {
                            const int j0 = 32 * jt + 16 * s + 4 * hi;
                            const f32x4 ca = *(const LAS f32x4*)(T + j0), cb4 = *(const LAS f32x4*)(T + j0 + 8), da = *(const LAS f32x4*)(T + 512 + j0), db = *(const LAS f32x4*)(T + 512 + j0 + 8);
                            float gv[8]; { u32x4 g_ = Gs[jt][s]; asm volatile("" : "+v"(g_)); unpack8(g_, gv); }
#pragma unroll
                            for (int e = 0; e < 4; ++e) {
                                const int ja = 16 * s + 4 * hi + e, jb = ja + 8;
                                const bool ka = sd_ * ja <= dr_, kb = sd_ * jb <= dr_;
                                gv[e] = ka ? gv[e] * da[e] * __builtin_amdgcn_exp2f(ci - ca[e]) : 0.f; gv[4 + e] = kb ? gv[4 + e] * db[e] * __builtin_amdgcn_exp2f(ci - cb4[e]) : 0.f;
                            }
                            const bf16x8 mB = __builtin_bit_cast(bf16x8, pack8(gv));
#pragma unroll
                            for (int pb = 0; pb < 2; ++pb) acc[pb] = __builtin_amdgcn_mfma_f32_32x32x16_bf16(tr_frag(X + pb * 16384 + (32 * jt + 16 * s) * 64), mB, acc[pb], 0, 0, 0);
                        }
                    }
                }
                if (!bi.isctx) {
                    const float ef = __builtin_amdgcn_exp2f(ci);
                    const bf16_t* Sp = ST + st_off(blk, dir, KIND == 0 ? hidx : 16 + gh) + (size_t)((KIND == 0 ? 0 : 64 * head) + r32) * N + 8 * hi;
                    const LAS char* Sl = lds + 32768 + dir * 16384 + r32 * 256;
                    if constexpr (KIND == 0) {
                        const unsigned cbase = lds0 + (unsigned)(QOFF + (32 * it + r32) * 256), sbase = lds0 + 32768u + (unsigned)(dir * 16384 + r32 * 256);
                        unsigned xo[NKS];
#pragma unroll
                        for (int ks = 0; ks < NKS; ++ks) xo[ks] = (unsigned)(((2 * ks + hi) ^ swz) * 16);
                        bf16x8 cf[NKS];
#pragma unroll
                        for (int ks = 0; ks < NKS; ++ks) asm volatile("ds_read_b128 %0, %1" : "=v"(cf[ks]) : "v"(cbase + xo[ks]) : "memory");
#pragma unroll
                        for (int pb = 0; pb < 2; ++pb) {
                            bf16x8 sf[NKS];
#pragma unroll
                            for (int ks = 0; ks < NKS; ++ks) asm volatile("ds_read_b128 %0, %1 offset:%c2" : "=v"(sf[ks]) : "v"(sbase + xo[ks]), "i"(pb * 8192) : "memory");
                            __builtin_amdgcn_sched_barrier(0); asm volatile("s_waitcnt lgkmcnt(0)" ::: "memory"); __builtin_amdgcn_sched_barrier(0);
                            f32x16 a2;
#pragma unroll
                            for (int r = 0; r < 16; ++r) a2[r] = 0.f;
#pragma unroll
                            for (int ks = 0; ks < NKS; ++ks) a2 = __builtin_amdgcn_mfma_f32_32x32x16_bf16(sf[ks], cf[ks], a2, 0, 0, 0);
#pragma unroll
                            for (int r = 0; r < 16; ++r) acc[pb][r] += ef * a2[r];
                        }
                    } else {
                        bf16x8 sg[2][NKS];
#pragma unroll
                        for (int pb = 0; pb < 2; ++pb)
#pragma unroll
                            for (int ks = 0; ks < NKS; ++ks) sg[pb][ks] = *(const bf16x8*)(Sp + (size_t)(32 * pb) * N + 16 * ks);
                        __builtin_amdgcn_sched_barrier(0);
#pragma unroll
                        for (int pb = 0; pb < 2; ++pb) {
                            f32x16 a2;
#pragma unroll
                            for (int r = 0; r < 16; ++r) a2[r] = 0.f;
#pragma unroll
                            for (int ks = 0; ks < NKS; ++ks) a2 = __builtin_amdgcn_mfma_f32_32x32x16_bf16(sg[pb][ks], SC_FRAG(QOFF, 32 * it + r32, ks), a2, 0, 0, 0);
#pragma unroll
                            for (int r = 0; r < 16; ++r) acc[pb][r] += ef * a2[r];
                        }
                    }
                }
            }
            const float Dh = KIND == 0 ? p->in[19][layer * 16 + hidx] : 0.f;
#pragma unroll
            for (int pb = 0; pb < 2; ++pb)
#pragma unroll
                for (int rg = 0; rg < 4; ++rg) {
                    const int p0 = 32 * pb + 8 * rg + 4 * hi;
                    const float a0 = acc[pb][4 * rg], a1 = acc[pb][4 * rg + 1], a2 = acc[pb][4 * rg + 2], a3 = acc[pb][4 * rg + 3];
                    const u32x2 zw = gz[pb][rg];
                    const float z0 = __uint_as_float(zw.x << 16), z1 = __uint_as_float(zw.x & 0xffff0000u), z2 = __uint_as_float(zw.y << 16), z3 = __uint_as_float(zw.y & 0xffff0000u);
                    u32x2 o;
                    if (KIND == 0) {
                        const u32x2 xw = *(const LAS u32x2*)(X - lo_ + pb * 16384 + i_tok * 64 + (8 * rg + 4 * hi) * 2);
                        const float x0 = __uint_as_float(xw.x << 16), x1 = __uint_as_float(xw.x & 0xffff0000u), x2 = __uint_as_float(xw.y << 16), x3 = __uint_as_float(xw.y & 0xffff0000u);
                        const float v0 = (a0 + Dh * x0) * siluf(z0), v1 = (a1 + Dh * x1) * siluf(z1), v2 = (a2 + Dh * x2) * siluf(z2), v3 = (a3 + Dh * x3) * siluf(z3);
                        ssq += v0 * v0 + v1 * v1 + v2 * v2 + v3 * v3;
                        o.x = cvtpk(v0, v1); o.y = cvtpk(v2, v3);
                    } else {
                        ssq += a0 * a0 + a1 * a1 + a2 * a2 + a3 * a3;
                        const f32x4 nw = *(const f32x4*)(p->in[21] + layer * 128 + 64 * head + p0);
                        o.x = cvtpk(a0 * nw[0] * siluf(z0), a1 * nw[1] * siluf(z1)); o.y = cvtpk(a2 * nw[2] * siluf(z2), a3 * nw[3] * siluf(z3));
                    }
                    *(u32x2*)(gbase + 32 * pb + 8 * rg) = o;
                }
        }
    }
    ssq += __shfl_xor(ssq, 32);
    LAS float* rsb = (LAS float*)(lds + RSOFF) + 32 * it;
    if (hi == 0) rsb[r32] = rsqrtf(ssq * (KIND == 0 ? 1.f / 512.f : 1.f / 128.f) + EPS);
    asm volatile("s_waitcnt vmcnt(0) lgkmcnt(0)" ::: "memory");
    {
        bf16_t* rbase = P + (size_t)(bi.row0 + 32 * it) * PITCH + (KIND == 0 ? C_Z + gh * 512 + lane * 8 : C_RG + gh * 128 + lane * 2);
        if (KIND == 0) {
            float nw[8];
#pragma unroll
            for (int j = 0; j < 8; ++j) nw[j] = p->in[20][layer * 1024 + gh * 512 + lane * 8 + j];
#pragma unroll 1
            for (int t8 = 0; t8 < 32; t8 += 32) {
                u32x4 w[32];
#pragma unroll
                for (int k = 0; k < 32; ++k) asm volatile("global_load_dwordx4 %0, %1, off sc1" : "=v"(w[k]) : "v"(rbase + (size_t)(t8 + k) * PITCH) : "memory");
                __builtin_amdgcn_sched_barrier(0); asm volatile("s_waitcnt vmcnt(0)" ::: "memory"); __builtin_amdgcn_sched_barrier(0);
#pragma unroll
                for (int k = 0; k < 32; ++k) { float f[8]; unpack8(w[k], f); const float rs = rsb[t8 + k];
#pragma unroll
                    for (int j = 0; j < 8; ++j) f[j] *= rs * nw[j];
                    *(u32x4*)(rbase + (size_t)(t8 + k) * PITCH) = pack8(f); }
            }
        } else {
            bf16_t* rb4 = P + (size_t)(bi.row0 + 32 * it + (lane >> 4)) * PITCH + C_RG + gh * 128 + (lane & 15) * 8;
            u32x4 w[8];
#pragma unroll
            for (int k = 0; k < 8; ++k) asm volatile("global_load_dwordx4 %0, %1, off sc1" : "=v"(w[k]) : "v"(rb4 + (size_t)(4 * k) * PITCH) : "memory");
            __builtin_amdgcn_sched_barrier(0); asm volatile("s_waitcnt vmcnt(0)" ::: "memory"); __builtin_amdgcn_sched_barrier(0);
#pragma unroll
            for (int k = 0; k < 8; ++k) { float f[8]; unpack8(w[k], f); const float rs = rsb[4 * k + (lane >> 4)];
#pragma unroll
                for (int j = 0; j < 8; ++j) f[j] *= rs;
                *(u32x4*)(rb4 + (size_t)(4 * k) * PITCH) = pack8(f); }
        }
    }
    __syncthreads();
#undef SC_FRAG
}
__device__ __forceinline__ void phase_scanC(KP p, int layer, LAS char* lds, int blk, int nblk) {
    if (nblk >= 200) {
        if (blk < 132) { const int bk = blk >> 1; if (layer + 1 < DEPTH || (bk % 33) != 0) scanC_unit<0>(p, layer, lds, bk, blk & 1); }
        else for (int v = blk - 132; v < 264; v += nblk - 132) { const int bk = v >> 2; if (layer + 1 < DEPTH || (bk % 33) != 0) scanC_unit<1>(p, layer, lds, bk, v & 3); }
        if (layer == 0 && blk >= 148 && blk < 164) { const int j = blk - 148; attn_unit(p, layer, lds, j >> 3, (j >> 1) & 3, (j & 1) * 128, 1); }
    } else
    for (int u = blk; u < 132 + 264; u += nblk) {
        if (u < 132) { const int bk = u >> 1; if (layer + 1 < DEPTH || (bk % 33) != 0) scanC_unit<0>(p, layer, lds, bk, u & 1); }
        else { const int v = u - 132, bk = v >> 2; if (layer + 1 < DEPTH || (bk % 33) != 0) scanC_unit<1>(p, layer, lds, bk, v & 3); }
    }
}


#define XB_TMO      128
#define XB_XCNT(j)  (256  + 64 * (j))
#define XB_XSUB(j)  (1280 + 64 * (j))
#define XB_XGEN(j)  (2304 + 64 * (j))
#define XB_TOP      3328
#define XB_TOPGEN   3392
#define XCD_BAR_WORDS 3456
#define XB_SPIN_CAP (1u << 20)
constexpr size_t WS_BAR = 262144;
constexpr int LDS_MISC = 147456;
__device__ __forceinline__ unsigned xb_ld(unsigned* p)              { return __hip_atomic_load(p, __ATOMIC_RELAXED, __HIP_MEMORY_SCOPE_AGENT); }
__device__ __forceinline__ unsigned xb_add(unsigned* p, unsigned v) { return __hip_atomic_fetch_add(p, v, __ATOMIC_RELAXED, __HIP_MEMORY_SCOPE_AGENT); }
__device__ __forceinline__ unsigned xb_xcc_id() { return (unsigned)__builtin_amdgcn_s_getreg((3 << 11) | 20) & 0xFu; }
#define XB_SPIN(cond, bar) do { unsigned _sp = 0; while (cond) { __builtin_amdgcn_s_sleep(1); \
    if ((++_sp & 255u) == 0u) { if (xb_ld(&(bar)[XB_TMO])) break; if (_sp > XB_SPIN_CAP) { atomicAdd(&(bar)[XB_TMO], 1u); break; } } } } while (0)
struct XcdBarrier { unsigned* bar; unsigned x; volatile LAS unsigned* st; };
__device__ __forceinline__ XcdBarrier xcd_barrier_post(unsigned* bar, volatile LAS unsigned* st) {
    XcdBarrier b; b.bar = bar; b.x = xb_xcc_id(); b.st = st;
    if (threadIdx.x == 0) (void)xb_add(&bar[XB_XCNT(b.x)], 1u);
    return b;
}
__device__ __forceinline__ void xcd_barrier_complete(unsigned* bar, unsigned x, unsigned& nloc, unsigned& nx) {
    const unsigned G = gridDim.x * gridDim.y * gridDim.z;
    unsigned sum, cnt, mine, sp = 0u;
    for (;;) {
        sum = 0u; cnt = 0u; mine = 0u;
#pragma unroll
        for (unsigned j = 0; j < 16; ++j) { const unsigned c = xb_ld(&bar[XB_XCNT(j)]); sum += c; cnt += (c > 0u) ? 1u : 0u; mine = (j == x) ? c : mine; }
        if (sum == G) break;
        __builtin_amdgcn_s_sleep(1);
        if ((++sp & 255u) == 0u) { if (xb_ld(&bar[XB_TMO])) break; if (sp > XB_SPIN_CAP) { atomicAdd(&bar[XB_TMO], 1u); break; } }
    }
    nloc = mine > 0u ? mine : 1u; nx = cnt > 0u ? cnt : 1u;
}
__device__ __forceinline__ void xcd_barrier(const XcdBarrier& b) {
    asm volatile("s_waitcnt vmcnt(0)" ::: "memory");
    __syncthreads();
    if (tid_opaque() == 0) {
        unsigned* bar = b.bar;
        __builtin_amdgcn_s_waitcnt(0);
        unsigned nloc = b.st[0], nx = b.st[1];
        if (nloc == 0u) { xcd_barrier_complete(bar, b.x, nloc, nx); b.st[0] = nloc; b.st[1] = nx; }
        const unsigned old = xb_add(&bar[XB_XSUB(b.x)], 1u);
        const unsigned gen = old / nloc;
        if (old + 1u == (gen + 1u) * nloc) {
            __builtin_amdgcn_fence(__ATOMIC_RELEASE, "agent");
            asm volatile("s_waitcnt vmcnt(0)" ::: "memory");
            const unsigned og = xb_add(&bar[XB_TOP], 1u);
            const unsigned tg = og / nx;
            if (og + 1u == (tg + 1u) * nx) xb_add(&bar[XB_TOPGEN], 1u);
            else XB_SPIN(xb_ld(&bar[XB_TOPGEN]) == tg, bar);
            __builtin_amdgcn_fence(__ATOMIC_ACQUIRE, "agent");
            xb_add(&bar[XB_XGEN(b.x)], 1u);
            asm volatile("s_waitcnt vmcnt(0)" ::: "memory");
        } else {
            XB_SPIN(xb_ld(&bar[XB_XGEN(b.x)]) == gen, bar);
            __builtin_amdgcn_fence(__ATOMIC_ACQUIRE, "agent");
            asm volatile("s_waitcnt vmcnt(0)" ::: "memory");
        }
    }
    __syncthreads();
}

__global__ __launch_bounds__(512, 2) void hybrid_fwd(Params p_) {
    extern __shared__ __attribute__((aligned(16))) unsigned char ldsb[];
    LAS char* lds = (LAS char*)ldsb;
    float* ldsf = (float*)ldsb;
    const int blk = blockIdx.x, nblk = gridDim.x;
    {
        volatile LAS unsigned* misc = (volatile LAS unsigned*)(lds + LDS_MISC);
        if (threadIdx.x < 2) misc[threadIdx.x] = 0u;
        __syncthreads();
        (void)xcd_barrier_post((unsigned*)(kargs()->ws + WS_BAR), misc);
    }
#define XBAR_NOW() XcdBarrier{(unsigned*)(kargs()->ws + WS_BAR), xb_xcc_id(), (volatile LAS unsigned*)(lds + LDS_MISC)}
#if PROBE >= 0
    unsigned long long pr_a = __builtin_amdgcn_s_memrealtime(), pr_b = pr_a; int pr_seam = 0;
#if PROBE >= 200
#define SEAM() do { xcd_barrier(XBAR_NOW()); ++pr_seam; if (pr_seam == PROBE - 200) pr_a = __builtin_amdgcn_s_memtime(); if (pr_seam == PROBE - 199) pr_b = pr_a + (__builtin_amdgcn_s_memtime() - pr_a) / 16; } while (0)
#else
#define SEAM() do { xcd_barrier(XBAR_NOW()); ++pr_seam; if (pr_seam == PROBE) pr_a = __builtin_amdgcn_s_memrealtime(); if (pr_seam == PROBE + 1) pr_b = __builtin_amdgcn_s_memrealtime(); } while (0)
#endif
#else
#define SEAM() xcd_barrier(XBAR_NOW())
#endif

    phase_ada(kargs(), ldsf, blk, nblk);
    __syncthreads();
    phase_convw(kargs(), 0, ldsf, blk, nblk);
    SEAM();
    for (int layer = 0; layer < DEPTH; ++layer) {
        if (layer > 0) phase_convw(kargs(), layer, ldsf, blk, nblk);
        phase_norm(kargs(), layer, blk, nblk, ldsf);
        SEAM();
        {
            KP p = kargs();
            pg8::Gemm g{(const bf16_t*)(p->ws + WS_H), (const bf16_t*)(p->ws + WS_WINT), MT, NPAD, DM, DM, DM};
            pg8::StaticOrder S; S.init(MT, NPAD, nblk, blk);
            pg8::EpiProj E{(bf16_t*)(p->ws + WS_PROJ), (bf16_t*)(p->ws + WS_HALO)};
            pg8::gemm_phase<pg8::EpiProj, pg8::StaticOrder, true, true>((LAS unsigned char*)lds, g, S, E);
        }
        SEAM();
        phase_scanA(kargs(), layer, lds, blk, nblk);
        phase_prep(kargs(), layer, ldsf, blk, nblk);
        SEAM();
        phase_scanB(kargs(), layer, blk, nblk);
        phase_attn(kargs(), layer, lds, blk, nblk);
        SEAM();
        phase_scanC(kargs(), layer, lds, blk, nblk);
        SEAM();
        {
            KP p = kargs(); const float* ctl = (const float*)(p->ws + WS_CTL);
            pg8::Gemm g{(const bf16_t*)(p->ws + WS_PROJ), (const bf16_t*)(p->ws + WS_WOUTT), ML, DM, DMIX, PITCH, DMIX};
            pg8::StaticOrder S; S.init(ML, DM, nblk, blk);
            pg8::EpiResid E{layer == 0 ? p->in[0] : p->out, p->out, p->in[2], (float*)(p->ws + WS_CTXN), ctl + CF_MOD + layer * 3 * 3072};
            pg8::gemm_phase<pg8::EpiResid, pg8::StaticOrder, true, true>((LAS unsigned char*)lds, g, S, E);
            if (layer == 0 && nblk >= 64) {
                pg8::Gemm g2{(const bf16_t*)(p->ws + WS_PROJ), (const bf16_t*)(p->ws + WS_WOUTT), MT, DM, 256, PITCH, DMIX};
                pg8::CtxSplitOrder S2{blk};
                pg8::EpiCtxSlab E2{p->ws, ctl + CF_MOD};
                pg8::gemm_phase<pg8::EpiCtxSlab, pg8::CtxSplitOrder, false, true>((LAS unsigned char*)lds, g2, S2, E2);
            }
        }
        if (layer + 1 < DEPTH) SEAM();
    }
#if PROBE >= 200
#elif PROBE >= 100
    { volatile LAS unsigned long long* mk = (volatile LAS unsigned long long*)(lds + 147456 + 16); pr_a = mk[PROBE - 100]; pr_b = mk[PROBE - 99]; }
#elif PROBE >= 0
    if (PROBE + 1 > pr_seam) pr_b = __builtin_amdgcn_s_memrealtime();
#endif
#if PROBE >= 0
    if (blk == 0) { const unsigned long long t0 = __builtin_amdgcn_s_memrealtime(), w = 8ull * (pr_b - pr_a); while (__builtin_amdgcn_s_memrealtime() - t0 < w) __builtin_amdgcn_s_sleep(8); }
#endif
}

extern "C" void kernel_launch(void* const* d_in, const int* in_sizes, int n_in, void* d_out, int out_size, void* d_ws, size_t ws_size, hipStream_t stream) {
    if (n_in != 22 || ws_size < WS_END || out_size != ML * DM) { fprintf(stderr, "kernel_launch: unexpected shapes (n_in %d, ws %zu, out %d)\n", n_in, ws_size, out_size); return; }
    static int grid_blocks = 0;
    if (!grid_blocks) {
        int dev = 0, cus = 0, per_cu = 0;
        (void)hipGetDevice(&dev);
        (void)hipDeviceGetAttribute(&cus, hipDeviceAttributeMultiprocessorCount, dev);
        (void)hipFuncSetAttribute((const void*)hybrid_fwd, hipFuncAttributeMaxDynamicSharedMemorySize, LDS_BYTES);
        (void)hipOccupancyMaxActiveBlocksPerMultiprocessor(&per_cu, (const void*)hybrid_fwd, 512, LDS_BYTES);
        if (per_cu < 1) { fprintf(stderr, "kernel_launch: occupancy query says %d blocks per CU\n", per_cu); per_cu = 1; }
        grid_blocks = cus;
        (void)hipGetLastError();
    }
    Params p{};
    for (int i = 0; i < 22; ++i) p.in[i] = (const float*)d_in[i];
    p.out = (float*)d_out; p.ws = (unsigned char*)d_ws; p.layer = 0; p.pad = 0;
    (void)hipMemsetAsync((unsigned char*)d_ws + WS_BAR, 0, XCD_BAR_WORDS * 4, stream);
    void* args[] = {&p};
    hipError_t e = hipLaunchCooperativeKernel((const void*)hybrid_fwd, dim3(grid_blocks), dim3(512), args, LDS_BYTES, stream);
    if (e != hipSuccess) fprintf(stderr, "cooperative launch failed: %s (grid %d)\n", hipGetErrorString(e), grid_blocks);
}
```
